# Optimizing an MI355X kernel written in HIP

```python
import math
import jax, jax.numpy as jnp
from jax import lax
import numpy as np

D_MODEL = 1024
BATCH = 4
SEQ = 4096
DEPTH = 4

HEAD_DIM = 64
A_HEADS = 4
A_VDIM = 2 * HEAD_DIM
B_HEADS = 8
B_KV_HEADS = 2
B_WINDOW = 128
C_HEADS = 8
C_KV_HEADS = 2
CMP_BLOCK = 32
CMP_STRIDE = 16
CMP_HIDDEN = 256
SEL_BLOCK = 64
N_SELECT = 16
C_WINDOW = 512
MIX_WIDTH = B_HEADS * HEAD_DIM
N_BRANCH = 3
D_FF = 4 * D_MODEL
NUM_BUCKETS = 32
MAX_DISTANCE = 128
TOTAL_HEADS = A_HEADS + B_HEADS + C_HEADS
Q_BLOCK = 128
SEL_Q_BLOCK = 64
NEG_INF = -1e30
FORCE_BONUS = 1e4
EPS = 1e-6

SPLIT_SIZES = (
    A_HEADS * 2 * HEAD_DIM,
    A_HEADS * 2 * HEAD_DIM,
    A_HEADS * A_VDIM,
    B_HEADS * HEAD_DIM,
    B_KV_HEADS * HEAD_DIM,
    B_KV_HEADS * HEAD_DIM,
    C_HEADS * HEAD_DIM,
    6 * C_KV_HEADS * HEAD_DIM,
    C_HEADS * 3,
    N_BRANCH * D_MODEL,
)
IN_COLS = sum(SPLIT_SIZES)

kernel_name = 'hybrid_gated_diffattn_swa_nsa'


def rms_norm(x, g):
    xf = x.astype(jnp.float32)
    y = xf * lax.rsqrt(jnp.mean(xf * xf, axis=-1, keepdims=True) + EPS)
    return (y * g.astype(jnp.float32)).astype(x.dtype)


def rel_bucket(dist):
    n = jnp.maximum(dist, 0)
    max_exact = NUM_BUCKETS // 2
    nf = jnp.maximum(n, 1).astype(jnp.float32)
    large = max_exact + (jnp.log(nf / max_exact) / math.log(MAX_DISTANCE / max_exact)
                         * (NUM_BUCKETS - max_exact)).astype(jnp.int32)
    large = jnp.minimum(large, NUM_BUCKETS - 1)
    return jnp.where(n < max_exact, n, large)


def diff_attention(q, k, v, lam, bias_tab):
    B, S, H, _, D = q.shape
    nb = S // Q_BLOCK
    scale = D ** -0.5
    k_pos = jnp.arange(S)
    qb = q.reshape(B, nb, Q_BLOCK, H, 2, D).transpose(1, 0, 2, 3, 4, 5)

    def block(args):
        i, qi = args
        q_pos = i * Q_BLOCK + jnp.arange(Q_BLOCK)
        dist = q_pos[:, None] - k_pos[None, :]
        mask = dist >= 0
        bias = bias_tab[rel_bucket(dist)].transpose(2, 0, 1).astype(jnp.float32)
        s = jnp.einsum('bqhcd,bkhcd->cbhqk', qi, k).astype(jnp.float32) * scale + bias
        p = jax.nn.softmax(jnp.where(mask, s, NEG_INF), axis=-1)
        w = p[0] - lam * p[1]
        return jnp.einsum('bhqk,bkhe->bqhe', w.astype(v.dtype), v)

    out = lax.map(block, (jnp.arange(nb), qb))
    return out.transpose(1, 0, 2, 3, 4).reshape(B, S, H, v.shape[-1])


def banded_attention(q, k, v, bias_tab, window, sink=None):
    B, S, H, D = q.shape
    G = k.shape[2]
    R = H // G
    nb = S // Q_BLOCK
    n_prev = -(-window // Q_BLOCK)
    kw = (n_prev + 1) * Q_BLOCK

    def band(t):
        tb = t.reshape(B, nb, Q_BLOCK, G, D)
        tb = jnp.pad(tb, ((0, 0), (n_prev, 0), (0, 0), (0, 0), (0, 0)))
        return jnp.concatenate([tb[:, j:j + nb] for j in range(n_prev + 1)], axis=2)

    kb, vb = band(k), band(v)
    qb = q.reshape(B, nb, Q_BLOCK, G, R, D)
    r = jnp.arange(Q_BLOCK)
    c = jnp.arange(kw)
    dist = n_prev * Q_BLOCK + r[:, None] - c[None, :]
    k_pos = (jnp.arange(nb)[:, None] - n_prev) * Q_BLOCK + c[None, :]
    mask = ((dist >= 0) & (dist < window))[None] & (k_pos >= 0)[:, None, :]
    bias = bias_tab[rel_bucket(dist)].reshape(Q_BLOCK, kw, G, R).transpose(2, 3, 0, 1).astype(jnp.float32)
    s = jnp.einsum('bnqgrd,bnkgd->bngrqk', qb, kb).astype(jnp.float32) * D ** -0.5 + bias
    s = jnp.where(mask[:, None, None], s, NEG_INF)
    if sink is None:
        p = jax.nn.softmax(s, axis=-1)
    else:
        sk = sink.astype(jnp.float32).reshape(G, R, 1, 1)
        m = jnp.maximum(jnp.max(s, axis=-1, keepdims=True), sk)
        e = jnp.exp(s - m)
        p = e / (jnp.sum(e, axis=-1, keepdims=True) + jnp.exp(sk - m))
    o = jnp.einsum('bngrqk,bnkgd->bnqgrd', p.astype(v.dtype), vb)
    return o.reshape(B, S, H, D)


def compress_blocks(t, pos, w1, w2):
    B, S, G, D = t.shape
    nc = (S - CMP_BLOCK) // CMP_STRIDE + 1
    idx = jnp.arange(nc)[:, None] * CMP_STRIDE + jnp.arange(CMP_BLOCK)[None, :]
    blocks = t[:, idx] + pos[None, None, :, None, :]
    flat = blocks.transpose(0, 1, 3, 2, 4).reshape(B, nc, G, CMP_BLOCK * D)
    return jax.nn.gelu(flat @ w1) @ w2


def nsa_attention(q, kc, vc, ks, vs, kw, vw, gates, bias_tab):
    B, S, H, D = q.shape
    G = ks.shape[2]
    R = H // G
    nc = kc.shape[1]
    scale = D ** -0.5
    qg = q.reshape(B, S, G, R, D)
    t_pos = jnp.arange(S)

    c_start = jnp.arange(nc) * CMP_STRIDE
    cmask = (c_start + CMP_BLOCK - 1)[None, :] <= t_pos[:, None]
    s = jnp.einsum('bsgrd,bcgd->bgrsc', qg, kc).astype(jnp.float32) * scale
    p_cmp = jnp.where(cmask, jax.nn.softmax(jnp.where(cmask, s, NEG_INF), axis=-1), 0.0)
    o_cmp = jnp.einsum('bgrsc,bcgd->bsgrd', p_cmp.astype(vc.dtype), vc).reshape(B, S, H, D)

    n_blk = S // SEL_BLOCK
    j_start = jnp.arange(n_blk) * SEL_BLOCK
    overlap = ((c_start[:, None] < j_start[None, :] + SEL_BLOCK)
               & (c_start[:, None] + CMP_BLOCK > j_start[None, :])).astype(jnp.float32)
    imp = jnp.einsum('bgrsc,cj->bgsj', p_cmp, overlap)
    cur = t_pos // SEL_BLOCK
    jj = jnp.arange(n_blk)
    valid = j_start[None, :] <= t_pos[:, None]
    forced = (jj[None, :] == 0) | (jj[None, :] == cur[:, None]) | (jj[None, :] == cur[:, None] - 1)
    score = jnp.where(valid, imp + jnp.where(forced, FORCE_BONUS, 0.0), NEG_INF)
    n_sel = min(N_SELECT, n_blk)
    _, sel_idx = lax.top_k(score, n_sel)

    kbk = ks.reshape(B, n_blk, SEL_BLOCK, G, D).transpose(0, 3, 1, 2, 4)
    vbk = vs.reshape(B, n_blk, SEL_BLOCK, G, D).transpose(0, 3, 1, 2, 4)
    nqb = S // SEL_Q_BLOCK
    qs = qg.reshape(B, nqb, SEL_Q_BLOCK, G, R, D).transpose(1, 0, 2, 3, 4, 5)
    idx_b = sel_idx.reshape(B, G, nqb, SEL_Q_BLOCK, n_sel).transpose(2, 0, 1, 3, 4)
    bi = jnp.arange(B)[:, None, None, None]
    gi = jnp.arange(G)[None, :, None, None]
    bias_g = bias_tab.reshape(NUM_BUCKETS, G, R).transpose(1, 0, 2)

    def sel_block(args):
        i, qi, ii = args
        kg = kbk[bi, gi, ii]
        vg = vbk[bi, gi, ii].reshape(B, G, SEL_Q_BLOCK, n_sel * SEL_BLOCK, D)
        q_pos = i * SEL_Q_BLOCK + jnp.arange(SEL_Q_BLOCK)
        k_pos = (ii[..., None] * SEL_BLOCK + jnp.arange(SEL_BLOCK)).reshape(B, G, SEL_Q_BLOCK, n_sel * SEL_BLOCK)
        dist = q_pos[None, None, :, None] - k_pos
        mask = dist >= 0
        bias = bias_g[gi, rel_bucket(dist)].transpose(0, 1, 4, 2, 3).astype(jnp.float32)
        s = jnp.einsum('bqgrd,bgqnkd->bgrqnk', qi, kg).reshape(B, G, R, SEL_Q_BLOCK, n_sel * SEL_BLOCK)
        s = s.astype(jnp.float32) * scale + bias
        p = jax.nn.softmax(jnp.where(mask[:, :, None], s, NEG_INF), axis=-1)
        return jnp.einsum('bgrqk,bgqkd->bqgrd', p.astype(vg.dtype), vg)

    o_sel = lax.map(sel_block, (jnp.arange(nqb), qs, idx_b))
    o_sel = o_sel.transpose(1, 0, 2, 3, 4, 5).reshape(B, S, H, D)

    o_win = banded_attention(q, kw, vw, bias_tab, C_WINDOW)

    g = jax.nn.sigmoid(gates.astype(jnp.float32)).astype(q.dtype)
    out = g[..., 0:1] * o_cmp + g[..., 1:2] * o_sel + g[..., 2:3] * o_win
    return out.reshape(B, S, H * D)


def setup_inputs(seed: int = 0) -> dict:
    key = jax.random.key(seed)
    ks = jax.random.split(key, 17)

    def nrm(k, shape, scale):
        return jax.random.normal(k, shape, jnp.float32) * scale

    return {
        'x': nrm(ks[0], (BATCH, SEQ, D_MODEL), 1.0),
        'w_in': nrm(ks[1], (DEPTH, D_MODEL, IN_COLS), D_MODEL ** -0.5),
        'qk_gain': 1.0 + nrm(ks[2], (DEPTH, 8, HEAD_DIM), 0.1),
        'diff_lambda': nrm(ks[3], (DEPTH, 4, HEAD_DIM), 0.1),
        'diff_subln': 1.0 + nrm(ks[4], (DEPTH, A_VDIM), 0.1),
        'sinks': nrm(ks[5], (DEPTH, B_HEADS), 0.5),
        'cmp_pos': nrm(ks[6], (DEPTH, 2, CMP_BLOCK, HEAD_DIM), 0.5),
        'cmp_w1': nrm(ks[7], (DEPTH, 2, CMP_BLOCK * HEAD_DIM, CMP_HIDDEN), (CMP_BLOCK * HEAD_DIM) ** -0.5),
        'cmp_w2': nrm(ks[8], (DEPTH, 2, CMP_HIDDEN, HEAD_DIM), CMP_HIDDEN ** -0.5),
        'w_branch': nrm(ks[9], (DEPTH, N_BRANCH, MIX_WIDTH, D_MODEL), MIX_WIDTH ** -0.5),
        'w_out': nrm(ks[10], (DEPTH, D_MODEL, D_MODEL), D_MODEL ** -0.5),
        'norm_mix': 1.0 + nrm(ks[11], (DEPTH, D_MODEL), 0.1),
        'norm_mlp': 1.0 + nrm(ks[12], (DEPTH, D_MODEL), 0.1),
        'w_up': nrm(ks[13], (DEPTH, D_MODEL, D_FF), D_MODEL ** -0.5),
        'w_down': nrm(ks[14], (DEPTH, D_FF, D_MODEL), D_FF ** -0.5),
        'rel_bias': nrm(ks[15], (NUM_BUCKETS, TOTAL_HEADS), 0.5),
    }


def reference(x, w_in, qk_gain, diff_lambda, diff_subln, sinks, cmp_pos, cmp_w1, cmp_w2,
              w_branch, w_out, norm_mix, norm_mlp, w_up, w_down, rel_bias):
    B, S, _ = x.shape
    points = []
    acc = 0
    for size in SPLIT_SIZES[:-1]:
        acc += size
        points.append(acc)
    bias_a = rel_bias[:, :A_HEADS]
    bias_b = rel_bias[:, A_HEADS:A_HEADS + B_HEADS]
    bias_c = rel_bias[:, A_HEADS + B_HEADS:]

    for layer in range(DEPTH):
        h = rms_norm(x, norm_mix[layer])
        proj = h @ w_in[layer]
        aq, ak, av, bq, bk, bv, cq, ckv, cg, mg = jnp.split(proj, points, axis=-1)
        gains = qk_gain[layer]

        aq = rms_norm(aq.reshape(B, S, A_HEADS, 2, HEAD_DIM), gains[0])
        ak = rms_norm(ak.reshape(B, S, A_HEADS, 2, HEAD_DIM), gains[1])
        av = av.reshape(B, S, A_HEADS, A_VDIM)
        lmb = diff_lambda[layer].astype(jnp.float32)
        lam_init = 0.8 - 0.6 * math.exp(-0.3 * layer)
        lam = jnp.exp(jnp.sum(lmb[0] * lmb[1])) - jnp.exp(jnp.sum(lmb[2] * lmb[3])) + lam_init
        oa = diff_attention(aq, ak, av, lam, bias_a)
        oa = (rms_norm(oa, diff_subln[layer]) * (1.0 - lam_init)).reshape(B, S, MIX_WIDTH)

        bq = rms_norm(bq.reshape(B, S, B_HEADS, HEAD_DIM), gains[2])
        bk = rms_norm(bk.reshape(B, S, B_KV_HEADS, HEAD_DIM), gains[3])
        bv = bv.reshape(B, S, B_KV_HEADS, HEAD_DIM)
        ob = banded_attention(bq, bk, bv, bias_b, B_WINDOW, sinks[layer]).reshape(B, S, MIX_WIDTH)

        cq = rms_norm(cq.reshape(B, S, C_HEADS, HEAD_DIM), gains[4])
        ckv = ckv.reshape(B, S, 6, C_KV_HEADS, HEAD_DIM)
        kc = rms_norm(compress_blocks(ckv[:, :, 0], cmp_pos[layer, 0], cmp_w1[layer, 0], cmp_w2[layer, 0]), gains[5])
        vc = compress_blocks(ckv[:, :, 1], cmp_pos[layer, 1], cmp_w1[layer, 1], cmp_w2[layer, 1])
        ksel = rms_norm(ckv[:, :, 2], gains[6])
        kwin = rms_norm(ckv[:, :, 4], gains[7])
        oc = nsa_attention(cq, kc, vc, ksel, ckv[:, :, 3], kwin, ckv[:, :, 5],
                           cg.reshape(B, S, C_HEADS, 3), bias_c)

        branches = jnp.stack([oa, ob, oc], axis=0)
        y = jnp.einsum('nbsm,nmd->bsnd', branches, w_branch[layer])
        gate = jax.nn.sigmoid(mg.reshape(B, S, N_BRANCH, D_MODEL).astype(jnp.float32)).astype(y.dtype)
        x = x + jnp.sum(gate * y, axis=2) @ w_out[layer]

        h = rms_norm(x, norm_mlp[layer])
        x = x + jnp.square(jax.nn.relu(h @ w_up[layer])) @ w_down[layer]
    return x
```

```cpp
#include <hip/hip_runtime.h>
#include <hip/hip_cooperative_groups.h>
#include <cstdio>
namespace cg = cooperative_groups;

typedef unsigned short bf16_t;
using bf16x8 = __attribute__((ext_vector_type(8))) short;
using f32x16 = __attribute__((ext_vector_type(16))) float;
using u32x4 = __attribute__((ext_vector_type(4))) unsigned;
#define DI __device__ __forceinline__
#define MFMA32(a, b, c) __builtin_amdgcn_mfma_f32_32x32x16_bf16((a), (b), (c), 0, 0, 0)

constexpr int S_ = 4096, T_ = 16384, NL = 4;
constexpr int NIN = 6680, NINP = 6912;
constexpr int LDS_BYTES = 147456;
constexpr int NTHR = 512;
constexpr int LDT = 72;
constexpr int LDK1 = 1088, LDK4 = 4160;
constexpr int WT_E = 256 * LDT;

constexpr size_t SZ_WIN = (size_t)NINP * LDK1 * 2;
constexpr size_t SZ_WBR = (size_t)3 * 1024 * 512 * 2;
constexpr size_t SZ_WO = (size_t)1024 * LDK1 * 2;
constexpr size_t SZ_WUP = (size_t)4096 * LDK1 * 2;
constexpr size_t SZ_WDN = (size_t)1024 * LDK4 * 2;
constexpr size_t SZ_W1 = (size_t)2 * 256 * 2048 * 2;
constexpr size_t SZ_W2 = (size_t)2 * 128 * 256 * 2;
constexpr size_t O_WIN = 0;
constexpr size_t O_WBR = O_WIN + NL * SZ_WIN;
constexpr size_t O_WO = O_WBR + NL * SZ_WBR;
constexpr size_t O_WUP = O_WO + NL * SZ_WO;
constexpr size_t O_WDN = O_WUP + NL * SZ_WUP;
constexpr size_t O_W1 = O_WDN + NL * SZ_WDN;
constexpr size_t O_W2 = O_W1 + NL * SZ_W1;
constexpr size_t O_POSW1 = O_W2 + NL * SZ_W2;
constexpr size_t O_LAM = O_POSW1 + (size_t)NL * 2 * 256 * 4;
constexpr size_t O_TABS = O_LAM + 256;
constexpr size_t O_PART = O_TABS + 20 * 132 * 4 + 192;
constexpr size_t O_XB = ((O_PART + (size_t)T_ * 16 * 4 + 255) / 256) * 256;
constexpr size_t O_ACT = O_XB + (size_t)T_ * LDK1 * 2;
constexpr size_t O_AQ = O_ACT;
constexpr size_t O_BQ = O_AQ + (size_t)T_ * 512 * 2;
constexpr size_t O_CQ = O_BQ + (size_t)T_ * 512 * 2;
constexpr size_t O_AK = O_CQ + (size_t)T_ * 512 * 2;
constexpr size_t O_AVT = O_AK + (size_t)T_ * 512 * 2;
constexpr size_t O_Z = O_AK;
constexpr size_t O_BK = O_AVT + (size_t)T_ * 512 * 2;
constexpr size_t SZ_S = (size_t)T_ * 128 * 2;
constexpr size_t O_BVT = O_BK + SZ_S;
constexpr size_t O_CK = O_BVT + SZ_S;
constexpr size_t O_CV = O_CK + SZ_S;
constexpr size_t O_KS = O_CV + SZ_S + 65536;
constexpr size_t O_VST = O_KS + SZ_S;
constexpr size_t O_KW = O_VST + SZ_S;
constexpr size_t O_VWT = O_KW + SZ_S;
constexpr size_t O_CGS = O_VWT + SZ_S;
constexpr size_t O_MGS = O_CGS + (size_t)T_ * 24 * 4;
constexpr size_t O_HID = O_MGS + (size_t)T_ * 3072 * 2;
constexpr size_t O_KC = O_HID + (size_t)16 * 256 * 256 * 2;
constexpr size_t O_VCT = O_KC + (size_t)8 * 256 * 64 * 2;
constexpr size_t O_U = O_ACT;
constexpr size_t O_BAR = O_VCT + (size_t)8 * 256 * 64 * 2;
constexpr size_t WS_END = O_BAR + 80 * 128;
static_assert(O_Z + (size_t)T_ * LDK1 * 2 <= O_CGS && O_U + (size_t)T_ * LDK4 * 2 <= O_HID, "u must fit in the aliased region");

struct P {
  const float* x; const float* w_in; const float* qk_gain; const float* diff_lambda; const float* diff_subln;
  const float* sinks; const float* cmp_pos; const float* cmp_w1; const float* cmp_w2; const float* w_branch;
  const float* w_out; const float* norm_mix; const float* norm_mlp; const float* w_up; const float* w_down;
  const float* rel_bias;
  float* out; unsigned char* ws;
};

DI int tidx() { int t = threadIdx.x; asm volatile("" : "+v"(t)); return t; }
DI bf16_t f2bf(float x) { unsigned u = __float_as_uint(x); u += 0x7fffu + ((u >> 16) & 1u); return (bf16_t)(u >> 16); }
DI float bf2f(bf16_t b) { return __uint_as_float(((unsigned)b) << 16); }
typedef float f32x2_t __attribute__((ext_vector_type(2)));
typedef __bf16 bf16x2_t __attribute__((ext_vector_type(2)));
DI unsigned pack2(float a, float b) { f32x2_t v = {a, b}; bf16x2_t r = __builtin_convertvector(v, bf16x2_t); return __builtin_bit_cast(unsigned, r); }
constexpr float LOG2E = 1.4426950408889634f;
constexpr float QSCL = 0.125f * LOG2E;
DI float ex2(float x) { return __builtin_amdgcn_exp2f(x); }
DI float sigmoidf_(float x) { return 1.f / (1.f + __expf(-x)); }
DI float xor32(float v) { return __shfl_xor(v, 32); }

DI void gemm_wide(const bf16_t* __restrict__ W, int ldw, const bf16_t* __restrict__ X, int ldx, int nkt,
                  f32x16 (&acc)[4][2], bf16_t* lds) {
  const int tid = tidx(), lane = tid & 63, wv = tid >> 6, wn = wv & 1, wm = wv >> 1;
  const int lr = lane & 31, lh = lane >> 5;
  const int lrow = tid >> 3, lkc = (tid & 7) * 8;
  const bf16_t* wp = W + (size_t)lrow * ldw + lkc;
  const bf16_t* xp = X + (size_t)lrow * ldx + lkc;
  const size_t wst = (size_t)64 * ldw, xst = (size_t)64 * ldx;
  u32x4 rw0, rw1, rw2, rw3, rx0, rx1, rx2, rx3;
#define GW_GLOAD(KT) { const size_t ko_ = (size_t)(KT) * 64; \
    rw0 = *(const u32x4*)(wp + ko_); rw1 = *(const u32x4*)(wp + wst + ko_); \
    rw2 = *(const u32x4*)(wp + 2 * wst + ko_); rw3 = *(const u32x4*)(wp + 3 * wst + ko_); \
    rx0 = *(const u32x4*)(xp + ko_); rx1 = *(const u32x4*)(xp + xst + ko_); \
    rx2 = *(const u32x4*)(xp + 2 * xst + ko_); rx3 = *(const u32x4*)(xp + 3 * xst + ko_); }
#define GW_LSTORE(BUF) { bf16_t* wb_ = lds + (BUF) * 2 * WT_E + lrow * LDT + lkc; bf16_t* xb_ = wb_ + WT_E; \
    *(u32x4*)(wb_) = rw0; *(u32x4*)(wb_ + 64 * LDT) = rw1; *(u32x4*)(wb_ + 128 * LDT) = rw2; *(u32x4*)(wb_ + 192 * LDT) = rw3; \
    *(u32x4*)(xb_) = rx0; *(u32x4*)(xb_ + 64 * LDT) = rx1; *(u32x4*)(xb_ + 128 * LDT) = rx2; *(u32x4*)(xb_ + 192 * LDT) = rx3; }
  u32x4 sw0, sw1, sw2, sw3, sx0, sx1, sx2, sx3;
#define GW_GLOAD_B(KT) { const size_t ko_ = (size_t)(KT) * 64; \
    sw0 = *(const u32x4*)(wp + ko_); sw1 = *(const u32x4*)(wp + wst + ko_); \
    sw2 = *(const u32x4*)(wp + 2 * wst + ko_); sw3 = *(const u32x4*)(wp + 3 * wst + ko_); \
    sx0 = *(const u32x4*)(xp + ko_); sx1 = *(const u32x4*)(xp + xst + ko_); \
    sx2 = *(const u32x4*)(xp + 2 * xst + ko_); sx3 = *(const u32x4*)(xp + 3 * xst + ko_); }
#define GW_LSTORE_B(BUF) { bf16_t* wb_ = lds + (BUF) * 2 * WT_E + lrow * LDT + lkc; bf16_t* xb_ = wb_ + WT_E; \
    *(u32x4*)(wb_) = sw0; *(u32x4*)(wb_ + 64 * LDT) = sw1; *(u32x4*)(wb_ + 128 * LDT) = sw2; *(u32x4*)(wb_ + 192 * LDT) = sw3; \
    *(u32x4*)(xb_) = sx0; *(u32x4*)(xb_ + 64 * LDT) = sx1; *(u32x4*)(xb_ + 128 * LDT) = sx2; *(u32x4*)(xb_ + 192 * LDT) = sx3; }
#define GW_KS(KT, ks) { \
      const bf16_t* wb = lds + ((KT) & 1) * 2 * WT_E + (wn * 128 + lr) * LDT + lh * 8; \
      const bf16_t* xb = lds + ((KT) & 1) * 2 * WT_E + WT_E + (wm * 64 + lr) * LDT + lh * 8; \
      const bf16x8 b0 = *(const bf16x8*)(xb + (ks) * 16), b1 = *(const bf16x8*)(xb + 32 * LDT + (ks) * 16); \
      const bf16x8 a0 = *(const bf16x8*)(wb + (ks) * 16), a1 = *(const bf16x8*)(wb + 32 * LDT + (ks) * 16); \
      const bf16x8 a2 = *(const bf16x8*)(wb + 64 * LDT + (ks) * 16), a3 = *(const bf16x8*)(wb + 96 * LDT + (ks) * 16); \
      acc[0][0] = MFMA32(a0, b0, acc[0][0]); acc[0][1] = MFMA32(a0, b1, acc[0][1]); \
      acc[1][0] = MFMA32(a1, b0, acc[1][0]); acc[1][1] = MFMA32(a1, b1, acc[1][1]); \
      acc[2][0] = MFMA32(a2, b0, acc[2][0]); acc[2][1] = MFMA32(a2, b1, acc[2][1]); \
      acc[3][0] = MFMA32(a3, b0, acc[3][0]); acc[3][1] = MFMA32(a3, b1, acc[3][1]); }
#define GW_ST2(BUF, OFF, R0, R1) { bf16_t* d_ = lds + (BUF) * 2 * WT_E + (OFF) + lrow * LDT + lkc; \
      *(u32x4*)(d_) = R0; *(u32x4*)(d_ + 64 * LDT) = R1; }
  __syncthreads();
  GW_GLOAD(0)
  GW_LSTORE(0)
  GW_GLOAD(1)
  GW_GLOAD_B(nkt > 2 ? 2 : nkt - 1)
  __syncthreads();
  for (int kt = 0; kt < nkt; kt += 2) {
    __builtin_amdgcn_sched_barrier(0);
    GW_ST2(1, 0, rw0, rw1)                         GW_KS(kt, 0)
    GW_ST2(1, 128 * LDT, rw2, rw3)                 GW_KS(kt, 1)
    GW_ST2(1, WT_E, rx0, rx1)                      GW_KS(kt, 2)
    GW_ST2(1, WT_E + 128 * LDT, rx2, rx3)          GW_KS(kt, 3)
    __builtin_amdgcn_sched_barrier(0);
    GW_GLOAD(kt + 3 < nkt ? kt + 3 : nkt - 1)
    __syncthreads();
    __builtin_amdgcn_sched_barrier(0);
    GW_ST2(0, 0, sw0, sw1)                         GW_KS(kt + 1, 0)
    GW_ST2(0, 128 * LDT, sw2, sw3)                 GW_KS(kt + 1, 1)
    GW_ST2(0, WT_E, sx0, sx1)                      GW_KS(kt + 1, 2)
    GW_ST2(0, WT_E + 128 * LDT, sx2, sx3)          GW_KS(kt + 1, 3)
    __builtin_amdgcn_sched_barrier(0);
    GW_GLOAD_B(kt + 4 < nkt ? kt + 4 : nkt - 1)
    __syncthreads();
  }
#undef GW_KS
#undef GW_ST2
#undef GW_GLOAD_B
#undef GW_LSTORE_B
#undef GW_GLOAD
#undef GW_LSTORE
}

constexpr int MID_E = (128 + 256) * LDT;
DI void gemm_mid(const bf16_t* __restrict__ W, int ldw, const bf16_t* __restrict__ X, size_t ldx, int mclamp, int kts,
                 int nkt, int m0, f32x16 (&acc)[2][2], bf16_t* lds) {
  const int tid = tidx(), lane = tid & 63, wv = tid >> 6, wn = wv & 1, wm = wv >> 1;
  const int lr = lane & 31, lh = lane >> 5;
  const int lrow = tid >> 3, lkc = (tid & 7) * 8;
  const bf16_t* wp = W + (size_t)lrow * ldw + lkc;
  const size_t wst = (size_t)64 * ldw;
  const bf16_t *xp0, *xp1, *xp2, *xp3;
  { int m;
    m = m0 + lrow;       m = m < mclamp ? m : mclamp; xp0 = X + (size_t)m * ldx + lkc;
    m = m0 + lrow + 64;  m = m < mclamp ? m : mclamp; xp1 = X + (size_t)m * ldx + lkc;
    m = m0 + lrow + 128; m = m < mclamp ? m : mclamp; xp2 = X + (size_t)m * ldx + lkc;
    m = m0 + lrow + 192; m = m < mclamp ? m : mclamp; xp3 = X + (size_t)m * ldx + lkc; }
  u32x4 rw0, rw1, rx0, rx1, rx2, rx3;
#define GM_GLOAD(KT) { \
    rw0 = *(const u32x4*)(wp + (size_t)(KT) * 64); rw1 = *(const u32x4*)(wp + wst + (size_t)(KT) * 64); \
    rx0 = *(const u32x4*)(xp0 + (size_t)(KT) * kts); rx1 = *(const u32x4*)(xp1 + (size_t)(KT) * kts); \
    rx2 = *(const u32x4*)(xp2 + (size_t)(KT) * kts); rx3 = *(const u32x4*)(xp3 + (size_t)(KT) * kts); }
#define GM_LSTORE(BUF) { bf16_t* wb_ = lds + (BUF) * MID_E + lrow * LDT + lkc; bf16_t* xb_ = wb_ + 128 * LDT; \
    *(u32x4*)(wb_) = rw0; *(u32x4*)(wb_ + 64 * LDT) = rw1; \
    *(u32x4*)(xb_) = rx0; *(u32x4*)(xb_ + 64 * LDT) = rx1; *(u32x4*)(xb_ + 128 * LDT) = rx2; *(u32x4*)(xb_ + 192 * LDT) = rx3; }
  __syncthreads();
  GM_GLOAD(0)
  GM_LSTORE(0)
  __syncthreads();
  for (int kt = 0; kt < nkt; ++kt) {
    const bool more = kt + 1 < nkt;
    if (more) GM_GLOAD(kt + 1)
    __builtin_amdgcn_sched_barrier(0);
    {
      const bf16_t* wb = lds + (kt & 1) * MID_E + (wn * 64 + lr) * LDT + lh * 8;
      const bf16_t* xb = lds + (kt & 1) * MID_E + 128 * LDT + (wm * 64 + lr) * LDT + lh * 8;
#pragma unroll
      for (int ks = 0; ks < 4; ++ks) {
        const bf16x8 a0 = *(const bf16x8*)(wb + ks * 16), a1 = *(const bf16x8*)(wb + 32 * LDT + ks * 16);
        const bf16x8 b0 = *(const bf16x8*)(xb + ks * 16), b1 = *(const bf16x8*)(xb + 32 * LDT + ks * 16);
        acc[0][0] = MFMA32(a0, b0, acc[0][0]); acc[0][1] = MFMA32(a0, b1, acc[0][1]);
        acc[1][0] = MFMA32(a1, b0, acc[1][0]); acc[1][1] = MFMA32(a1, b1, acc[1][1]);
      }
    }
    __builtin_amdgcn_sched_barrier(0);
    if (more) GM_LSTORE((kt + 1) & 1)
    __syncthreads();
  }
#undef GM_GLOAD
#undef GM_LSTORE
}

DI void zero_acc(f32x16 (&acc)[2][2]) {
#pragma unroll
  for (int a = 0; a < 2; ++a)
#pragma unroll
    for (int b = 0; b < 2; ++b)
#pragma unroll
      for (int i = 0; i < 16; ++i) acc[a][b][i] = 0.f;
}
DI void zero_acc8(f32x16 (&acc)[4][2]) {
#pragma unroll
  for (int a = 0; a < 4; ++a)
#pragma unroll
    for (int b = 0; b < 2; ++b)
#pragma unroll
      for (int i = 0; i < 16; ++i) acc[a][b][i] = 0.f;
}

DI const float* tile_rstd(const float* __restrict__ part, int m0, bf16_t* sm) {
  float* rs = (float*)((unsigned char*)sm + 139264);
  const int tid = tidx();
  if (tid < 256) {
    const float4* p4 = (const float4*)(part + (size_t)(m0 + tid) * 16);
    float s = 0.f;
#pragma unroll
    for (int i = 0; i < 4; ++i) { float4 v = p4[i]; s += v.x + v.y + v.z + v.w; }
    rs[tid] = rsqrtf(s * (1.f / 1024.f) + 1e-6f);
  }
  __syncthreads();
  return rs;
}
DI float row_rstd(const float* __restrict__ part, int m) {
  const float4* p4 = (const float4*)(part + (size_t)m * 16);
  float s = 0.f;
#pragma unroll
  for (int i = 0; i < 4; ++i) { float4 v = p4[i]; s += v.x + v.y + v.z + v.w; }
  return rsqrtf(s * (1.f / 1024.f) + 1e-6f);
}

struct Geo { int xcd, loc, nloc; };
struct TileWalk {
  int xcd, loc, nloc, ng, NT, g, i;
  DI TileWalk(int NT_, const Geo& ge) : xcd(ge.xcd), loc(ge.loc), nloc(ge.nloc), ng((NT_ + 7) >> 3), NT(NT_), g(0), i(ge.loc) {}
  DI bool next(int& mt, int& nt) {
    for (;;) {
      if (g >= ng) return false;
      if (i >= 64) { i = loc; ++g; continue; }
      mt = xcd * 8 + (i & 7); nt = g * 8 + (i >> 3);
      i += nloc;
      if (nt < NT) return true;
    }
  }
};

DI int next_task(unsigned* ctr, bf16_t* sm) {
  volatile int* slot = (volatile int*)((unsigned char*)sm + LDS_BYTES - 16);
  __syncthreads();
  if (threadIdx.x == 0) *slot = (int)__hip_atomic_fetch_add(ctr, 1u, __ATOMIC_RELAXED, __HIP_MEMORY_SCOPE_AGENT);
  __syncthreads();
  return __builtin_amdgcn_readfirstlane(*slot);
}

DI void tr_tile(const float* __restrict__ src, int ldS, int C, int r0, int c0, bf16_t* __restrict__ dst, int ldd,
                const float* __restrict__ g, int remap, float* tl) {
  const int tid = tidx() & 255;
  __syncthreads();
  {
    const int c4 = (tid & 15) * 4;
#pragma unroll
    for (int i = 0; i < 4; ++i) {
      const int r = (tid >> 4) + 16 * i;
      float4 v = make_float4(0.f, 0.f, 0.f, 0.f);
      if (c0 + c4 < C) {
        v = *(const float4*)(src + (size_t)(r0 + r) * ldS + c0 + c4);
        if (g) { const float gg = g[r0 + r]; v.x *= gg; v.y *= gg; v.z *= gg; v.w *= gg; }
      }
      float* t4 = tl + r * 65 + c4;
      t4[0] = v.x; t4[1] = v.y; t4[2] = v.z; t4[3] = v.w;
    }
  }
  __syncthreads();
  {
    const int c = tid >> 2, rq = (tid & 3) * 16;
    if (c0 + c < C) {
      int dr = c0 + c;
      if (remap) { if (dr >= 3608) dr -= 24; else if (dr >= 3584) dr += 6656 - 3584; }
      unsigned w[8];
#pragma unroll
      for (int k = 0; k < 8; ++k) w[k] = pack2(tl[(rq + 2 * k) * 65 + c], tl[(rq + 2 * k + 1) * 65 + c]);
      uint4* d4 = (uint4*)(dst + (size_t)dr * ldd + r0 + rq);
      d4[0] = make_uint4(w[0], w[1], w[2], w[3]);
      d4[1] = make_uint4(w[4], w[5], w[6], w[7]);
    }
  }
}

DI void tr_tile_wave(const float* __restrict__ src, int ldS, int C, int r0, int c0, bf16_t* __restrict__ dst, int ldd,
                     const float* __restrict__ g, int remap, float* tl) {
  const int lane = tidx() & 63;
  {
    const int c4 = (lane & 15) * 4;
    float4 v[16];
#pragma unroll
    for (int i = 0; i < 16; ++i) {
      const int r = (lane >> 4) + 4 * i;
      v[i] = make_float4(0.f, 0.f, 0.f, 0.f);
      if (c0 + c4 < C) v[i] = *(const float4*)(src + (size_t)(r0 + r) * ldS + c0 + c4);
    }
#pragma unroll
    for (int i = 0; i < 16; ++i) {
      const int r = (lane >> 4) + 4 * i;
      const float gg = g ? g[r0 + r] : 1.f;
      float* t4 = tl + r * 65 + c4;
      t4[0] = v[i].x * gg; t4[1] = v[i].y * gg; t4[2] = v[i].z * gg; t4[3] = v[i].w * gg;
    }
  }
  __builtin_amdgcn_fence(__ATOMIC_RELEASE, "wavefront");
  __builtin_amdgcn_wave_barrier();
#pragma unroll
  for (int j = 0; j < 4; ++j) {
    const int c = (lane >> 2) + 16 * j, rq = (lane & 3) * 16;
    if (c0 + c < C) {
      int dr = c0 + c;
      if (remap) { if (dr >= 3608) dr -= 24; else if (dr >= 3584) dr += 6656 - 3584; }
      unsigned w[8];
#pragma unroll
      for (int k = 0; k < 8; ++k) w[k] = pack2(tl[(rq + 2 * k) * 65 + c], tl[(rq + 2 * k + 1) * 65 + c]);
      uint4* d4 = (uint4*)(dst + (size_t)dr * ldd + r0 + rq);
      d4[0] = make_uint4(w[0], w[1], w[2], w[3]);
      d4[1] = make_uint4(w[4], w[5], w[6], w[7]);
    }
  }
  __builtin_amdgcn_wave_barrier();
}

DI void phase0(const P& p, bf16_t* sm) {
  const int tid5 = tidx(), half = tid5 >> 8, tid = tid5 & 255, lane = tid5 & 63, wv8 = tid5 >> 6;
  float* tl = (float*)sm + half * (64 * 65);
  constexpr int NTR_L = 1680 + 384 + 256 + 1024 + 1024 + 256 + 8;
  {
    float* tlw = (float*)sm + wv8 * (64 * 65);
    for (int t = blockIdx.x * 8 + wv8; t < NTR_L * NL; t += gridDim.x * 8) {
      const int layer = t / NTR_L; int r = t % NTR_L;
      if (r < 1680) {
        tr_tile_wave(p.w_in + (size_t)layer * 1024 * NIN, NIN, NIN, (r / 105) * 64, (r % 105) * 64,
                     (bf16_t*)(p.ws + O_WIN + layer * SZ_WIN), LDK1, p.norm_mix + layer * 1024, 1, tlw);
      } else if ((r -= 1680) < 384) {
        const int n3 = r / 128; r %= 128;
        tr_tile_wave(p.w_branch + ((size_t)layer * 3 + n3) * 512 * 1024, 1024, 1024, (r / 16) * 64, (r % 16) * 64,
                     (bf16_t*)(p.ws + O_WBR + layer * SZ_WBR) + (size_t)n3 * 1024 * 512, 512, nullptr, 0, tlw);
      } else if ((r -= 384) < 256) {
        tr_tile_wave(p.w_out + (size_t)layer * 1024 * 1024, 1024, 1024, (r / 16) * 64, (r % 16) * 64,
                     (bf16_t*)(p.ws + O_WO + layer * SZ_WO), LDK1, nullptr, 0, tlw);
      } else if ((r -= 256) < 1024) {
        tr_tile_wave(p.w_up + (size_t)layer * 1024 * 4096, 4096, 4096, (r / 64) * 64, (r % 64) * 64,
                     (bf16_t*)(p.ws + O_WUP + layer * SZ_WUP), LDK1, p.norm_mlp + layer * 1024, 0, tlw);
      } else if ((r -= 1024) < 1024) {
        tr_tile_wave(p.w_down + (size_t)layer * 4096 * 1024, 1024, 1024, (r / 16) * 64, (r % 16) * 64,
                     (bf16_t*)(p.ws + O_WDN + layer * SZ_WDN), LDK4, nullptr, 0, tlw);
      } else if ((r -= 1024) < 256) {
        const int kv = r / 128; r %= 128;
        tr_tile_wave(p.cmp_w1 + ((size_t)layer * 2 + kv) * 2048 * 256, 256, 256, (r / 4) * 64, (r % 4) * 64,
                     (bf16_t*)(p.ws + O_W1 + layer * SZ_W1) + (size_t)kv * 256 * 2048, 2048, nullptr, 0, tlw);
      } else {
        r -= 256;
        const int kv = r / 4; r %= 4;
        tr_tile_wave(p.cmp_w2 + ((size_t)layer * 2 + kv) * 256 * 64, 64, 64, r * 64, 0,
                     (bf16_t*)(p.ws + O_W2 + layer * SZ_W2) + (size_t)kv * 128 * 256, 256, nullptr, 0, tlw);
      }
    }
    __syncthreads();
  }
  constexpr int J_TR = 0;
  constexpr int J_X = J_TR + T_ / 8;
  constexpr int J_POS = J_X + 32;
  constexpr int J_MISC = J_POS + 1;
  constexpr int ZW_PER = ((NINP - NIN) * LDK1 / 8 + 511) / 512;
  constexpr int J_ZW = J_MISC + NL * ZW_PER;
  constexpr int J_ZW2 = J_ZW + 32;
  for (int job = blockIdx.x; job < J_ZW2; job += gridDim.x) {
    if (job < J_TR) {
      const int t = job * 2 + half;
      const int layer = t / NTR_L; int r = t % NTR_L;
      if (r < 1680) {
        tr_tile(p.w_in + (size_t)layer * 1024 * NIN, NIN, NIN, (r / 105) * 64, (r % 105) * 64,
                (bf16_t*)(p.ws + O_WIN + layer * SZ_WIN), LDK1, p.norm_mix + layer * 1024, 1, tl);
      } else if ((r -= 1680) < 384) {
        const int n3 = r / 128; r %= 128;
        tr_tile(p.w_branch + ((size_t)layer * 3 + n3) * 512 * 1024, 1024, 1024, (r / 16) * 64, (r % 16) * 64,
                (bf16_t*)(p.ws + O_WBR + layer * SZ_WBR) + (size_t)n3 * 1024 * 512, 512, nullptr, 0, tl);
      } else if ((r -= 384) < 256) {
        tr_tile(p.w_out + (size_t)layer * 1024 * 1024, 1024, 1024, (r / 16) * 64, (r % 16) * 64,
                (bf16_t*)(p.ws + O_WO + layer * SZ_WO), LDK1, nullptr, 0, tl);
      } else if ((r -= 256) < 1024) {
        tr_tile(p.w_up + (size_t)layer * 1024 * 4096, 4096, 4096, (r / 64) * 64, (r % 64) * 64,
                (bf16_t*)(p.ws + O_WUP + layer * SZ_WUP), LDK1, p.norm_mlp + layer * 1024, 0, tl);
      } else if ((r -= 1024) < 1024) {
        tr_tile(p.w_down + (size_t)layer * 4096 * 1024, 1024, 1024, (r / 16) * 64, (r % 16) * 64,
                (bf16_t*)(p.ws + O_WDN + layer * SZ_WDN), LDK4, nullptr, 0, tl);
      } else if ((r -= 1024) < 256) {
        const int kv = r / 128; r %= 128;
        tr_tile(p.cmp_w1 + ((size_t)layer * 2 + kv) * 2048 * 256, 256, 256, (r / 4) * 64, (r % 4) * 64,
                (bf16_t*)(p.ws + O_W1 + layer * SZ_W1) + (size_t)kv * 256 * 2048, 2048, nullptr, 0, tl);
      } else {
        r -= 256;
        const int kv = r / 4; r %= 4;
        tr_tile(p.cmp_w2 + ((size_t)layer * 2 + kv) * 256 * 64, 64, 64, r * 64, 0,
                (bf16_t*)(p.ws + O_W2 + layer * SZ_W2) + (size_t)kv * 128 * 256, 256, nullptr, 0, tl);
      }
    } else if (job < J_X) {
      const int row = (job - J_TR) * 8 + wv8;
      const float4* src = (const float4*)(p.x + (size_t)row * 1024);
      bf16_t* xb = (bf16_t*)(p.ws + O_XB) + (size_t)row * LDK1;
      float ss = 0.f;
#pragma unroll
      for (int i = 0; i < 4; ++i) {
        float4 v = src[lane + 64 * i];
        ss += v.x * v.x + v.y * v.y + v.z * v.z + v.w * v.w;
        *(uint2*)(xb + (lane + 64 * i) * 4) = make_uint2(pack2(v.x, v.y), pack2(v.z, v.w));
      }
#pragma unroll
      for (int o = 32; o >= 1; o >>= 1) ss += __shfl_xor(ss, o);
      float* part = (float*)(p.ws + O_PART) + (size_t)row * 16;
      if (lane < 16) part[lane] = lane == 0 ? ss : 0.f;
    } else if (job < J_POS) {
      const int jj = (job - J_X) * 2 + half; const int lk = jj >> 3, ng = jj & 7;
      const int col = ng * 32 + (tid & 31), ksl = tid >> 5;
      const float* pos = p.cmp_pos + (size_t)lk * 2048;
      const float* w1 = p.cmp_w1 + (size_t)lk * 2048 * 256;
      float s = 0.f;
      for (int k = ksl * 256; k < ksl * 256 + 256; ++k) s += pos[k] * w1[(size_t)k * 256 + col];
      __syncthreads();
      tl[tid] = s;
      __syncthreads();
      if (tid < 32) {
        float t = 0.f;
        for (int q = 0; q < 8; ++q) t += tl[q * 32 + tid];
        ((float*)(p.ws + O_POSW1))[lk * 256 + col] = t;
      }
    } else if (job < J_MISC) {
      float* tabs = (float*)(p.ws + O_TABS);
      for (int i = tid5; i < 20 * 129; i += NTHR) {
        const int h = i / 129, d = i % 129;
        int bk;
        if (d < 16) bk = d;
        else { bk = 16 + (int)(logf((float)d / 16.f) / 2.0794415416798357f * 16.f); if (bk > 31) bk = 31; }
        tabs[h * 132 + d] = p.rel_bias[bk * 20 + h] * LOG2E;
      }
      if (wv8 == 0) {
        for (int layer = 0; layer < NL; ++layer) {
          const float* lm = p.diff_lambda + layer * 256;
          float a = lm[lane] * lm[64 + lane], b = lm[128 + lane] * lm[192 + lane];
#pragma unroll
          for (int o = 32; o >= 1; o >>= 1) { a += __shfl_xor(a, o); b += __shfl_xor(b, o); }
          const float li = 0.8f - 0.6f * expf(-0.3f * (float)layer);
          if (lane == 0) ((float*)(p.ws + O_LAM))[layer] = expf(a) - expf(b) + li;
        }
      }
    } else if (job < J_ZW) {
      const int jj = job - J_MISC; const int layer = jj / ZW_PER, q = jj % ZW_PER;
      uint4* d = (uint4*)(p.ws + O_WIN + layer * SZ_WIN + (size_t)NIN * LDK1 * 2) + q * 512 + tid5;
      if (q * 512 + tid5 < (NINP - NIN) * LDK1 / 8) *d = make_uint4(0, 0, 0, 0);
    } else {
      const int jj = job - J_ZW; const int lk = jj >> 2, q = jj & 3;
      uint4* d = (uint4*)(p.ws + O_W2 + (size_t)lk * 128 * 256 * 2 + 64 * 256 * 2) + q * 512 + tid5;
      *d = make_uint4(0, 0, 0, 0);
    }
  }
}

DI bool epi_inproj_chunk(const P& p, int layer, int ch, int m0w, f32x16 (&a0)[2], f32x16 (&a1)[2], bf16_t* stg, int cp,
                         bf16_t*& rdst, int& rldd, int& rcoff, const float* rsw) {
  const int lane = tidx() & 63;
  const int lr = lane & 31, lh = lane >> 5;
  enum { NORM, RAW, TRANS, SIG, CG };
  int type = RAW, ldd = 512, coff = 0, nh = 2, dv = 64, hd = 0, doff = 0;
  bf16_t* dst = nullptr; const float* gain = nullptr; float scl = 1.f;
  const float* gains = p.qk_gain + layer * 512;
  unsigned char* ws = p.ws;
  if (ch < 8) { type = NORM; dst = (bf16_t*)(ws + O_AQ); coff = ch * 64; gain = gains; scl = QSCL; }
  else if (ch < 16) { type = NORM; dst = (bf16_t*)(ws + O_AK); coff = (ch - 8) * 64; gain = gains + 64; }
  else if (ch < 24) { type = TRANS; dst = (bf16_t*)(ws + O_AVT); nh = 4; dv = 128; hd = (ch - 16) >> 1; doff = ((ch - 16) & 1) * 64; }
  else if (ch < 32) { type = NORM; dst = (bf16_t*)(ws + O_BQ); coff = (ch - 24) * 64; gain = gains + 128; scl = QSCL; }
  else if (ch < 34) { type = NORM; dst = (bf16_t*)(ws + O_BK); ldd = 128; coff = (ch - 32) * 64; gain = gains + 192; }
  else if (ch < 36) { type = TRANS; dst = (bf16_t*)(ws + O_BVT); hd = ch - 34; }
  else if (ch < 44) { type = NORM; dst = (bf16_t*)(ws + O_CQ); coff = (ch - 36) * 64; gain = gains + 256; scl = QSCL; }
  else if (ch < 46) { type = RAW; dst = (bf16_t*)(ws + O_CK); ldd = 128; coff = (ch - 44) * 64; }
  else if (ch < 48) { type = RAW; dst = (bf16_t*)(ws + O_CV); ldd = 128; coff = (ch - 46) * 64; }
  else if (ch < 50) { type = NORM; dst = (bf16_t*)(ws + O_KS); ldd = 128; coff = (ch - 48) * 64; gain = gains + 384; }
  else if (ch < 52) { type = TRANS; dst = (bf16_t*)(ws + O_VST); hd = ch - 50; }
  else if (ch < 54) { type = NORM; dst = (bf16_t*)(ws + O_KW); ldd = 128; coff = (ch - 52) * 64; gain = gains + 448; }
  else if (ch < 56) { type = TRANS; dst = (bf16_t*)(ws + O_VWT); hd = ch - 54; }
  else if (ch < 104) { type = SIG; dst = (bf16_t*)(ws + O_MGS); ldd = 3072; coff = (ch - 56) * 64; }
  else if (ch == 104) { type = CG; }
  else return false;
  rdst = dst; rldd = ldd; rcoff = coff;
#pragma unroll
  for (int mt = 0; mt < 2; ++mt) {
    const int m = m0w + mt * 32 + lr;
    const float rs = rsw[mt * 32 + lr];
    float v[2][16];
    float ss = 0.f;
#pragma unroll
    for (int i = 0; i < 16; ++i) { float t = a0[mt][i] * rs; v[0][i] = t; ss += t * t; }
#pragma unroll
    for (int i = 0; i < 16; ++i) { float t = a1[mt][i] * rs; v[1][i] = t; ss += t * t; }
    if (type == NORM) {
      ss += xor32(ss);
      const float r = rsqrtf(ss * (1.f / 64.f) + 1e-6f) * scl;
#pragma unroll
      for (int nt = 0; nt < 2; ++nt)
#pragma unroll
        for (int qd = 0; qd < 4; ++qd) {
          const int n = nt * 32 + 8 * qd + 4 * lh;
          const float4 g4 = *(const float4*)(gain + n);
          *(uint2*)(stg + (mt * 32 + lr) * 136 + cp * 64 + n) =
              make_uint2(pack2(v[nt][4 * qd] * r * g4.x, v[nt][4 * qd + 1] * r * g4.y),
                         pack2(v[nt][4 * qd + 2] * r * g4.z, v[nt][4 * qd + 3] * r * g4.w));
        }
    } else if (type == RAW || type == SIG) {
#pragma unroll
      for (int nt = 0; nt < 2; ++nt)
#pragma unroll
        for (int qd = 0; qd < 4; ++qd) {
          const int n = nt * 32 + 8 * qd + 4 * lh;
          float a = v[nt][4 * qd], b = v[nt][4 * qd + 1], c = v[nt][4 * qd + 2], d = v[nt][4 * qd + 3];
          if (type == SIG) { a = sigmoidf_(a); b = sigmoidf_(b); c = sigmoidf_(c); d = sigmoidf_(d); }
          if (type == SIG)
            *(uint2*)(dst + ((size_t)((coff + n) >> 2) * T_ + m) * 4) = make_uint2(pack2(a, b), pack2(c, d));
          else
            *(uint2*)(stg + (mt * 32 + lr) * 136 + cp * 64 + n) = make_uint2(pack2(a, b), pack2(c, d));
        }
    } else if (type == TRANS) {
      const int b = m >> 12, s = m & 4095;
      bf16_t* base = dst + ((size_t)(b * nh + hd) * dv + doff) * S_ + s;
#pragma unroll
      for (int nt = 0; nt < 2; ++nt)
#pragma unroll
        for (int i = 0; i < 16; ++i) {
          const int n = nt * 32 + 8 * (i >> 2) + 4 * lh + (i & 3);
          base[(size_t)n * S_] = f2bf(v[nt][i]);
        }
    } else {
      float* cg = (float*)(ws + O_CGS) + (size_t)m * 24;
#pragma unroll
      for (int i = 0; i < 16; ++i) {
        const int n = 8 * (i >> 2) + 4 * lh + (i & 3);
        if (n < 24) cg[n] = sigmoidf_(v[0][i]);
      }
    }
  }
  return type == NORM || type == RAW;
}

DI void stage_rows_store(const bf16_t* stg, bf16_t* dst, size_t ldd, int m0w) {
  const int lane = tidx() & 63;
#pragma unroll
  for (int it = 0; it < 16; ++it) {
    const int row = it * 4 + (lane >> 4), c16 = lane & 15;
    const u32x4 v = *(const u32x4*)(stg + row * 136 + c16 * 8);
    *(u32x4*)(dst + (size_t)(m0w + row) * ldd + c16 * 8) = v;
  }
}

DI void phase_inproj(const P& p, int layer, bf16_t* sm, const Geo& ge) {
  const bf16_t* W = (const bf16_t*)(p.ws + O_WIN + layer * SZ_WIN);
  const bf16_t* X = (const bf16_t*)(p.ws + O_XB);
  TileWalk tw(27, ge);
  int mt, nt;
  while (tw.next(mt, nt)) {
    f32x16 acc[4][2]; zero_acc8(acc);
    gemm_wide(W + (size_t)nt * 256 * LDK1, LDK1, X + (size_t)mt * 256 * LDK1, LDK1, 16, acc, sm);
    const int wv = tidx() >> 6, wn = wv & 1, wm = wv >> 1;
    bf16_t* stg = sm + wv * (64 * 136);
    bf16_t *d0 = nullptr, *d1 = nullptr; int ld0 = 0, ld1 = 0, co0 = 0, co1 = 0;
    const float* rsw = tile_rstd((const float*)(p.ws + O_PART), mt * 256, sm) + wm * 64;
    const bool s0 = epi_inproj_chunk(p, layer, nt * 4 + wn * 2, mt * 256 + wm * 64, acc[0], acc[1], stg, 0, d0, ld0, co0, rsw);
    const bool s1 = epi_inproj_chunk(p, layer, nt * 4 + wn * 2 + 1, mt * 256 + wm * 64, acc[2], acc[3], stg, 1, d1, ld1, co1, rsw);
    if (s0 && s1) stage_rows_store(stg, d0 + co0, ld0, mt * 256 + wm * 64);
  }
}

template <int NDT, int MODE, bool ALLON>
DI void attn_tile(const bf16_t* Kl, int kst, const bf16_t* Vl, const bf16x8 (&q)[4], f32x16 (&O)[NDT], float& m, float& l,
                  int kbase, int qp, int win, float cbias, const float* tab, bool lane_on) {
  const int lane = tidx() & 63, lr = lane & 31, lh = lane >> 5;
  f32x16 s[2];
#pragma unroll
  for (int st = 0; st < 2; ++st) {
#pragma unroll
    for (int i = 0; i < 16; ++i) s[st][i] = 0.f;
  }
#pragma unroll
  for (int ks = 0; ks < 4; ++ks) {
    const bf16x8 k0 = *(const bf16x8*)(Kl + lr * kst + ks * 16 + lh * 8);
    const bf16x8 k1 = *(const bf16x8*)(Kl + (32 + lr) * kst + ks * 16 + lh * 8);
    s[0] = MFMA32(k0, q[ks], s[0]);
    s[1] = MFMA32(k1, q[ks], s[1]);
  }
  float alpha, psum = 0.f;
  if (MODE == 0) {
    float tmax = fmaxf(s[0][0], s[1][0]);
#pragma unroll
    for (int i = 1; i < 16; ++i) tmax = fmaxf(tmax, fmaxf(s[0][i], s[1][i]));
    tmax = fmaxf(tmax, xor32(tmax)) + cbias;
    if (!ALLON) tmax = lane_on ? tmax : -1e30f;
    const float mn = fmaxf(m, tmax);
    alpha = ex2(m - mn);
    m = mn;
    const float mc = (ALLON || lane_on) ? mn - cbias : 1e30f;
#pragma unroll
    for (int st = 0; st < 2; ++st)
#pragma unroll
      for (int i = 0; i < 16; ++i) { const float pe = ex2(s[st][i] - mc); psum += pe; s[st][i] = pe; }
  } else {
    float tmax = -1e30f;
#pragma unroll
    for (int st = 0; st < 2; ++st)
#pragma unroll
      for (int i = 0; i < 16; ++i) {
        const int key = kbase + st * 32 + 8 * (i >> 2) + 4 * lh + (i & 3);
        float v;
        if (MODE == 1) {
          const int dist = qp - key;
          const bool ok = (ALLON || lane_on) && dist >= 0 && dist < win;
          const int di = dist < 0 ? 0 : (dist > 128 ? 128 : dist);
          v = ok ? s[st][i] + tab[di] : -1e30f;
        } else {
          v = (16 * key + 31 <= qp) ? s[st][i] : -1e30f;
        }
        s[st][i] = v;
        tmax = fmaxf(tmax, v);
      }
    tmax = fmaxf(tmax, xor32(tmax));
    const float mn = fmaxf(m, tmax);
    alpha = ex2(m - mn);
    m = mn;
#pragma unroll
    for (int st = 0; st < 2; ++st)
#pragma unroll
      for (int i = 0; i < 16; ++i) {
        const float pe = s[st][i] > -5e29f ? ex2(s[st][i] - mn) : 0.f;
        psum += pe;
        s[st][i] = pe;
      }
  }
  l = l * alpha + psum;
  if (__ballot(alpha != 1.f)) {
#pragma unroll
    for (int dt = 0; dt < NDT; ++dt)
#pragma unroll
      for (int i = 0; i < 16; ++i) O[dt][i] *= alpha;
  }
#pragma unroll
  for (int st = 0; st < 2; ++st)
#pragma unroll
    for (int sk = 0; sk < 2; ++sk) {
      u32x4 pu;
      pu[0] = pack2(s[st][8 * sk + 0], s[st][8 * sk + 1]);
      pu[1] = pack2(s[st][8 * sk + 2], s[st][8 * sk + 3]);
      pu[2] = pack2(s[st][8 * sk + 4], s[st][8 * sk + 5]);
      pu[3] = pack2(s[st][8 * sk + 6], s[st][8 * sk + 7]);
      const bf16x8 pf = __builtin_bit_cast(bf16x8, pu);
#pragma unroll
      for (int dt = 0; dt < NDT; ++dt) {
        const bf16_t* vp = Vl + (dt * 32 + lr) * 72 + st * 32 + sk * 16 + 4 * lh;
        const uint2 v0 = *(const uint2*)(vp);
        const uint2 v1 = *(const uint2*)(vp + 8);
        u32x4 vu; vu[0] = v0.x; vu[1] = v0.y; vu[2] = v1.x; vu[3] = v1.y;
        O[dt] = MFMA32(__builtin_bit_cast(bf16x8, vu), pf, O[dt]);
      }
    }
}

DI float gelu_tanh(float x) {
  const float u = 0.7978845608028654f * (x + 0.044715f * x * x * x);
  const float e = __expf(2.f * u);
  const float th = 1.f - 2.f / (e + 1.f);
  return 0.5f * x * (1.f + th);
}

DI void task_compress(const P& p, int layer, int task, bf16_t* sm) {
  const int tid = tidx(), lane = tid & 63, wv = tid >> 6, wn = wv & 1, wm = wv >> 1;
  const int lr = lane & 31, lh = lane >> 5;
  const int b = task & 3, g = (task >> 2) & 1, kv = task >> 3;
  const bf16_t* src = (const bf16_t*)(p.ws + (kv ? O_CV : O_CK)) + (size_t)b * S_ * 128 + g * 64;
  const bf16_t* W1 = (const bf16_t*)(p.ws + O_W1 + layer * SZ_W1) + (size_t)kv * 256 * 2048;
  const bf16_t* W2 = (const bf16_t*)(p.ws + O_W2 + layer * SZ_W2) + (size_t)kv * 128 * 256;
  bf16_t* hid = (bf16_t*)(p.ws + O_HID) + (size_t)((kv * 2 + g) * 4 + b) * 65536;
  const float* pw = (const float*)(p.ws + O_POSW1) + (layer * 2 + kv) * 256;
  for (int nt2 = 0; nt2 < 2; ++nt2) {
    f32x16 acc[2][2]; zero_acc(acc);
    gemm_mid(W1 + (size_t)nt2 * 128 * 2048, 2048, src, 16 * 128, 254, 128, 32, 0, acc, sm);
#pragma unroll
    for (int mt = 0; mt < 2; ++mt) {
      const int m = wm * 64 + mt * 32 + lr;
#pragma unroll
      for (int nt = 0; nt < 2; ++nt)
#pragma unroll
        for (int qd = 0; qd < 4; ++qd) {
          const int n = nt2 * 128 + wn * 64 + nt * 32 + 8 * qd + 4 * lh;
          const float4 pw4 = *(const float4*)(pw + n);
          *(uint2*)(hid + (size_t)m * 256 + n) =
              make_uint2(pack2(gelu_tanh(acc[nt][mt][4 * qd] + pw4.x), gelu_tanh(acc[nt][mt][4 * qd + 1] + pw4.y)),
                         pack2(gelu_tanh(acc[nt][mt][4 * qd + 2] + pw4.z), gelu_tanh(acc[nt][mt][4 * qd + 3] + pw4.w)));
        }
    }
  }
  __threadfence();
  __syncthreads();
  {
    f32x16 acc[2][2]; zero_acc(acc);
    gemm_mid(W2, 256, hid, 256, 1 << 30, 64, 4, 0, acc, sm);
    if (wn == 0) {
      const float* gain = p.qk_gain + layer * 512 + 320;
#pragma unroll
      for (int mt = 0; mt < 2; ++mt) {
        const int m = wm * 64 + mt * 32 + lr;
        if (kv == 0) {
          float ss = 0.f;
#pragma unroll
          for (int nt = 0; nt < 2; ++nt)
#pragma unroll
            for (int i = 0; i < 16; ++i) ss += acc[nt][mt][i] * acc[nt][mt][i];
          ss += xor32(ss);
          const float r = rsqrtf(ss * (1.f / 64.f) + 1e-6f);
          bf16_t* kc = (bf16_t*)(p.ws + O_KC) + ((size_t)(b * 2 + g) * 256 + m) * 64;
#pragma unroll
          for (int nt = 0; nt < 2; ++nt)
#pragma unroll
            for (int qd = 0; qd < 4; ++qd) {
              const int n = nt * 32 + 8 * qd + 4 * lh;
              const float4 g4 = *(const float4*)(gain + n);
              *(uint2*)(kc + n) = make_uint2(pack2(acc[nt][mt][4 * qd] * r * g4.x, acc[nt][mt][4 * qd + 1] * r * g4.y),
                                             pack2(acc[nt][mt][4 * qd + 2] * r * g4.z, acc[nt][mt][4 * qd + 3] * r * g4.w));
            }
        } else {
          bf16_t* vc = (bf16_t*)(p.ws + O_VCT) + (size_t)(b * 2 + g) * 64 * 256 + m;
#pragma unroll
          for (int nt = 0; nt < 2; ++nt)
#pragma unroll
            for (int i = 0; i < 16; ++i) {
              const int n = nt * 32 + 8 * (i >> 2) + 4 * lh + (i & 3);
              vc[(size_t)n * 256] = f2bf(acc[nt][mt][i]);
            }
        }
      }
    }
  }
}

DI void task_attnA(const P& p, int layer, int task, bf16_t* sm, int dm) {
  const int tid = tidx(), lane = tid & 63, wv = tid >> 6, c = wv & 1, qs = wv >> 1;
  const int lr = lane & 31, lh = lane >> 5;
  const int qb = 31 - (task >> 4), bh = task & 15, b = bh >> 2, h = bh & 3;
  float* tab = (float*)((unsigned char*)sm + 71680);
  bf16x8* qlds = (bf16x8*)((unsigned char*)sm + 72704) + wv * 256 + lane;
  float* xbuf = (float*)((unsigned char*)sm);
  __syncthreads();
  if (tid < 129) tab[tid] = ((const float*)(p.ws + O_TABS))[h * 132 + tid];
  const int q0 = qb * 128, qmin = q0 + qs * 32, qp = qmin + lr;
  bf16_t* aq = (bf16_t*)(p.ws + O_AQ);
  {
    const bf16_t* qptr = aq + (size_t)(b * S_ + qp) * 512 + h * 128 + c * 64 + lh * 8;
#pragma unroll
    for (int ks = 0; ks < 4; ++ks) qlds[ks * 64] = *(const bf16x8*)(qptr + ks * 16);
  }
  f32x16 O[4];
#pragma unroll
  for (int dt = 0; dt < 4; ++dt)
#pragma unroll
    for (int i = 0; i < 16; ++i) O[dt][i] = 0.f;
  float m = -1e30f, l = 0.f;
  const bf16_t* kg = (const bf16_t*)(p.ws + O_AK) + (size_t)b * S_ * 512 + h * 128;
  const bf16_t* vg = (const bf16_t*)(p.ws + O_AVT) + (size_t)((b * 4 + h) * 128) * S_;
  u32x4 rk0, rk1, rv0, rv1;
#define A_GLOAD(i, KT) { const int chk = tid + 512 * i; \
    rk##i = *(const u32x4*)(kg + (size_t)((KT) * 64 + (chk >> 4)) * 512 + (chk & 15) * 8); \
    rv##i = *(const u32x4*)(vg + (size_t)(chk >> 3) * S_ + (KT) * 64 + (chk & 7) * 8); }
#define A_LSTORE(i) { const int chk = tid + 512 * i; \
    *(u32x4*)(Kl + (chk >> 4) * 136 + (chk & 15) * 8) = rk##i; \
    *(u32x4*)(Kl + 64 * 136 + (chk >> 3) * 72 + (chk & 7) * 8) = rv##i; }
  const int kt_hi = 2 * qb + 1;
  A_GLOAD(0, 0) A_GLOAD(1, 0)
  for (int kt = 0; kt <= kt_hi; ++kt) {
    bf16_t* Kl = sm + (kt & 1) * 17920; const bf16_t* Vl = Kl + 64 * 136;
    A_LSTORE(0) A_LSTORE(1)
    if (kt < kt_hi) { A_GLOAD(0, kt + 1) A_GLOAD(1, kt + 1) }
    __syncthreads();
    if (kt * 64 <= qmin + 31) {
      bf16x8 q[4];
#pragma unroll
      for (int ks = 0; ks < 4; ++ks) q[ks] = qlds[ks * 64];
      if (kt * 64 + 63 + 128 <= qmin)
        attn_tile<4, 0, true>(Kl + c * 64, 136, Vl, q, O, m, l, kt * 64, qp, 0, tab[128], tab, true);
      else
        attn_tile<4, 1, true>(Kl + c * 64, 136, Vl, q, O, m, l, kt * 64, qp, 1 << 30, 0.f, tab, true);
    }
  }
#undef A_GLOAD
#undef A_LSTORE
  const float lt = l + xor32(l);
  const float inv = 1.f / lt;
  __syncthreads();
  if (c == 1) {
#pragma unroll
    for (int dt = 0; dt < 4; ++dt)
#pragma unroll
      for (int i = 0; i < 16; ++i) {
        const int d = dt * 32 + 8 * (i >> 2) + 4 * lh + (i & 3);
        xbuf[(qs * 128 + d) * 32 + lr] = O[dt][i] * inv;
      }
  }
  __syncthreads();
  if (c == 0) {
    const float lam = ((const float*)(p.ws + O_LAM))[layer];
    const float li = 0.8f - 0.6f * expf(-0.3f * (float)layer);
    float ss = 0.f;
#pragma unroll
    for (int dt = 0; dt < 4; ++dt)
#pragma unroll
      for (int i = 0; i < 16; ++i) {
        const int d = dt * 32 + 8 * (i >> 2) + 4 * lh + (i & 3);
        const float o = O[dt][i] * inv - lam * xbuf[(qs * 128 + d) * 32 + lr];
        O[dt][i] = o;
        ss += o * o;
      }
    ss += xor32(ss);
    const float r = rsqrtf(ss * (1.f / 128.f) + 1e-6f) * (1.f - li);
    const float* sub = p.diff_subln + layer * 128;
    bf16_t* dst = (dm ? (bf16_t*)(p.ws + WS_END) : aq) + (size_t)(b * S_ + qp) * 512 + h * 128;
#pragma unroll
    for (int dt = 0; dt < 4; ++dt)
#pragma unroll
      for (int qd = 0; qd < 4; ++qd) {
        const int d = dt * 32 + 8 * qd + 4 * lh;
        const float4 g4 = *(const float4*)(sub + d);
        *(uint2*)(dst + d) = make_uint2(pack2(O[dt][4 * qd] * r * g4.x, O[dt][4 * qd + 1] * r * g4.y),
                                        pack2(O[dt][4 * qd + 2] * r * g4.z, O[dt][4 * qd + 3] * r * g4.w));
      }
  }
}

struct KVRegs { u32x4 k0, v0; };
DI void kv_gload(KVRegs& r, const bf16_t* kg, size_t kld, const bf16_t* vg, size_t vld, int key0) {
  const int c0 = tidx();
  r.k0 = *(const u32x4*)(kg + (size_t)(key0 + (c0 >> 3)) * kld + (c0 & 7) * 8);
  r.v0 = *(const u32x4*)(vg + (size_t)(c0 >> 3) * vld + key0 + (c0 & 7) * 8);
}
DI void kv_lstore(const KVRegs& r, bf16_t* Kl, bf16_t* Vl) {
  const int c0 = tidx();
  *(u32x4*)(Kl + (c0 >> 3) * 72 + (c0 & 7) * 8) = r.k0;
  *(u32x4*)(Vl + (c0 >> 3) * 72 + (c0 & 7) * 8) = r.v0;
}

DI void task_attnB(const P& p, int layer, int task, bf16_t* sm, int dm) {
  const int tid = tidx(), lane = tid & 63, wv = tid >> 6, hr = wv & 3, qs = wv >> 2;
  const int lr = lane & 31, lh = lane >> 5;
  const int qb = 63 - (task >> 3), bg = task & 7, b = bg >> 1, g = bg & 1, head = g * 4 + hr;
  float* tabs = (float*)((unsigned char*)sm + 36864);
  __syncthreads();
  for (int i = tid; i < 4 * 129; i += NTHR) {
    const int r = i / 129, d = i % 129;
    tabs[r * 132 + d] = ((const float*)(p.ws + O_TABS))[(4 + g * 4 + r) * 132 + d];
  }
  const int q0 = qb * 64, qmin = q0 + qs * 32, qp = qmin + lr;
  bf16_t* bq = (bf16_t*)(p.ws + O_BQ);
  bf16x8 q[4];
  {
    const bf16_t* qptr = bq + (size_t)(b * S_ + qp) * 512 + head * 64 + lh * 8;
#pragma unroll
    for (int ks = 0; ks < 4; ++ks) q[ks] = *(const bf16x8*)(qptr + ks * 16);
  }
  f32x16 O[2];
#pragma unroll
  for (int dt = 0; dt < 2; ++dt)
#pragma unroll
    for (int i = 0; i < 16; ++i) O[dt][i] = 0.f;
  float m = p.sinks[layer * 8 + head] * LOG2E, l = lh == 0 ? 1.f : 0.f;
  const bf16_t* kg = (const bf16_t*)(p.ws + O_BK) + (size_t)b * S_ * 128 + g * 64;
  const bf16_t* vg = (const bf16_t*)(p.ws + O_BVT) + (size_t)((b * 2 + g) * 64) * S_;
  const int kt_lo = q0 >= 127 ? (q0 - 127) >> 6 : 0, kt_hi = qb;
  KVRegs R;
  kv_gload(R, kg, 128, vg, S_, kt_lo * 64);
  for (int kt = kt_lo; kt <= kt_hi; ++kt) {
    bf16_t* Kl = sm + (kt & 1) * 9216; bf16_t* Vl = Kl + 4608;
    kv_lstore(R, Kl, Vl);
    if (kt < kt_hi) kv_gload(R, kg, 128, vg, S_, (kt + 1) * 64);
    __syncthreads();
    if (kt * 64 <= qmin + 31 && kt * 64 + 63 + 127 >= qmin)
      attn_tile<2, 1, true>(Kl, 72, Vl, q, O, m, l, kt * 64, qp, 128, 0.f, tabs + hr * 132, true);
  }
  const float lt = l + xor32(l);
  const float inv = 1.f / lt;
  bf16_t* dst = (dm ? (bf16_t*)(p.ws + WS_END) : bq) + (size_t)(b * S_ + qp) * 512 + head * 64;
#pragma unroll
  for (int dt = 0; dt < 2; ++dt)
#pragma unroll
    for (int qd = 0; qd < 4; ++qd) {
      const int d = dt * 32 + 8 * qd + 4 * lh;
      *(uint2*)(dst + d) = make_uint2(pack2(O[dt][4 * qd] * inv, O[dt][4 * qd + 1] * inv),
                                      pack2(O[dt][4 * qd + 2] * inv, O[dt][4 * qd + 3] * inv));
    }
}

DI void phase2(const P& p, int layer, bf16_t* sm, unsigned* qhead, int dm = 0) {
  for (;;) {
    const int task = next_task(qhead, sm);
    if (task >= 16 + 512 + 512) break;
    if (task < 16) task_compress(p, layer, task, sm);
    else if (task < 16 + 512) task_attnA(p, layer, task - 16, sm, dm);
    else task_attnB(p, layer, task - 528, sm, dm);
  }
}

DI void task_nsa(const P& p, int layer, int task, bf16_t* sm, int dm) {
  const int tid = tidx(), lane = tid & 63, wv = tid >> 6, hr = wv & 3, qs = wv >> 2;
  const int lr = lane & 31, lh = lane >> 5;
  const int qb = 63 - (task >> 3), bg = task & 7, b = bg >> 1, g = bg & 1, head = g * 4 + hr;
  float* tabs = (float*)((unsigned char*)sm + 36864);
  float* cbuf = (float*)((unsigned char*)sm + 39168);
  unsigned long long* masks = (unsigned long long*)((unsigned char*)sm + 55808);
  float* outl = (float*)((unsigned char*)sm + 56320) + wv * 2048 + lane;
  int itc = 0;
  __syncthreads();
  for (int i = tid; i < 4 * 129; i += NTHR) {
    const int r = i / 129, d = i % 129;
    tabs[r * 132 + d] = ((const float*)(p.ws + O_TABS))[(12 + g * 4 + r) * 132 + d];
  }
  for (int i = tid; i < 64 * 65; i += NTHR) cbuf[i] = 0.f;
  const float* tab = tabs + hr * 132;
  const int q0 = qb * 64, qmin = q0 + qs * 32, ql = qs * 32 + lr, qp = q0 + ql;
  bf16_t* cq = (bf16_t*)(p.ws + O_CQ);
  bf16x8 q[4];
  {
    const bf16_t* qptr = cq + (size_t)(b * S_ + qp) * 512 + head * 64 + lh * 8;
#pragma unroll
    for (int ks = 0; ks < 4; ++ks) q[ks] = *(const bf16x8*)(qptr + ks * 16);
  }
  const float* cg = (const float*)(p.ws + O_CGS) + (size_t)(b * S_ + qp) * 24 + head * 3;
  const float g0 = cg[0], g1 = cg[1], g2 = cg[2];
  f32x16 O[2];
  KVRegs R;
  {
    int nct = (((q0 + 32) >> 4) + 1 + 63) >> 6; if (nct > 4) nct = 4;
    const bf16_t* kg = (const bf16_t*)(p.ws + O_KC) + (size_t)(b * 2 + g) * 256 * 64;
    const bf16_t* vg = (const bf16_t*)(p.ws + O_VCT) + (size_t)(b * 2 + g) * 64 * 256;
#pragma unroll
    for (int dt = 0; dt < 2; ++dt)
#pragma unroll
      for (int i = 0; i < 16; ++i) O[dt][i] = 0.f;
    float m = -1e30f, l = 0.f;
    kv_gload(R, kg, 64, vg, 256, 0);
    for (int ct = 0; ct < nct; ++ct, ++itc) {
      bf16_t* Kl = sm + (itc & 1) * 9216; bf16_t* Vl = Kl + 4608;
      kv_lstore(R, Kl, Vl);
      if (ct + 1 < nct) kv_gload(R, kg, 64, vg, 256, (ct + 1) * 64);
      __syncthreads();
      attn_tile<2, 2, true>(Kl, 72, Vl, q, O, m, l, ct * 64, qp, 0, 0.f, tab, true);
    }
    const float lt = l + xor32(l);
    const float inv = lt > 0.f ? 1.f / lt : 0.f;
    {
      const float sc = g0 * inv;
#pragma unroll
      for (int dt = 0; dt < 2; ++dt)
#pragma unroll
        for (int i = 0; i < 16; ++i) outl[(dt * 16 + i) * 64] = sc * O[dt][i];
    }
    float carry = 0.f;
    kv_gload(R, kg, 64, vg, 256, 0);
    for (int ct = 0; ct < nct; ++ct, ++itc) {
      bf16_t* Kl = sm + (itc & 1) * 9216; bf16_t* Vl = Kl + 4608;
      kv_lstore(R, Kl, Vl);
      if (ct + 1 < nct) kv_gload(R, kg, 64, vg, 256, (ct + 1) * 64);
      __syncthreads();
      float val[2][4];
#pragma unroll
      for (int st = 0; st < 2; ++st) {
        f32x16 s;
#pragma unroll
        for (int i = 0; i < 16; ++i) s[i] = 0.f;
#pragma unroll
        for (int ks = 0; ks < 4; ++ks) {
          bf16x8 kf = *(const bf16x8*)(Kl + (st * 32 + lr) * 72 + ks * 16 + lh * 8);
          s = MFMA32(kf, q[ks], s);
        }
        float pq[4], pl[4], other[4];
#pragma unroll
        for (int g4 = 0; g4 < 4; ++g4) {
          float sum = 0.f, last = 0.f;
#pragma unroll
          for (int e = 0; e < 4; ++e) {
            const int cc = ct * 64 + st * 32 + 8 * g4 + 4 * lh + e;
            const float pe = (16 * cc + 31 <= qp) ? ex2(s[4 * g4 + e] - m) * inv : 0.f;
            sum += pe; last = pe;
          }
          pq[g4] = sum; pl[g4] = last;
        }
#pragma unroll
        for (int g4 = 0; g4 < 4; ++g4) other[g4] = xor32(pl[g4]);
        val[st][0] = pq[0] + (lh ? other[0] : carry);
        val[st][1] = pq[1] + (lh ? other[1] : other[0]);
        val[st][2] = pq[2] + (lh ? other[2] : other[1]);
        val[st][3] = pq[3] + (lh ? other[3] : other[2]);
        carry = other[3];
      }
      for (int w = 0; w < 4; ++w) {
        if (hr == w) {
#pragma unroll
          for (int st = 0; st < 2; ++st)
#pragma unroll
            for (int g4 = 0; g4 < 4; ++g4) cbuf[(ct * 16 + st * 8 + 2 * g4 + lh) * 65 + ql] += val[st][g4];
        }
        __syncthreads();
      }
    }
  }
  __syncthreads();
  for (int qi = 0; qi < 8; ++qi) {
    const int qq = wv * 8 + qi, qpos = q0 + qq, j = lane, cur = qpos >> 6;
    const float imp = cbuf[j * 65 + qq];
    const bool valid = j <= cur;
    const bool forced = (j == 0) || (j == cur) || (j == cur - 1);
    const float score = valid ? imp + (forced ? 1e4f : 0.f) : -1e30f;
    int rank = 0;
#pragma unroll 4
    for (int jp = 0; jp < 64; ++jp) {
      const float sj = __int_as_float(__builtin_amdgcn_readlane(__float_as_int(score), jp));
      rank += ((sj > score) || (sj == score && jp < j)) ? 1 : 0;
    }
    const unsigned long long mk = __ballot(rank < 16);
    if (lane == 0) masks[qq] = mk;
  }
  __syncthreads();
  const unsigned long long mymask = masks[ql];
  unsigned long long un = 0ull;
  for (int i = 0; i < 64; ++i) un |= masks[i];
  {
    const int cmax = qb;
    unsigned long long todo = un & (cmax == 63 ? ~0ull : ((1ull << (cmax + 1)) - 1ull));
    const bf16_t* kg = (const bf16_t*)(p.ws + O_KS) + (size_t)b * S_ * 128 + g * 64;
    const bf16_t* vg = (const bf16_t*)(p.ws + O_VST) + (size_t)((b * 2 + g) * 64) * S_;
#pragma unroll
    for (int dt = 0; dt < 2; ++dt)
#pragma unroll
      for (int i = 0; i < 16; ++i) O[dt][i] = 0.f;
    float m = -1e30f, l = 0.f;
    kv_gload(R, kg, 128, vg, S_, (__ffsll((long long)todo) - 1) * 64);
    for (; todo; ++itc) {
      const int j = __ffsll((long long)todo) - 1;
      todo &= todo - 1ull;
      bf16_t* Kl = sm + (itc & 1) * 9216; bf16_t* Vl = Kl + 4608;
      kv_lstore(R, Kl, Vl);
      if (todo) kv_gload(R, kg, 128, vg, S_, (__ffsll((long long)todo) - 1) * 64);
      __syncthreads();
      const bool on = (mymask >> j) & 1ull;
      if (j * 64 <= qmin + 31 && __ballot(on)) {
        if (j * 64 + 63 + 128 <= qmin)
          attn_tile<2, 0, false>(Kl, 72, Vl, q, O, m, l, j * 64, qp, 0, tab[128], tab, on);
        else
          attn_tile<2, 1, false>(Kl, 72, Vl, q, O, m, l, j * 64, qp, 1 << 30, 0.f, tab, on);
      }
    }
    const float lt = l + xor32(l);
    const float inv = lt > 0.f ? 1.f / lt : 0.f;
    {
      const float sc = g1 * inv;
#pragma unroll
      for (int dt = 0; dt < 2; ++dt)
#pragma unroll
        for (int i = 0; i < 16; ++i) outl[(dt * 16 + i) * 64] += sc * O[dt][i];
    }
  }
  {
    const bf16_t* kg = (const bf16_t*)(p.ws + O_KW) + (size_t)b * S_ * 128 + g * 64;
    const bf16_t* vg = (const bf16_t*)(p.ws + O_VWT) + (size_t)((b * 2 + g) * 64) * S_;
#pragma unroll
    for (int dt = 0; dt < 2; ++dt)
#pragma unroll
      for (int i = 0; i < 16; ++i) O[dt][i] = 0.f;
    float m = -1e30f, l = 0.f;
    const int kt_lo = q0 >= 511 ? (q0 - 511) >> 6 : 0, kt_hi = qb;
    kv_gload(R, kg, 128, vg, S_, kt_lo * 64);
    for (int kt = kt_lo; kt <= kt_hi; ++kt, ++itc) {
      bf16_t* Kl = sm + (itc & 1) * 9216; bf16_t* Vl = Kl + 4608;
      kv_lstore(R, Kl, Vl);
      if (kt < kt_hi) kv_gload(R, kg, 128, vg, S_, (kt + 1) * 64);
      __syncthreads();
      if (kt * 64 <= qmin + 31 && kt * 64 + 63 + 511 >= qmin) {
        if (kt * 64 + 63 + 128 <= qmin && qmin + 31 - kt * 64 < 512)
          attn_tile<2, 0, true>(Kl, 72, Vl, q, O, m, l, kt * 64, qp, 0, tab[128], tab, true);
        else
          attn_tile<2, 1, true>(Kl, 72, Vl, q, O, m, l, kt * 64, qp, 512, 0.f, tab, true);
      }
    }
    const float lt = l + xor32(l);
    const float inv = 1.f / lt;
    {
      const float sc = g2 * inv;
#pragma unroll
      for (int dt = 0; dt < 2; ++dt)
#pragma unroll
        for (int i = 0; i < 16; ++i) O[dt][i] = outl[(dt * 16 + i) * 64] + sc * O[dt][i];
    }
  }
  bf16_t* dst = (dm ? (bf16_t*)(p.ws + WS_END) : cq) + (size_t)(b * S_ + qp) * 512 + head * 64;
#pragma unroll
  for (int dt = 0; dt < 2; ++dt)
#pragma unroll
    for (int qd = 0; qd < 4; ++qd) {
      const int d = dt * 32 + 8 * qd + 4 * lh;
      *(uint2*)(dst + d) = make_uint2(pack2(O[dt][4 * qd], O[dt][4 * qd + 1]), pack2(O[dt][4 * qd + 2], O[dt][4 * qd + 3]));
    }
}

DI void phase3(const P& p, int layer, bf16_t* sm, unsigned* qhead, int dm = 0) {
  for (;;) {
    const int task = next_task(qhead, sm);
    if (task >= 512) break;
    task_nsa(p, layer, task, sm, dm);
  }
}

DI void phase_merge(const P& p, int layer, bf16_t* sm, const Geo& ge) {
  const int tid = tidx(), lane = tid & 63, wv = tid >> 6, wn = wv & 1, wm = wv >> 1;
  const int lr = lane & 31, lh = lane >> 5;
  const bf16_t* W = (const bf16_t*)(p.ws + O_WBR + layer * SZ_WBR);
  const bf16_t* mgs = (const bf16_t*)(p.ws + O_MGS);
  bf16_t* z = (bf16_t*)(p.ws + O_Z);
  TileWalk tw(8, ge);
  int mt_, nt_;
  while (tw.next(mt_, nt_)) {
    unsigned zp[2][2][8];
#pragma unroll
    for (int a_ = 0; a_ < 2; ++a_)
#pragma unroll
      for (int b_ = 0; b_ < 2; ++b_)
#pragma unroll
        for (int i = 0; i < 8; ++i) zp[a_][b_][i] = 0u;
    for (int n3 = 0; n3 < 3; ++n3) {
      const bf16_t* X = (const bf16_t*)(p.ws + (n3 == 0 ? O_AQ : (n3 == 1 ? O_BQ : O_CQ)));
      f32x16 acc[2][2]; zero_acc(acc);
      gemm_mid(W + ((size_t)n3 * 1024 + nt_ * 128) * 512, 512, X, 512, 1 << 30, 64, 8, mt_ * 256, acc, sm);
#pragma unroll
      for (int mt = 0; mt < 2; ++mt) {
        const int m = mt_ * 256 + wm * 64 + mt * 32 + lr;
#pragma unroll
        for (int nt = 0; nt < 2; ++nt)
#pragma unroll
          for (int qd = 0; qd < 4; ++qd) {
            const int n = nt_ * 128 + wn * 64 + nt * 32 + 8 * qd + 4 * lh;
            const uint2 gq = *(const uint2*)(mgs + ((size_t)((n3 * 1024 + n) >> 2) * T_ + m) * 4);
            const unsigned z01 = zp[nt][mt][2 * qd], z23 = zp[nt][mt][2 * qd + 1];
            const float v0 = bf2f((bf16_t)(z01 & 0xffff)) + bf2f((bf16_t)(gq.x & 0xffff)) * acc[nt][mt][4 * qd];
            const float v1 = bf2f((bf16_t)(z01 >> 16)) + bf2f((bf16_t)(gq.x >> 16)) * acc[nt][mt][4 * qd + 1];
            const float v2 = bf2f((bf16_t)(z23 & 0xffff)) + bf2f((bf16_t)(gq.y & 0xffff)) * acc[nt][mt][4 * qd + 2];
            const float v3 = bf2f((bf16_t)(z23 >> 16)) + bf2f((bf16_t)(gq.y >> 16)) * acc[nt][mt][4 * qd + 3];
            zp[nt][mt][2 * qd] = pack2(v0, v1);
            zp[nt][mt][2 * qd + 1] = pack2(v2, v3);
          }
      }
    }
    bf16_t* stg = sm + wv * (64 * 72);
#pragma unroll
    for (int mt = 0; mt < 2; ++mt)
#pragma unroll
      for (int nt = 0; nt < 2; ++nt)
#pragma unroll
        for (int qd = 0; qd < 4; ++qd)
          *(uint2*)(stg + (mt * 32 + lr) * 72 + nt * 32 + 8 * qd + 4 * lh) = make_uint2(zp[nt][mt][2 * qd], zp[nt][mt][2 * qd + 1]);
#pragma unroll
    for (int it = 0; it < 8; ++it) {
      const int row = it * 8 + (lane >> 3), c16 = lane & 7;
      const u32x4 v = *(const u32x4*)(stg + row * 72 + c16 * 8);
      *(u32x4*)(z + (size_t)(mt_ * 256 + wm * 64 + row) * LDK1 + nt_ * 128 + wn * 64 + c16 * 8) = v;
    }
  }
}

DI void phase_resid(const P& p, const bf16_t* W, const bf16_t* X, int K, bf16_t* sm, const Geo& ge, bool last) {
  const int tid = tidx(), lane = tid & 63, wv = tid >> 6, wn = wv & 1, wm = wv >> 1;
  const int lr = lane & 31, lh = lane >> 5;
  bf16_t* xb = (bf16_t*)(p.ws + O_XB);
  float* part = (float*)(p.ws + O_PART);
  TileWalk tw(4, ge);
  int mt_, nt_;
  while (tw.next(mt_, nt_)) {
    f32x16 acc[4][2]; zero_acc8(acc);
    const int ldk = K + 64;
    gemm_wide(W + (size_t)nt_ * 256 * ldk, ldk, X + (size_t)mt_ * 256 * ldk, ldk, K / 64, acc, sm);
    float* stg = (float*)sm + wv * (64 * 68);
    const int m0w = mt_ * 256 + wm * 64, n0w = nt_ * 256 + wn * 128;
#pragma unroll
    for (int cp = 0; cp < 2; ++cp) {
#pragma unroll 4
      for (int it = 0; it < 8; ++it) {
        const int row = it * 8 + (lane >> 3), c8 = (lane & 7) * 8;
        const u32x4 raw = *(const u32x4*)(xb + (size_t)(m0w + row) * LDK1 + n0w + cp * 64 + c8);
        float* d = stg + row * 68 + c8;
        *(float4*)(d) = make_float4(__uint_as_float(raw[0] << 16), __uint_as_float(raw[0] & 0xffff0000u),
                                    __uint_as_float(raw[1] << 16), __uint_as_float(raw[1] & 0xffff0000u));
        *(float4*)(d + 4) = make_float4(__uint_as_float(raw[2] << 16), __uint_as_float(raw[2] & 0xffff0000u),
                                        __uint_as_float(raw[3] << 16), __uint_as_float(raw[3] & 0xffff0000u));
      }
#pragma unroll
      for (int mt = 0; mt < 2; ++mt) {
        float ss = 0.f;
#pragma unroll
        for (int nh = 0; nh < 2; ++nh)
#pragma unroll
          for (int qd = 0; qd < 4; ++qd) {
            const int nt = cp * 2 + nh;
            float4* sp = (float4*)(stg + (mt * 32 + lr) * 68 + nh * 32 + 8 * qd + 4 * lh);
            float4 v = *sp;
            v.x += acc[nt][mt][4 * qd]; v.y += acc[nt][mt][4 * qd + 1]; v.z += acc[nt][mt][4 * qd + 2]; v.w += acc[nt][mt][4 * qd + 3];
            *sp = v;
            ss += v.x * v.x + v.y * v.y + v.z * v.z + v.w * v.w;
          }
        ss += xor32(ss);
        if (lh == 0) part[(size_t)(m0w + mt * 32 + lr) * 16 + nt_ * 4 + wn * 2 + cp] = ss;
      }
#pragma unroll 4
      for (int it = 0; it < 16; ++it) {
        const int row = it * 4 + (lane >> 4), c4 = (lane & 15) * 4;
        const float4 v = *(const float4*)(stg + row * 68 + c4);
        if (last) *(float4*)(p.out + (size_t)(m0w + row) * 1024 + n0w + cp * 64 + c4) = v;
        *(uint2*)(xb + (size_t)(m0w + row) * LDK1 + n0w + cp * 64 + c4) = make_uint2(pack2(v.x, v.y), pack2(v.z, v.w));
      }
    }
  }
}

DI void phase_up(const P& p, int layer, bf16_t* sm, const Geo& ge) {
  const int tid = tidx(), lane = tid & 63, wv = tid >> 6, wn = wv & 1, wm = wv >> 1;
  const int lr = lane & 31, lh = lane >> 5;
  const bf16_t* W = (const bf16_t*)(p.ws + O_WUP + layer * SZ_WUP);
  const bf16_t* X = (const bf16_t*)(p.ws + O_XB);
  const float* part = (const float*)(p.ws + O_PART);
  bf16_t* u = (bf16_t*)(p.ws + O_U);
  TileWalk tw(16, ge);
  int mt_, nt_;
  while (tw.next(mt_, nt_)) {
    f32x16 acc[4][2]; zero_acc8(acc);
    gemm_wide(W + (size_t)nt_ * 256 * LDK1, LDK1, X + (size_t)mt_ * 256 * LDK1, LDK1, 16, acc, sm);
    bf16_t* stg = sm + wv * (64 * 136);
    const float* rsw = tile_rstd(part, mt_ * 256, sm) + wm * 64;
#pragma unroll
    for (int mt = 0; mt < 2; ++mt) {
      const float rs = rsw[mt * 32 + lr];
#pragma unroll
      for (int nt = 0; nt < 4; ++nt)
#pragma unroll
        for (int qd = 0; qd < 4; ++qd) {
          const int n = nt_ * 256 + wn * 128 + nt * 32 + 8 * qd + 4 * lh;
          float a = fmaxf(acc[nt][mt][4 * qd] * rs, 0.f), b = fmaxf(acc[nt][mt][4 * qd + 1] * rs, 0.f);
          float c = fmaxf(acc[nt][mt][4 * qd + 2] * rs, 0.f), d = fmaxf(acc[nt][mt][4 * qd + 3] * rs, 0.f);
          *(uint2*)(stg + (mt * 32 + lr) * 136 + nt * 32 + 8 * qd + 4 * lh) = make_uint2(pack2(a * a, b * b), pack2(c * c, d * d));
        }
    }
    stage_rows_store(stg, u + nt_ * 256 + wn * 128, LDK4, mt_ * 256 + wm * 64);
  }
}

DI unsigned xcc_id() { return (unsigned)__builtin_amdgcn_s_getreg((3 << 11) | 20) & 0xFu; }
struct BarCtx { unsigned* base; unsigned xcc, xcnt, nxcc, gen; };
DI void gbar(BarCtx& c) {
  ++c.gen;
  asm volatile("s_waitcnt vmcnt(0) lgkmcnt(0)" ::: "memory");
  __syncthreads();
  if (threadIdx.x == 0) {
    const unsigned old = __hip_atomic_fetch_add(c.base + (16 + c.xcc) * 32, 1u, __ATOMIC_RELAXED, __HIP_MEMORY_SCOPE_AGENT);
    if (old % c.xcnt == c.xcnt - 1) {
      __builtin_amdgcn_fence(__ATOMIC_RELEASE, "agent");
      asm volatile("s_waitcnt vmcnt(0)" ::: "memory");
      const unsigned t = __hip_atomic_fetch_add(c.base + 32 * 32, 1u, __ATOMIC_RELAXED, __HIP_MEMORY_SCOPE_AGENT);
      if (t % c.nxcc == c.nxcc - 1) {
        for (unsigned i = 0; i < 16; ++i)
          __hip_atomic_store(c.base + (33 + i) * 32, c.gen, __ATOMIC_RELAXED, __HIP_MEMORY_SCOPE_AGENT);
      }
    }
    while (__hip_atomic_load(c.base + (33 + c.xcc) * 32, __ATOMIC_RELAXED, __HIP_MEMORY_SCOPE_AGENT) < c.gen) __builtin_amdgcn_s_sleep(1);
    __builtin_amdgcn_fence(__ATOMIC_ACQUIRE, "agent");
    asm volatile("s_waitcnt vmcnt(0)" ::: "memory");
  }
  __syncthreads();
}

__global__ void __launch_bounds__(512, 2) mega(P p) {
  extern __shared__ __attribute__((aligned(16))) unsigned char smraw[];
  bf16_t* sm = (bf16_t*)smraw;
  cg::grid_group grid = cg::this_grid();
  if (threadIdx.x == 0)
    ((unsigned*)smraw)[0] = __hip_atomic_fetch_add((unsigned*)(p.ws + O_BAR) + xcc_id() * 32, 1u, __ATOMIC_RELAXED, __HIP_MEMORY_SCOPE_AGENT);
  __syncthreads();
  const unsigned my_rank = (unsigned)__builtin_amdgcn_readfirstlane((int)((volatile unsigned*)smraw)[0]);
  __syncthreads();
#ifndef PHMASK
#define PHMASK 0xff
#endif
  if (PHMASK & 1) phase0(p, sm);
  grid.sync();
  BarCtx bc;
  bc.base = (unsigned*)(p.ws + O_BAR); bc.xcc = xcc_id(); bc.gen = 0;
  bc.xcnt = (unsigned)__builtin_amdgcn_readfirstlane((int)__hip_atomic_load(bc.base + bc.xcc * 32, __ATOMIC_RELAXED, __HIP_MEMORY_SCOPE_AGENT));
  bc.nxcc = 0;
  for (unsigned i = 0; i < 16; ++i) bc.nxcc += __hip_atomic_load(bc.base + i * 32, __ATOMIC_RELAXED, __HIP_MEMORY_SCOPE_AGENT) ? 1u : 0u;
  bc.nxcc = (unsigned)__builtin_amdgcn_readfirstlane((int)bc.nxcc);
  unsigned hi_cnt = 0;
  for (unsigned i = 8; i < 16; ++i) hi_cnt += __hip_atomic_load(bc.base + i * 32, __ATOMIC_RELAXED, __HIP_MEMORY_SCOPE_AGENT);
  hi_cnt = (unsigned)__builtin_amdgcn_readfirstlane((int)hi_cnt);
  Geo ge;
  if (bc.nxcc == 8 && hi_cnt == 0) { ge.xcd = (int)bc.xcc; ge.loc = (int)my_rank; ge.nloc = (int)bc.xcnt; }
  else { ge.xcd = blockIdx.x & 7; ge.loc = blockIdx.x >> 3; ge.nloc = gridDim.x >> 3; }
  unsigned* qheads = bc.base + 64 * 32;
  for (int layer = 0; layer < NL; ++layer) {
    if (PHMASK & 2) phase_inproj(p, layer, sm, ge);
    gbar(bc);
    if (PHMASK & 4) phase2(p, layer, sm, qheads + (layer * 2) * 32);
    gbar(bc);
    if (PHMASK & 8) phase3(p, layer, sm, qheads + (layer * 2 + 1) * 32);
    gbar(bc);
    if (PHMASK & 16) phase_merge(p, layer, sm, ge);
    gbar(bc);
    if (PHMASK & 32) phase_resid(p, (const bf16_t*)(p.ws + O_WO + layer * SZ_WO), (const bf16_t*)(p.ws + O_Z), 1024, sm, ge, false);
    gbar(bc);
    if (PHMASK & 64) phase_up(p, layer, sm, ge);
    gbar(bc);
    if (PHMASK & 128) phase_resid(p, (const bf16_t*)(p.ws + O_WDN + layer * SZ_WDN), (const bf16_t*)(p.ws + O_U), 4096, sm, ge, layer == NL - 1);
    gbar(bc);
  }
}

extern "C" void kernel_launch(void* const* d_in, const int* in_sizes, int n_in, void* d_out, int out_size, void* d_ws,
                              size_t ws_size, hipStream_t stream) {
  static int grid_blocks = 0;
  if (!grid_blocks) {
    int dev = 0, cus = 0, per_cu = 0;
    (void)hipGetDevice(&dev);
    (void)hipDeviceGetAttribute(&cus, hipDeviceAttributeMultiprocessorCount, dev);
    (void)hipFuncSetAttribute((const void*)mega, hipFuncAttributeMaxDynamicSharedMemorySize, LDS_BYTES);
    (void)hipOccupancyMaxActiveBlocksPerMultiprocessor(&per_cu, (const void*)mega, NTHR, LDS_BYTES);
    if (per_cu < 1) per_cu = 1;
    if (per_cu > 1) per_cu = 1;
    grid_blocks = cus * per_cu;
    if (ws_size < WS_END) fprintf(stderr, "workspace too small: %zu < %zu\n", ws_size, (size_t)WS_END);
  }
  P p{};
  p.x = (const float*)d_in[0]; p.w_in = (const float*)d_in[1]; p.qk_gain = (const float*)d_in[2];
  p.diff_lambda = (const float*)d_in[3]; p.diff_subln = (const float*)d_in[4]; p.sinks = (const float*)d_in[5];
  p.cmp_pos = (const float*)d_in[6]; p.cmp_w1 = (const float*)d_in[7]; p.cmp_w2 = (const float*)d_in[8];
  p.w_branch = (const float*)d_in[9]; p.w_out = (const float*)d_in[10]; p.norm_mix = (const float*)d_in[11];
  p.norm_mlp = (const float*)d_in[12]; p.w_up = (const float*)d_in[13]; p.w_down = (const float*)d_in[14];
  p.rel_bias = (const float*)d_in[15];
  p.out = (float*)d_out; p.ws = (unsigned char*)d_ws;
  (void)hipMemsetAsync((unsigned char*)d_ws + O_BAR, 0, 80 * 128, stream);
  void* args[] = {&p};
  hipError_t e = hipLaunchCooperativeKernel((const void*)mega, dim3(grid_blocks), dim3(NTHR), args, LDS_BYTES, stream);
  if (e != hipSuccess) fprintf(stderr, "cooperative launch failed: %s (grid %d)\n", hipGetErrorString(e), grid_blocks);
}
```

```cpp
#include <hip/hip_runtime.h>
#include <hip/hip_cooperative_groups.h>
#include <cstdio>
namespace cg = cooperative_groups;

typedef unsigned short bf16_t;
using bf16x8 = __attribute__((ext_vector_type(8))) short;
using f32x16 = __attribute__((ext_vector_type(16))) float;
using u32x4 = __attribute__((ext_vector_type(4))) unsigned;
#define DI __device__ __forceinline__
#define MFMA32(a, b, c) __builtin_amdgcn_mfma_f32_32x32x16_bf16((a), (b), (c), 0, 0, 0)

constexpr int S_ = 4096, T_ = 16384, NL = 4;
constexpr int NIN = 6680, NINP = 6912;
constexpr int LDS_BYTES = 147456;
constexpr int NTHR = 512;
constexpr int LDT = 72;
constexpr int LDK1 = 1088, LDK4 = 4160;
constexpr int WT_E = 256 * LDT;

constexpr size_t SZ_WIN = (size_t)NINP * LDK1 * 2;
constexpr size_t SZ_WBR = (size_t)3 * 1024 * 512 * 2;
constexpr size_t SZ_WO = (size_t)1024 * LDK1 * 2;
constexpr size_t SZ_WUP = (size_t)4096 * LDK1 * 2;
constexpr size_t SZ_WDN = (size_t)1024 * LDK4 * 2;
constexpr size_t SZ_W1 = (size_t)2 * 256 * 2048 * 2;
constexpr size_t SZ_W2 = (size_t)2 * 128 * 256 * 2;
constexpr size_t O_WIN = 0;
constexpr size_t O_WBR = O_WIN + NL * SZ_WIN;
constexpr size_t O_WO = O_WBR + NL * SZ_WBR;
constexpr size_t O_WUP = O_WO + NL * SZ_WO;
constexpr size_t O_WDN = O_WUP + NL * SZ_WUP;
constexpr size_t O_W1 = O_WDN + NL * SZ_WDN;
constexpr size_t O_W2 = O_W1 + NL * SZ_W1;
constexpr size_t O_POSW1 = O_W2 + NL * SZ_W2;
constexpr size_t O_LAM = O_POSW1 + (size_t)NL * 2 * 256 * 4;
constexpr size_t O_TABS = O_LAM + 256;
constexpr size_t O_PART = O_TABS + 20 * 132 * 4 + 192;
constexpr size_t O_XB = ((O_PART + (size_t)T_ * 16 * 4 + 255) / 256) * 256;
constexpr size_t O_ACT = O_XB + (size_t)T_ * LDK1 * 2;
constexpr size_t O_AQ = O_ACT;
constexpr size_t O_BQ = O_AQ + (size_t)T_ * 512 * 2;
constexpr size_t O_CQ = O_BQ + (size_t)T_ * 512 * 2;
constexpr size_t O_AK = O_CQ + (size_t)T_ * 512 * 2;
constexpr size_t O_AVT = O_AK + (size_t)T_ * 512 * 2;
constexpr size_t O_Z = O_AK;
constexpr size_t O_BK = O_AVT + (size_t)T_ * 512 * 2;
constexpr size_t SZ_S = (size_t)T_ * 128 * 2;
constexpr size_t O_BVT = O_BK + SZ_S;
constexpr size_t O_CK = O_BVT + SZ_S;
constexpr size_t O_CV = O_CK + SZ_S;
constexpr size_t O_KS = O_CV + SZ_S + 65536;
constexpr size_t O_VST = O_KS + SZ_S;
constexpr size_t O_KW = O_VST + SZ_S;
constexpr size_t O_VWT = O_KW + SZ_S;
constexpr size_t O_CGS = O_VWT + SZ_S;
constexpr size_t O_MGS = O_CGS + (size_t)T_ * 24 * 4;
constexpr size_t O_HID = O_MGS + (size_t)T_ * 3072 * 2;
constexpr size_t O_KC = O_HID + (size_t)16 * 256 * 256 * 2;
constexpr size_t O_VCT = O_KC + (size_t)8 * 256 * 64 * 2;
constexpr size_t O_U = O_ACT;
constexpr size_t O_BAR = O_VCT + (size_t)8 * 256 * 64 * 2;
constexpr size_t WS_END = O_BAR + 80 * 128;
static_assert(O_Z + (size_t)T_ * LDK1 * 2 <= O_CGS && O_U + (size_t)T_ * LDK4 * 2 <= O_HID, "u must fit in the aliased region");

struct P {
  const float* x; const float* w_in; const float* qk_gain; const float* diff_lambda; const float* diff_subln;
  const float* sinks; const float* cmp_pos; const float* cmp_w1; const float* cmp_w2; const float* w_branch;
  const float* w_out; const float* norm_mix; const float* norm_mlp; const float* w_up; const float* w_down;
  const float* rel_bias;
  float* out; unsigned char* ws;
};

DI int tidx() { int t = threadIdx.x; asm volatile("" : "+v"(t)); return t; }
DI bf16_t f2bf(float x) { unsigned u = __float_as_uint(x); u += 0x7fffu + ((u >> 16) & 1u); return (bf16_t)(u >> 16); }
DI float bf2f(bf16_t b) { return __uint_as_float(((unsigned)b) << 16); }
typedef float f32x2_t __attribute__((ext_vector_type(2)));
typedef __bf16 bf16x2_t __attribute__((ext_vector_type(2)));
DI unsigned pack2(float a, float b) { f32x2_t v = {a, b}; bf16x2_t r = __builtin_convertvector(v, bf16x2_t); return __builtin_bit_cast(unsigned, r); }
constexpr float LOG2E = 1.4426950408889634f;
constexpr float QSCL = 0.125f * LOG2E;
DI float ex2(float x) { return __builtin_amdgcn_exp2f(x); }
DI float sigmoidf_(float x) { return 1.f / (1.f + __expf(-x)); }
DI float xor32(float v) { return __shfl_xor(v, 32); }

DI void gemm_wide(const bf16_t* __restrict__ W, int ldw, const bf16_t* __restrict__ X, int ldx, int nkt,
                  f32x16 (&acc)[4][2], bf16_t* lds) {
  const int tid = tidx(), lane = tid & 63, wv = tid >> 6, wn = wv & 1, wm = wv >> 1;
  const int lr = lane & 31, lh = lane >> 5;
  const int lrow = tid >> 3, lkc = (tid & 7) * 8;
  const bf16_t* wp = W + (size_t)lrow * ldw + lkc;
  const bf16_t* xp = X + (size_t)lrow * ldx + lkc;
  const size_t wst = (size_t)64 * ldw, xst = (size_t)64 * ldx;
  u32x4 rw0, rw1, rw2, rw3, rx0, rx1, rx2, rx3;
#define GW_GLOAD(KT) { const size_t ko_ = (size_t)(KT) * 64; \
    rw0 = *(const u32x4*)(wp + ko_); rw1 = *(const u32x4*)(wp + wst + ko_); \
    rw2 = *(const u32x4*)(wp + 2 * wst + ko_); rw3 = *(const u32x4*)(wp + 3 * wst + ko_); \
    rx0 = *(const u32x4*)(xp + ko_); rx1 = *(const u32x4*)(xp + xst + ko_); \
    rx2 = *(const u32x4*)(xp + 2 * xst + ko_); rx3 = *(const u32x4*)(xp + 3 * xst + ko_); }
#define GW_LSTORE(BUF) { bf16_t* wb_ = lds + (BUF) * 2 * WT_E + lrow * LDT + lkc; bf16_t* xb_ = wb_ + WT_E; \
    *(u32x4*)(wb_) = rw0; *(u32x4*)(wb_ + 64 * LDT) = rw1; *(u32x4*)(wb_ + 128 * LDT) = rw2; *(u32x4*)(wb_ + 192 * LDT) = rw3; \
    *(u32x4*)(xb_) = rx0; *(u32x4*)(xb_ + 64 * LDT) = rx1; *(u32x4*)(xb_ + 128 * LDT) = rx2; *(u32x4*)(xb_ + 192 * LDT) = rx3; }
  u32x4 sw0, sw1, sw2, sw3, sx0, sx1, sx2, sx3;
#define GW_GLOAD_B(KT) { const size_t ko_ = (size_t)(KT) * 64; \
    sw0 = *(const u32x4*)(wp + ko_); sw1 = *(const u32x4*)(wp + wst + ko_); \
    sw2 = *(const u32x4*)(wp + 2 * wst + ko_); sw3 = *(const u32x4*)(wp + 3 * wst + ko_); \
    sx0 = *(const u32x4*)(xp + ko_); sx1 = *(const u32x4*)(xp + xst + ko_); \
    sx2 = *(const u32x4*)(xp + 2 * xst + ko_); sx3 = *(const u32x4*)(xp + 3 * xst + ko_); }
#define GW_LSTORE_B(BUF) { bf16_t* wb_ = lds + (BUF) * 2 * WT_E + lrow * LDT + lkc; bf16_t* xb_ = wb_ + WT_E; \
    *(u32x4*)(wb_) = sw0; *(u32x4*)(wb_ + 64 * LDT) = sw1; *(u32x4*)(wb_ + 128 * LDT) = sw2; *(u32x4*)(wb_ + 192 * LDT) = sw3; \
    *(u32x4*)(xb_) = sx0; *(u32x4*)(xb_ + 64 * LDT) = sx1; *(u32x4*)(xb_ + 128 * LDT) = sx2; *(u32x4*)(xb_ + 192 * LDT) = sx3; }
#define GW_KS(KT, ks) { \
      const bf16_t* wb = lds + ((KT) & 1) * 2 * WT_E + (wn * 128 + lr) * LDT + lh * 8; \
      const bf16_t* xb = lds + ((KT) & 1) * 2 * WT_E + WT_E + (wm * 64 + lr) * LDT + lh * 8; \
      const bf16x8 b0 = *(const bf16x8*)(xb + (ks) * 16), b1 = *(const bf16x8*)(xb + 32 * LDT + (ks) * 16); \
      const bf16x8 a0 = *(const bf16x8*)(wb + (ks) * 16), a1 = *(const bf16x8*)(wb + 32 * LDT + (ks) * 16); \
      const bf16x8 a2 = *(const bf16x8*)(wb + 64 * LDT + (ks) * 16), a3 = *(const bf16x8*)(wb + 96 * LDT + (ks) * 16); \
      acc[0][0] = MFMA32(a0, b0, acc[0][0]); acc[0][1] = MFMA32(a0, b1, acc[0][1]); \
      acc[1][0] = MFMA32(a1, b0, acc[1][0]); acc[1][1] = MFMA32(a1, b1, acc[1][1]); \
      acc[2][0] = MFMA32(a2, b0, acc[2][0]); acc[2][1] = MFMA32(a2, b1, acc[2][1]); \
      acc[3][0] = MFMA32(a3, b0, acc[3][0]); acc[3][1] = MFMA32(a3, b1, acc[3][1]); }
#define GW_ST2(BUF, OFF, R0, R1) { bf16_t* d_ = lds + (BUF) * 2 * WT_E + (OFF) + lrow * LDT + lkc; \
      *(u32x4*)(d_) = R0; *(u32x4*)(d_ + 64 * LDT) = R1; }
  __syncthreads();
  GW_GLOAD(0)
  GW_LSTORE(0)
  GW_GLOAD(1)
  GW_GLOAD_B(nkt > 2 ? 2 : nkt - 1)
  __syncthreads();
  for (int kt = 0; kt < nkt; kt += 2) {
    __builtin_amdgcn_sched_barrier(0);
    GW_ST2(1, 0, rw0, rw1)                         GW_KS(kt, 0)
    GW_ST2(1, 128 * LDT, rw2, rw3)                 GW_KS(kt, 1)
    GW_ST2(1, WT_E, rx0, rx1)                      GW_KS(kt, 2)
    GW_ST2(1, WT_E + 128 * LDT, rx2, rx3)          GW_KS(kt, 3)
    __builtin_amdgcn_sched_barrier(0);
    GW_GLOAD(kt + 3 < nkt ? kt + 3 : nkt - 1)
    __syncthreads();
    __builtin_amdgcn_sched_barrier(0);
    GW_ST2(0, 0, sw0, sw1)                         GW_KS(kt + 1, 0)
    GW_ST2(0, 128 * LDT, sw2, sw3)                 GW_KS(kt + 1, 1)
    GW_ST2(0, WT_E, sx0, sx1)                      GW_KS(kt + 1, 2)
    GW_ST2(0, WT_E + 128 * LDT, sx2, sx3)          GW_KS(kt + 1, 3)
    __builtin_amdgcn_sched_barrier(0);
    GW_GLOAD_B(kt + 4 < nkt ? kt + 4 : nkt - 1)
    __syncthreads();
  }
#undef GW_KS
#undef GW_ST2
#undef GW_GLOAD_B
#undef GW_LSTORE_B
#undef GW_GLOAD
#undef GW_LSTORE
}

constexpr int MID_E = (128 + 256) * LDT;
DI void gemm_mid(const bf16_t* __restrict__ W, int ldw, const bf16_t* __restrict__ X, size_t ldx, int mclamp, int kts,
                 int nkt, int m0, f32x16 (&acc)[2][2], bf16_t* lds) {
  const int tid = tidx(), lane = tid & 63, wv = tid >> 6, wn = wv & 1, wm = wv >> 1;
  const int lr = lane & 31, lh = lane >> 5;
  const int lrow = tid >> 3, lkc = (tid & 7) * 8;
  const bf16_t* wp = W + (size_t)lrow * ldw + lkc;
  const size_t wst = (size_t)64 * ldw;
  const bf16_t *xp0, *xp1, *xp2, *xp3;
  { int m;
    m = m0 + lrow;       m = m < mclamp ? m : mclamp; xp0 = X + (size_t)m * ldx + lkc;
    m = m0 + lrow + 64;  m = m < mclamp ? m : mclamp; xp1 = X + (size_t)m * ldx + lkc;
    m = m0 + lrow + 128; m = m < mclamp ? m : mclamp; xp2 = X + (size_t)m * ldx + lkc;
    m = m0 + lrow + 192; m = m < mclamp ? m : mclamp; xp3 = X + (size_t)m * ldx + lkc; }
  u32x4 rw0, rw1, rx0, rx1, rx2, rx3;
#define GM_GLOAD(KT) { \
    rw0 = *(const u32x4*)(wp + (size_t)(KT) * 64); rw1 = *(const u32x4*)(wp + wst + (size_t)(KT) * 64); \
    rx0 = *(const u32x4*)(xp0 + (size_t)(KT) * kts); rx1 = *(const u32x4*)(xp1 + (size_t)(KT) * kts); \
    rx2 = *(const u32x4*)(xp2 + (size_t)(KT) * kts); rx3 = *(const u32x4*)(xp3 + (size_t)(KT) * kts); }
#define GM_LSTORE(BUF) { bf16_t* wb_ = lds + (BUF) * MID_E + lrow * LDT + lkc; bf16_t* xb_ = wb_ + 128 * LDT; \
    *(u32x4*)(wb_) = rw0; *(u32x4*)(wb_ + 64 * LDT) = rw1; \
    *(u32x4*)(xb_) = rx0; *(u32x4*)(xb_ + 64 * LDT) = rx1; *(u32x4*)(xb_ + 128 * LDT) = rx2; *(u32x4*)(xb_ + 192 * LDT) = rx3; }
  __syncthreads();
  GM_GLOAD(0)
  GM_LSTORE(0)
  __syncthreads();
  for (int kt = 0; kt < nkt; ++kt) {
    const bool more = kt + 1 < nkt;
    if (more) GM_GLOAD(kt + 1)
    __builtin_amdgcn_sched_barrier(0);
    {
      const bf16_t* wb = lds + (kt & 1) * MID_E + (wn * 64 + lr) * LDT + lh * 8;
      const bf16_t* xb = lds + (kt & 1) * MID_E + 128 * LDT + (wm * 64 + lr) * LDT + lh * 8;
#pragma unroll
      for (int ks = 0; ks < 4; ++ks) {
        const bf16x8 a0 = *(const bf16x8*)(wb + ks * 16), a1 = *(const bf16x8*)(wb + 32 * LDT + ks * 16);
        const bf16x8 b0 = *(const bf16x8*)(xb + ks * 16), b1 = *(const bf16x8*)(xb + 32 * LDT + ks * 16);
        acc[0][0] = MFMA32(a0, b0, acc[0][0]); acc[0][1] = MFMA32(a0, b1, acc[0][1]);
        acc[1][0] = MFMA32(a1, b0, acc[1][0]); acc[1][1] = MFMA32(a1, b1, acc[1][1]);
      }
    }
    __builtin_amdgcn_sched_barrier(0);
    if (more) GM_LSTORE((kt + 1) & 1)
    __syncthreads();
  }
#undef GM_GLOAD
#undef GM_LSTORE
}

DI void zero_acc(f32x16 (&acc)[2][2]) {
#pragma unroll
  for (int a = 0; a < 2; ++a)
#pragma unroll
    for (int b = 0; b < 2; ++b)
#pragma unroll
      for (int i = 0; i < 16; ++i) acc[a][b][i] = 0.f;
}
DI void zero_acc8(f32x16 (&acc)[4][2]) {
#pragma unroll
  for (int a = 0; a < 4; ++a)
#pragma unroll
    for (int b = 0; b < 2; ++b)
#pragma unroll
      for (int i = 0; i < 16; ++i) acc[a][b][i] = 0.f;
}

DI const float* tile_rstd(const float* __restrict__ part, int m0, bf16_t* sm) {
  float* rs = (float*)((unsigned char*)sm + 139264);
  const int tid = tidx();
  if (tid < 256) {
    const float4* p4 = (const float4*)(part + (size_t)(m0 + tid) * 16);
    float s = 0.f;
#pragma unroll
    for (int i = 0; i < 4; ++i) { float4 v = p4[i]; s += v.x + v.y + v.z + v.w; }
    rs[tid] = rsqrtf(s * (1.f / 1024.f) + 1e-6f);
  }
  __syncthreads();
  return rs;
}
DI float row_rstd(const float* __restrict__ part, int m) {
  const float4* p4 = (const float4*)(part + (size_t)m * 16);
  float s = 0.f;
#pragma unroll
  for (int i = 0; i < 4; ++i) { float4 v = p4[i]; s += v.x + v.y + v.z + v.w; }
  return rsqrtf(s * (1.f / 1024.f) + 1e-6f);
}

struct Geo { int xcd, loc, nloc; };
struct TileWalk {
  int xcd, loc, nloc, ng, NT, g, i;
  DI TileWalk(int NT_, const Geo& ge) : xcd(ge.xcd), loc(ge.loc), nloc(ge.nloc), ng((NT_ + 7) >> 3), NT(NT_), g(0), i(ge.loc) {}
  DI bool next(int& mt, int& nt) {
    for (;;) {
      if (g >= ng) return false;
      if (i >= 64) { i = loc; ++g; continue; }
      mt = xcd * 8 + (i & 7); nt = g * 8 + (i >> 3);
      i += nloc;
      if (nt < NT) return true;
    }
  }
};

DI int next_task(unsigned* ctr, bf16_t* sm) {
  volatile int* slot = (volatile int*)((unsigned char*)sm + LDS_BYTES - 16);
  __syncthreads();
  if (threadIdx.x == 0) *slot = (int)__hip_atomic_fetch_add(ctr, 1u, __ATOMIC_RELAXED, __HIP_MEMORY_SCOPE_AGENT);
  __syncthreads();
  return __builtin_amdgcn_readfirstlane(*slot);
}

DI void tr_tile(const float* __restrict__ src, int ldS, int C, int r0, int c0, bf16_t* __restrict__ dst, int ldd,
                const float* __restrict__ g, int remap, float* tl) {
  const int tid = tidx() & 255;
  __syncthreads();
  {
    const int c4 = (tid & 15) * 4;
#pragma unroll
    for (int i = 0; i < 4; ++i) {
      const int r = (tid >> 4) + 16 * i;
      float4 v = make_float4(0.f, 0.f, 0.f, 0.f);
      if (c0 + c4 < C) {
        v = *(const float4*)(src + (size_t)(r0 + r) * ldS + c0 + c4);
        if (g) { const float gg = g[r0 + r]; v.x *= gg; v.y *= gg; v.z *= gg; v.w *= gg; }
      }
      float* t4 = tl + r * 65 + c4;
      t4[0] = v.x; t4[1] = v.y; t4[2] = v.z; t4[3] = v.w;
    }
  }
  __syncthreads();
  {
    const int c = tid >> 2, rq = (tid & 3) * 16;
    if (c0 + c < C) {
      int dr = c0 + c;
      if (remap) { if (dr >= 3608) dr -= 24; else if (dr >= 3584) dr += 6656 - 3584; }
      unsigned w[8];
#pragma unroll
      for (int k = 0; k < 8; ++k) w[k] = pack2(tl[(rq + 2 * k) * 65 + c], tl[(rq + 2 * k + 1) * 65 + c]);
      uint4* d4 = (uint4*)(dst + (size_t)dr * ldd + r0 + rq);
      d4[0] = make_uint4(w[0], w[1], w[2], w[3]);
      d4[1] = make_uint4(w[4], w[5], w[6], w[7]);
    }
  }
}

DI void tr_tile_wave(const float* __restrict__ src, int ldS, int C, int r0, int c0, bf16_t* __restrict__ dst, int ldd,
                     const float* __restrict__ g, int remap, float* tl) {
  const int lane = tidx() & 63;
  {
    const int c4 = (lane & 15) * 4;
    float4 v[16];
#pragma unroll
    for (int i = 0; i < 16; ++i) {
      const int r = (lane >> 4) + 4 * i;
      v[i] = make_float4(0.f, 0.f, 0.f, 0.f);
      if (c0 + c4 < C) v[i] = *(const float4*)(src + (size_t)(r0 + r) * ldS + c0 + c4);
    }
#pragma unroll
    for (int i = 0; i < 16; ++i) {
      const int r = (lane >> 4) + 4 * i;
      const float gg = g ? g[r0 + r] : 1.f;
      float* t4 = tl + r * 65 + c4;
      t4[0] = v[i].x * gg; t4[1] = v[i].y * gg; t4[2] = v[i].z * gg; t4[3] = v[i].w * gg;
    }
  }
  __builtin_amdgcn_fence(__ATOMIC_RELEASE, "wavefront");
  __builtin_amdgcn_wave_barrier();
#pragma unroll
  for (int j = 0; j < 4; ++j) {
    const int c = (lane >> 2) + 16 * j, rq = (lane & 3) * 16;
    if (c0 + c < C) {
      int dr = c0 + c;
      if (remap) { if (dr >= 3608) dr -= 24; else if (dr >= 3584) dr += 6656 - 3584; }
      unsigned w[8];
#pragma unroll
      for (int k = 0; k < 8; ++k) w[k] = pack2(tl[(rq + 2 * k) * 65 + c], tl[(rq + 2 * k + 1) * 65 + c]);
      uint4* d4 = (uint4*)(dst + (size_t)dr * ldd + r0 + rq);
      d4[0] = make_uint4(w[0], w[1], w[2], w[3]);
      d4[1] = make_uint4(w[4], w[5], w[6], w[7]);
    }
  }
  __builtin_amdgcn_wave_barrier();
}

DI void phase0(const P& p, bf16_t* sm) {
  const int tid5 = tidx(), half = tid5 >> 8, tid = tid5 & 255, lane = tid5 & 63, wv8 = tid5 >> 6;
  float* tl = (float*)sm + half * (64 * 65);
  constexpr int NTR_L = 1680 + 384 + 256 + 1024 + 1024 + 256 + 8;
  {
    float* tlw = (float*)sm + wv8 * (64 * 65);
    for (int t = blockIdx.x * 8 + wv8; t < NTR_L * NL; t += gridDim.x * 8) {
      const int layer = t / NTR_L; int r = t % NTR_L;
      if (r < 1680) {
        tr_tile_wave(p.w_in + (size_t)layer * 1024 * NIN, NIN, NIN, (r / 105) * 64, (r % 105) * 64,
                     (bf16_t*)(p.ws + O_WIN + layer * SZ_WIN), LDK1, p.norm_mix + layer * 1024, 1, tlw);
      } else if ((r -= 1680) < 384) {
        const int n3 = r / 128; r %= 128;
        tr_tile_wave(p.w_branch + ((size_t)layer * 3 + n3) * 512 * 1024, 1024, 1024, (r / 16) * 64, (r % 16) * 64,
                     (bf16_t*)(p.ws + O_WBR + layer * SZ_WBR) + (size_t)n3 * 1024 * 512, 512, nullptr, 0, tlw);
      } else if ((r -= 384) < 256) {
        tr_tile_wave(p.w_out + (size_t)layer * 1024 * 1024, 1024, 1024, (r / 16) * 64, (r % 16) * 64,
                     (bf16_t*)(p.ws + O_WO + layer * SZ_WO), LDK1, nullptr, 0, tlw);
      } else if ((r -= 256) < 1024) {
        tr_tile_wave(p.w_up + (size_t)layer * 1024 * 4096, 4096, 4096, (r / 64) * 64, (r % 64) * 64,
                     (bf16_t*)(p.ws + O_WUP + layer * SZ_WUP), LDK1, p.norm_mlp + layer * 1024, 0, tlw);
      } else if ((r -= 1024) < 1024) {
        tr_tile_wave(p.w_down + (size_t)layer * 4096 * 1024, 1024, 1024, (r / 16) * 64, (r % 16) * 64,
                     (bf16_t*)(p.ws + O_WDN + layer * SZ_WDN), LDK4, nullptr, 0, tlw);
      } else if ((r -= 1024) < 256) {
        const int kv = r / 128; r %= 128;
        tr_tile_wave(p.cmp_w1 + ((size_t)layer * 2 + kv) * 2048 * 256, 256, 256, (r / 4) * 64, (r % 4) * 64,
                     (bf16_t*)(p.ws + O_W1 + layer * SZ_W1) + (size_t)kv * 256 * 2048, 2048, nullptr, 0, tlw);
      } else {
        r -= 256;
        const int kv = r / 4; r %= 4;
        tr_tile_wave(p.cmp_w2 + ((size_t)layer * 2 + kv) * 256 * 64, 64, 64, r * 64, 0,
                     (bf16_t*)(p.ws + O_W2 + layer * SZ_W2) + (size_t)kv * 128 * 256, 256, nullptr, 0, tlw);
      }
    }
    __syncthreads();
  }
  constexpr int J_TR = 0;
  constexpr int J_X = J_TR + T_ / 8;
  constexpr int J_POS = J_X + 32;
  constexpr int J_MISC = J_POS + 1;
  constexpr int ZW_PER = ((NINP - NIN) * LDK1 / 8 + 511) / 512;
  constexpr int J_ZW = J_MISC + NL * ZW_PER;
  constexpr int J_ZW2 = J_ZW + 32;
  for (int job = blockIdx.x; job < J_ZW2; job += gridDim.x) {
    if (job < J_TR) {
      const int t = job * 2 + half;
      const int layer = t / NTR_L; int r = t % NTR_L;
      if (r < 1680) {
        tr_tile(p.w_in + (size_t)layer * 1024 * NIN, NIN, NIN, (r / 105) * 64, (r % 105) * 64,
                (bf16_t*)(p.ws + O_WIN + layer * SZ_WIN), LDK1, p.norm_mix + layer * 1024, 1, tl);
      } else if ((r -= 1680) < 384) {
        const int n3 = r / 128; r %= 128;
        tr_tile(p.w_branch + ((size_t)layer * 3 + n3) * 512 * 1024, 1024, 1024, (r / 16) * 64, (r % 16) * 64,
                (bf16_t*)(p.ws + O_WBR + layer * SZ_WBR) + (size_t)n3 * 1024 * 512, 512, nullptr, 0, tl);
      } else if ((r -= 384) < 256) {
        tr_tile(p.w_out + (size_t)layer * 1024 * 1024, 1024, 1024, (r / 16) * 64, (r % 16) * 64,
                (bf16_t*)(p.ws + O_WO + layer * SZ_WO), LDK1, nullptr, 0, tl);
      } else if ((r -= 256) < 1024) {
        tr_tile(p.w_up + (size_t)layer * 1024 * 4096, 4096, 4096, (r / 64) * 64, (r % 64) * 64,
                (bf16_t*)(p.ws + O_WUP + layer * SZ_WUP), LDK1, p.norm_mlp + layer * 1024, 0, tl);
      } else if ((r -= 1024) < 1024) {
        tr_tile(p.w_down + (size_t)layer * 4096 * 1024, 1024, 1024, (r / 16) * 64, (r % 16) * 64,
                (bf16_t*)(p.ws + O_WDN + layer * SZ_WDN), LDK4, nullptr, 0, tl);
      } else if ((r -= 1024) < 256) {
        const int kv = r / 128; r %= 128;
        tr_tile(p.cmp_w1 + ((size_t)layer * 2 + kv) * 2048 * 256, 256, 256, (r / 4) * 64, (r % 4) * 64,
                (bf16_t*)(p.ws + O_W1 + layer * SZ_W1) + (size_t)kv * 256 * 2048, 2048, nullptr, 0, tl);
      } else {
        r -= 256;
        const int kv = r / 4; r %= 4;
        tr_tile(p.cmp_w2 + ((size_t)layer * 2 + kv) * 256 * 64, 64, 64, r * 64, 0,
                (bf16_t*)(p.ws + O_W2 + layer * SZ_W2) + (size_t)kv * 128 * 256, 256, nullptr, 0, tl);
      }
    } else if (job < J_X) {
      const int row = (job - J_TR) * 8 + wv8;
      const float4* src = (const float4*)(p.x + (size_t)row * 1024);
      bf16_t* xb = (bf16_t*)(p.ws + O_XB) + (size_t)row * LDK1;
      float ss = 0.f;
#pragma unroll
      for (int i = 0; i < 4; ++i) {
        float4 v = src[lane + 64 * i];
        ss += v.x * v.x + v.y * v.y + v.z * v.z + v.w * v.w;
        *(uint2*)(xb + (lane + 64 * i) * 4) = make_uint2(pack2(v.x, v.y), pack2(v.z, v.w));
      }
#pragma unroll
      for (int o = 32; o >= 1; o >>= 1) ss += __shfl_xor(ss, o);
      float* part = (float*)(p.ws + O_PART) + (size_t)row * 16;
      if (lane < 16) part[lane] = lane == 0 ? ss : 0.f;
    } else if (job < J_POS) {
      const int jj = (job - J_X) * 2 + half; const int lk = jj >> 3, ng = jj & 7;
      const int col = ng * 32 + (tid & 31), ksl = tid >> 5;
      const float* pos = p.cmp_pos + (size_t)lk * 2048;
      const float* w1 = p.cmp_w1 + (size_t)lk * 2048 * 256;
      float s = 0.f;
      for (int k = ksl * 256; k < ksl * 256 + 256; ++k) s += pos[k] * w1[(size_t)k * 256 + col];
      __syncthreads();
      tl[tid] = s;
      __syncthreads();
      if (tid < 32) {
        float t = 0.f;
        for (int q = 0; q < 8; ++q) t += tl[q * 32 + tid];
        ((float*)(p.ws + O_POSW1))[lk * 256 + col] = t;
      }
    } else if (job < J_MISC) {
      float* tabs = (float*)(p.ws + O_TABS);
      for (int i = tid5; i < 20 * 129; i += NTHR) {
        const int h = i / 129, d = i % 129;
        int bk;
        if (d < 16) bk = d;
        else { bk = 16 + (int)(logf((float)d / 16.f) / 2.0794415416798357f * 16.f); if (bk > 31) bk = 31; }
        tabs[h * 132 + d] = p.rel_bias[bk * 20 + h] * LOG2E;
      }
      if (wv8 == 0) {
        for (int layer = 0; layer < NL; ++layer) {
          const float* lm = p.diff_lambda + layer * 256;
          float a = lm[lane] * lm[64 + lane], b = lm[128 + lane] * lm[192 + lane];
#pragma unroll
          for (int o = 32; o >= 1; o >>= 1) { a += __shfl_xor(a, o); b += __shfl_xor(b, o); }
          const float li = 0.8f - 0.6f * expf(-0.3f * (float)layer);
          if (lane == 0) ((float*)(p.ws + O_LAM))[layer] = expf(a) - expf(b) + li;
        }
      }
    } else if (job < J_ZW) {
      const int jj = job - J_MISC; const int layer = jj / ZW_PER, q = jj % ZW_PER;
      uint4* d = (uint4*)(p.ws + O_WIN + layer * SZ_WIN + (size_t)NIN * LDK1 * 2) + q * 512 + tid5;
      if (q * 512 + tid5 < (NINP - NIN) * LDK1 / 8) *d = make_uint4(0, 0, 0, 0);
    } else {
      const int jj = job - J_ZW; const int lk = jj >> 2, q = jj & 3;
      uint4* d = (uint4*)(p.ws + O_W2 + (size_t)lk * 128 * 256 * 2 + 64 * 256 * 2) + q * 512 + tid5;
      *d = make_uint4(0, 0, 0, 0);
    }
  }
}

DI bool epi_inproj_chunk(const P& p, int layer, int ch, int m0w, f32x16 (&a0)[2], f32x16 (&a1)[2], bf16_t* stg, int cp,
                         bf16_t*& rdst, int& rldd, int& rcoff, float rs0, float rs1) {
  const int lane = tidx() & 63;
  const int lr = lane & 31, lh = lane >> 5;
  enum { NORM, RAW, TRANS, SIG, CG };
  int type = RAW, ldd = 512, coff = 0, nh = 2, dv = 64, hd = 0, doff = 0;
  bf16_t* dst = nullptr; const float* gain = nullptr; float scl = 1.f;
  const float* gains = p.qk_gain + layer * 512;
  unsigned char* ws = p.ws;
  if (ch < 8) { type = NORM; dst = (bf16_t*)(ws + O_AQ); coff = ch * 64; gain = gains; scl = QSCL; }
  else if (ch < 16) { type = NORM; dst = (bf16_t*)(ws + O_AK); coff = (ch - 8) * 64; gain = gains + 64; }
  else if (ch < 24) { type = TRANS; dst = (bf16_t*)(ws + O_AVT); nh = 4; dv = 128; hd = (ch - 16) >> 1; doff = ((ch - 16) & 1) * 64; }
  else if (ch < 32) { type = NORM; dst = (bf16_t*)(ws + O_BQ); coff = (ch - 24) * 64; gain = gains + 128; scl = QSCL; }
  else if (ch < 34) { type = NORM; dst = (bf16_t*)(ws + O_BK); ldd = 128; coff = (ch - 32) * 64; gain = gains + 192; }
  else if (ch < 36) { type = TRANS; dst = (bf16_t*)(ws + O_BVT); hd = ch - 34; }
  else if (ch < 44) { type = NORM; dst = (bf16_t*)(ws + O_CQ); coff = (ch - 36) * 64; gain = gains + 256; scl = QSCL; }
  else if (ch < 46) { type = RAW; dst = (bf16_t*)(ws + O_CK); ldd = 128; coff = (ch - 44) * 64; }
  else if (ch < 48) { type = RAW; dst = (bf16_t*)(ws + O_CV); ldd = 128; coff = (ch - 46) * 64; }
  else if (ch < 50) { type = NORM; dst = (bf16_t*)(ws + O_KS); ldd = 128; coff = (ch - 48) * 64; gain = gains + 384; }
  else if (ch < 52) { type = TRANS; dst = (bf16_t*)(ws + O_VST); hd = ch - 50; }
  else if (ch < 54) { type = NORM; dst = (bf16_t*)(ws + O_KW); ldd = 128; coff = (ch - 52) * 64; gain = gains + 448; }
  else if (ch < 56) { type = TRANS; dst = (bf16_t*)(ws + O_VWT); hd = ch - 54; }
  else if (ch < 104) { type = SIG; dst = (bf16_t*)(ws + O_MGS); ldd = 3072; coff = (ch - 56) * 64; }
  else if (ch == 104) { type = CG; }
  else return false;
  rdst = dst; rldd = ldd; rcoff = coff;
#pragma unroll
  for (int mt = 0; mt < 2; ++mt) {
    const int m = m0w + mt * 32 + lr;
    const float rs = mt ? rs1 : rs0;
    float v[2][16];
    float ss = 0.f;
#pragma unroll
    for (int i = 0; i < 16; ++i) { float t = a0[mt][i] * rs; v[0][i] = t; ss += t * t; }
#pragma unroll
    for (int i = 0; i < 16; ++i) { float t = a1[mt][i] * rs; v[1][i] = t; ss += t * t; }
    if (type == NORM) {
      ss += xor32(ss);
      const float r = rsqrtf(ss * (1.f / 64.f) + 1e-6f) * scl;
#pragma unroll
      for (int nt = 0; nt < 2; ++nt)
#pragma unroll
        for (int qd = 0; qd < 4; ++qd) {
          const int n = nt * 32 + 8 * qd + 4 * lh;
          const float4 g4 = *(const float4*)(gain + n);
          *(uint2*)(stg + (mt * 32 + lr) * 136 + cp * 64 + n) =
              make_uint2(pack2(v[nt][4 * qd] * r * g4.x, v[nt][4 * qd + 1] * r * g4.y),
                         pack2(v[nt][4 * qd + 2] * r * g4.z, v[nt][4 * qd + 3] * r * g4.w));
        }
    } else if (type == RAW || type == SIG) {
#pragma unroll
      for (int nt = 0; nt < 2; ++nt)
#pragma unroll
        for (int qd = 0; qd < 4; ++qd) {
          const int n = nt * 32 + 8 * qd + 4 * lh;
          float a = v[nt][4 * qd], b = v[nt][4 * qd + 1], c = v[nt][4 * qd + 2], d = v[nt][4 * qd + 3];
          if (type == SIG) { a = sigmoidf_(a); b = sigmoidf_(b); c = sigmoidf_(c); d = sigmoidf_(d); }
          if (type == SIG)
            *(uint2*)(dst + ((size_t)((coff + n) >> 2) * T_ + m) * 4) = make_uint2(pack2(a, b), pack2(c, d));
          else
            *(uint2*)(stg + (mt * 32 + lr) * 136 + cp * 64 + n) = make_uint2(pack2(a, b), pack2(c, d));
        }
    } else if (type == TRANS) {
      const int b = m >> 12, s = m & 4095;
      bf16_t* base = dst + ((size_t)(b * nh + hd) * dv + doff) * S_ + s;
#pragma unroll
      for (int nt = 0; nt < 2; ++nt)
#pragma unroll
        for (int i = 0; i < 16; ++i) {
          const int n = nt * 32 + 8 * (i >> 2) + 4 * lh + (i & 3);
          base[(size_t)n * S_] = f2bf(v[nt][i]);
        }
    } else {
      float* cg = (float*)(ws + O_CGS) + (size_t)m * 24;
#pragma unroll
      for (int i = 0; i < 16; ++i) {
        const int n = 8 * (i >> 2) + 4 * lh + (i & 3);
        if (n < 24) cg[n] = sigmoidf_(v[0][i]);
      }
    }
  }
  return type == NORM || type == RAW;
}

DI void stage_rows_store(const bf16_t* stg, bf16_t* dst, size_t ldd, int m0w) {
  const int lane = tidx() & 63;
#pragma unroll
  for (int it = 0; it < 16; ++it) {
    const int row = it * 4 + (lane >> 4), c16 = lane & 15;
    const u32x4 v = *(const u32x4*)(stg + row * 136 + c16 * 8);
    *(u32x4*)(dst + (size_t)(m0w + row) * ldd + c16 * 8) = v;
  }
}

DI void phase_inproj(const P& p, int layer, bf16_t* sm, const Geo& ge) {
  const bf16_t* W = (const bf16_t*)(p.ws + O_WIN + layer * SZ_WIN);
  const bf16_t* X = (const bf16_t*)(p.ws + O_XB);
  TileWalk tw(27, ge);
  int mt, nt, mt_have = -1;
  float rs0 = 0.f, rs1 = 0.f;
  while (tw.next(mt, nt)) {
    if (mt != mt_have) {
      const int lane_ = tidx() & 63, wm_ = (tidx() >> 6) >> 1;
      rs0 = row_rstd((const float*)(p.ws + O_PART), mt * 256 + wm_ * 64 + (lane_ & 31));
      rs1 = row_rstd((const float*)(p.ws + O_PART), mt * 256 + wm_ * 64 + 32 + (lane_ & 31));
      mt_have = mt;
    }
    f32x16 acc[4][2]; zero_acc8(acc);
    gemm_wide(W + (size_t)nt * 256 * LDK1, LDK1, X + (size_t)mt * 256 * LDK1, LDK1, 16, acc, sm);
    const int wv = tidx() >> 6, wn = wv & 1, wm = wv >> 1;
    bf16_t* stg = sm + wv * (64 * 136);
    bf16_t *d0 = nullptr, *d1 = nullptr; int ld0 = 0, ld1 = 0, co0 = 0, co1 = 0;
    const bool s0 = epi_inproj_chunk(p, layer, nt * 4 + wn * 2, mt * 256 + wm * 64, acc[0], acc[1], stg, 0, d0, ld0, co0, rs0, rs1);
    const bool s1 = epi_inproj_chunk(p, layer, nt * 4 + wn * 2 + 1, mt * 256 + wm * 64, acc[2], acc[3], stg, 1, d1, ld1, co1, rs0, rs1);
    if (s0 && s1) stage_rows_store(stg, d0 + co0, ld0, mt * 256 + wm * 64);
  }
}

template <int NDT, int MODE, bool ALLON>
DI void attn_tile(const bf16_t* Kl, int kst, const bf16_t* Vl, const bf16x8 (&q)[4], f32x16 (&O)[NDT], float& m, float& l,
                  int kbase, int qp, int win, float cbias, const float* tab, bool lane_on) {
  const int lane = tidx() & 63, lr = lane & 31, lh = lane >> 5;
  f32x16 s[2];
#pragma unroll
  for (int st = 0; st < 2; ++st) {
#pragma unroll
    for (int i = 0; i < 16; ++i) s[st][i] = 0.f;
  }
#pragma unroll
  for (int ks = 0; ks < 4; ++ks) {
    const bf16x8 k0 = *(const bf16x8*)(Kl + lr * kst + ks * 16 + lh * 8);
    const bf16x8 k1 = *(const bf16x8*)(Kl + (32 + lr) * kst + ks * 16 + lh * 8);
    s[0] = MFMA32(k0, q[ks], s[0]);
    s[1] = MFMA32(k1, q[ks], s[1]);
  }
  float alpha, psum = 0.f;
  if (MODE == 0) {
    float tmax = fmaxf(s[0][0], s[1][0]);
#pragma unroll
    for (int i = 1; i < 16; ++i) tmax = fmaxf(tmax, fmaxf(s[0][i], s[1][i]));
    tmax = fmaxf(tmax, xor32(tmax)) + cbias;
    if (!ALLON) tmax = lane_on ? tmax : -1e30f;
    const float mn = fmaxf(m, tmax);
    alpha = ex2(m - mn);
    m = mn;
    const float mc = (ALLON || lane_on) ? mn - cbias : 1e30f;
#pragma unroll
    for (int st = 0; st < 2; ++st)
#pragma unroll
      for (int i = 0; i < 16; ++i) { const float pe = ex2(s[st][i] - mc); psum += pe; s[st][i] = pe; }
  } else {
    float tmax = -1e30f;
#pragma unroll
    for (int st = 0; st < 2; ++st)
#pragma unroll
      for (int i = 0; i < 16; ++i) {
        const int key = kbase + st * 32 + 8 * (i >> 2) + 4 * lh + (i & 3);
        float v;
        if (MODE == 1) {
          const int dist = qp - key;
          const bool ok = (ALLON || lane_on) && dist >= 0 && dist < win;
          const int di = dist < 0 ? 0 : (dist > 128 ? 128 : dist);
          v = ok ? s[st][i] + tab[di] : -1e30f;
        } else {
          v = (16 * key + 31 <= qp) ? s[st][i] : -1e30f;
        }
        s[st][i] = v;
        tmax = fmaxf(tmax, v);
      }
    tmax = fmaxf(tmax, xor32(tmax));
    const float mn = fmaxf(m, tmax);
    alpha = ex2(m - mn);
    m = mn;
#pragma unroll
    for (int st = 0; st < 2; ++st)
#pragma unroll
      for (int i = 0; i < 16; ++i) {
        const float pe = s[st][i] > -5e29f ? ex2(s[st][i] - mn) : 0.f;
        psum += pe;
        s[st][i] = pe;
      }
  }
  l = l * alpha + psum;
  if (__ballot(alpha != 1.f)) {
#pragma unroll
    for (int dt = 0; dt < NDT; ++dt)
#pragma unroll
      for (int i = 0; i < 16; ++i) O[dt][i] *= alpha;
  }
#pragma unroll
  for (int st = 0; st < 2; ++st)
#pragma unroll
    for (int sk = 0; sk < 2; ++sk) {
      u32x4 pu;
      pu[0] = pack2(s[st][8 * sk + 0], s[st][8 * sk + 1]);
      pu[1] = pack2(s[st][8 * sk + 2], s[st][8 * sk + 3]);
      pu[2] = pack2(s[st][8 * sk + 4], s[st][8 * sk + 5]);
      pu[3] = pack2(s[st][8 * sk + 6], s[st][8 * sk + 7]);
      const bf16x8 pf = __builtin_bit_cast(bf16x8, pu);
#pragma unroll
      for (int dt = 0; dt < NDT; ++dt) {
        const bf16_t* vp = Vl + (dt * 32 + lr) * 72 + st * 32 + sk * 16 + 4 * lh;
        const uint2 v0 = *(const uint2*)(vp);
        const uint2 v1 = *(const uint2*)(vp + 8);
        u32x4 vu; vu[0] = v0.x; vu[1] = v0.y; vu[2] = v1.x; vu[3] = v1.y;
        O[dt] = MFMA32(__builtin_bit_cast(bf16x8, vu), pf, O[dt]);
      }
    }
}

DI float gelu_tanh(float x) {
  const float u = 0.7978845608028654f * (x + 0.044715f * x * x * x);
  const float e = __expf(2.f * u);
  const float th = 1.f - 2.f / (e + 1.f);
  return 0.5f * x * (1.f + th);
}

DI void task_compress(const P& p, int layer, int task, bf16_t* sm) {
  const int tid = tidx(), lane = tid & 63, wv = tid >> 6, wn = wv & 1, wm = wv >> 1;
  const int lr = lane & 31, lh = lane >> 5;
  const int b = task & 3, g = (task >> 2) & 1, kv = task >> 3;
  const bf16_t* src = (const bf16_t*)(p.ws + (kv ? O_CV : O_CK)) + (size_t)b * S_ * 128 + g * 64;
  const bf16_t* W1 = (const bf16_t*)(p.ws + O_W1 + layer * SZ_W1) + (size_t)kv * 256 * 2048;
  const bf16_t* W2 = (const bf16_t*)(p.ws + O_W2 + layer * SZ_W2) + (size_t)kv * 128 * 256;
  bf16_t* hid = (bf16_t*)(p.ws + O_HID) + (size_t)((kv * 2 + g) * 4 + b) * 65536;
  const float* pw = (const float*)(p.ws + O_POSW1) + (layer * 2 + kv) * 256;
  for (int nt2 = 0; nt2 < 2; ++nt2) {
    f32x16 acc[2][2]; zero_acc(acc);
    gemm_mid(W1 + (size_t)nt2 * 128 * 2048, 2048, src, 16 * 128, 254, 128, 32, 0, acc, sm);
#pragma unroll
    for (int mt = 0; mt < 2; ++mt) {
      const int m = wm * 64 + mt * 32 + lr;
#pragma unroll
      for (int nt = 0; nt < 2; ++nt)
#pragma unroll
        for (int qd = 0; qd < 4; ++qd) {
          const int n = nt2 * 128 + wn * 64 + nt * 32 + 8 * qd + 4 * lh;
          const float4 pw4 = *(const float4*)(pw + n);
          *(uint2*)(hid + (size_t)m * 256 + n) =
              make_uint2(pack2(gelu_tanh(acc[nt][mt][4 * qd] + pw4.x), gelu_tanh(acc[nt][mt][4 * qd + 1] + pw4.y)),
                         pack2(gelu_tanh(acc[nt][mt][4 * qd + 2] + pw4.z), gelu_tanh(acc[nt][mt][4 * qd + 3] + pw4.w)));
        }
    }
  }
  __threadfence();
  __syncthreads();
  {
    f32x16 acc[2][2]; zero_acc(acc);
    gemm_mid(W2, 256, hid, 256, 1 << 30, 64, 4, 0, acc, sm);
    if (wn == 0) {
      const float* gain = p.qk_gain + layer * 512 + 320;
#pragma unroll
      for (int mt = 0; mt < 2; ++mt) {
        const int m = wm * 64 + mt * 32 + lr;
        if (kv == 0) {
          float ss = 0.f;
#pragma unroll
          for (int nt = 0; nt < 2; ++nt)
#pragma unroll
            for (int i = 0; i < 16; ++i) ss += acc[nt][mt][i] * acc[nt][mt][i];
          ss += xor32(ss);
          const float r = rsqrtf(ss * (1.f / 64.f) + 1e-6f);
          bf16_t* kc = (bf16_t*)(p.ws + O_KC) + ((size_t)(b * 2 + g) * 256 + m) * 64;
#pragma unroll
          for (int nt = 0; nt < 2; ++nt)
#pragma unroll
            for (int qd = 0; qd < 4; ++qd) {
              const int n = nt * 32 + 8 * qd + 4 * lh;
              const float4 g4 = *(const float4*)(gain + n);
              *(uint2*)(kc + n) = make_uint2(pack2(acc[nt][mt][4 * qd] * r * g4.x, acc[nt][mt][4 * qd + 1] * r * g4.y),
                                             pack2(acc[nt][mt][4 * qd + 2] * r * g4.z, acc[nt][mt][4 * qd + 3] * r * g4.w));
            }
        } else {
          bf16_t* vc = (bf16_t*)(p.ws + O_VCT) + (size_t)(b * 2 + g) * 64 * 256 + m;
#pragma unroll
          for (int nt = 0; nt < 2; ++nt)
#pragma unroll
            for (int i = 0; i < 16; ++i) {
              const int n = nt * 32 + 8 * (i >> 2) + 4 * lh + (i & 3);
              vc[(size_t)n * 256] = f2bf(acc[nt][mt][i]);
            }
        }
      }
    }
  }
}

DI void task_attnA(const P& p, int layer, int task, bf16_t* sm, int dm) {
  const int tid = tidx(), lane = tid & 63, wv = tid >> 6, c = wv & 1, qs = wv >> 1;
  const int lr = lane & 31, lh = lane >> 5;
  const int qb = 31 - (task >> 4), bh = task & 15, b = bh >> 2, h = bh & 3;
  float* tab = (float*)((unsigned char*)sm + 71680);
  bf16x8* qlds = (bf16x8*)((unsigned char*)sm + 72704) + wv * 256 + lane;
  float* xbuf = (float*)((unsigned char*)sm);
  __syncthreads();
  if (tid < 129) tab[tid] = ((const float*)(p.ws + O_TABS))[h * 132 + tid];
  const int q0 = qb * 128, qmin = q0 + qs * 32, qp = qmin + lr;
  bf16_t* aq = (bf16_t*)(p.ws + O_AQ);
  {
    const bf16_t* qptr = aq + (size_t)(b * S_ + qp) * 512 + h * 128 + c * 64 + lh * 8;
#pragma unroll
    for (int ks = 0; ks < 4; ++ks) qlds[ks * 64] = *(const bf16x8*)(qptr + ks * 16);
  }
  f32x16 O[4];
#pragma unroll
  for (int dt = 0; dt < 4; ++dt)
#pragma unroll
    for (int i = 0; i < 16; ++i) O[dt][i] = 0.f;
  float m = -1e30f, l = 0.f;
  const bf16_t* kg = (const bf16_t*)(p.ws + O_AK) + (size_t)b * S_ * 512 + h * 128;
  const bf16_t* vg = (const bf16_t*)(p.ws + O_AVT) + (size_t)((b * 4 + h) * 128) * S_;
  u32x4 rk0, rk1, rv0, rv1;
#define A_GLOAD(i, KT) { const int chk = tid + 512 * i; \
    rk##i = *(const u32x4*)(kg + (size_t)((KT) * 64 + (chk >> 4)) * 512 + (chk & 15) * 8); \
    rv##i = *(const u32x4*)(vg + (size_t)(chk >> 3) * S_ + (KT) * 64 + (chk & 7) * 8); }
#define A_LSTORE(i) { const int chk = tid + 512 * i; \
    *(u32x4*)(Kl + (chk >> 4) * 136 + (chk & 15) * 8) = rk##i; \
    *(u32x4*)(Kl + 64 * 136 + (chk >> 3) * 72 + (chk & 7) * 8) = rv##i; }
  const int kt_hi = 2 * qb + 1;
  A_GLOAD(0, 0) A_GLOAD(1, 0)
  for (int kt = 0; kt <= kt_hi; ++kt) {
    bf16_t* Kl = sm + (kt & 1) * 17920; const bf16_t* Vl = Kl + 64 * 136;
    A_LSTORE(0) A_LSTORE(1)
    if (kt < kt_hi) { A_GLOAD(0, kt + 1) A_GLOAD(1, kt + 1) }
    __syncthreads();
    if (kt * 64 <= qmin + 31) {
      bf16x8 q[4];
#pragma unroll
      for (int ks = 0; ks < 4; ++ks) q[ks] = qlds[ks * 64];
      if (kt * 64 + 63 + 128 <= qmin)
        attn_tile<4, 0, true>(Kl + c * 64, 136, Vl, q, O, m, l, kt * 64, qp, 0, tab[128], tab, true);
      else
        attn_tile<4, 1, true>(Kl + c * 64, 136, Vl, q, O, m, l, kt * 64, qp, 1 << 30, 0.f, tab, true);
    }
  }
#undef A_GLOAD
#undef A_LSTORE
  const float lt = l + xor32(l);
  const float inv = 1.f / lt;
  __syncthreads();
  if (c == 1) {
#pragma unroll
    for (int dt = 0; dt < 4; ++dt)
#pragma unroll
      for (int i = 0; i < 16; ++i) {
        const int d = dt * 32 + 8 * (i >> 2) + 4 * lh + (i & 3);
        xbuf[(qs * 128 + d) * 32 + lr] = O[dt][i] * inv;
      }
  }
  __syncthreads();
  if (c == 0) {
    const float lam = ((const float*)(p.ws + O_LAM))[layer];
    const float li = 0.8f - 0.6f * expf(-0.3f * (float)layer);
    float ss = 0.f;
#pragma unroll
    for (int dt = 0; dt < 4; ++dt)
#pragma unroll
      for (int i = 0; i < 16; ++i) {
        const int d = dt * 32 + 8 * (i >> 2) + 4 * lh + (i & 3);
        const float o = O[dt][i] * inv - lam * xbuf[(qs * 128 + d) * 32 + lr];
        O[dt][i] = o;
        ss += o * o;
      }
    ss += xor32(ss);
    const float r = rsqrtf(ss * (1.f / 128.f) + 1e-6f) * (1.f - li);
    const float* sub = p.diff_subln + layer * 128;
    bf16_t* dst = (dm ? (bf16_t*)(p.ws + WS_END) : aq) + (size_t)(b * S_ + qp) * 512 + h * 128;
#pragma unroll
    for (int dt = 0; dt < 4; ++dt)
#pragma unroll
      for (int qd = 0; qd < 4; ++qd) {
        const int d = dt * 32 + 8 * qd + 4 * lh;
        const float4 g4 = *(const float4*)(sub + d);
        *(uint2*)(dst + d) = make_uint2(pack2(O[dt][4 * qd] * r * g4.x, O[dt][4 * qd + 1] * r * g4.y),
                                        pack2(O[dt][4 * qd + 2] * r * g4.z, O[dt][4 * qd + 3] * r * g4.w));
      }
  }
}

struct KVRegs { u32x4 k0, v0; };
DI void kv_gload(KVRegs& r, const bf16_t* kg, size_t kld, const bf16_t* vg, size_t vld, int key0) {
  const int c0 = tidx();
  r.k0 = *(const u32x4*)(kg + (size_t)(key0 + (c0 >> 3)) * kld + (c0 & 7) * 8);
  r.v0 = *(const u32x4*)(vg + (size_t)(c0 >> 3) * vld + key0 + (c0 & 7) * 8);
}
DI void kv_lstore(const KVRegs& r, bf16_t* Kl, bf16_t* Vl) {
  const int c0 = tidx();
  *(u32x4*)(Kl + (c0 >> 3) * 72 + (c0 & 7) * 8) = r.k0;
  *(u32x4*)(Vl + (c0 >> 3) * 72 + (c0 & 7) * 8) = r.v0;
}

DI void task_attnB(const P& p, int layer, int task, bf16_t* sm, int dm) {
  const int tid = tidx(), lane = tid & 63, wv = tid >> 6, hr = wv & 3, qs = wv >> 2;
  const int lr = lane & 31, lh = lane >> 5;
  const int qb = 63 - (task >> 3), bg = task & 7, b = bg >> 1, g = bg & 1, head = g * 4 + hr;
  float* tabs = (float*)((unsigned char*)sm + 36864);
  __syncthreads();
  for (int i = tid; i < 4 * 129; i += NTHR) {
    const int r = i / 129, d = i % 129;
    tabs[r * 132 + d] = ((const float*)(p.ws + O_TABS))[(4 + g * 4 + r) * 132 + d];
  }
  const int q0 = qb * 64, qmin = q0 + qs * 32, qp = qmin + lr;
  bf16_t* bq = (bf16_t*)(p.ws + O_BQ);
  bf16x8 q[4];
  {
    const bf16_t* qptr = bq + (size_t)(b * S_ + qp) * 512 + head * 64 + lh * 8;
#pragma unroll
    for (int ks = 0; ks < 4; ++ks) q[ks] = *(const bf16x8*)(qptr + ks * 16);
  }
  f32x16 O[2];
#pragma unroll
  for (int dt = 0; dt < 2; ++dt)
#pragma unroll
    for (int i = 0; i < 16; ++i) O[dt][i] = 0.f;
  float m = p.sinks[layer * 8 + head] * LOG2E, l = lh == 0 ? 1.f : 0.f;
  const bf16_t* kg = (const bf16_t*)(p.ws + O_BK) + (size_t)b * S_ * 128 + g * 64;
  const bf16_t* vg = (const bf16_t*)(p.ws + O_BVT) + (size_t)((b * 2 + g) * 64) * S_;
  const int kt_lo = q0 >= 127 ? (q0 - 127) >> 6 : 0, kt_hi = qb;
  KVRegs R;
  kv_gload(R, kg, 128, vg, S_, kt_lo * 64);
  for (int kt = kt_lo; kt <= kt_hi; ++kt) {
    bf16_t* Kl = sm + (kt & 1) * 9216; bf16_t* Vl = Kl + 4608;
    kv_lstore(R, Kl, Vl);
    if (kt < kt_hi) kv_gload(R, kg, 128, vg, S_, (kt + 1) * 64);
    __syncthreads();
    if (kt * 64 <= qmin + 31 && kt * 64 + 63 + 127 >= qmin)
      attn_tile<2, 1, true>(Kl, 72, Vl, q, O, m, l, kt * 64, qp, 128, 0.f, tabs + hr * 132, true);
  }
  const float lt = l + xor32(l);
  const float inv = 1.f / lt;
  bf16_t* dst = (dm ? (bf16_t*)(p.ws + WS_END) : bq) + (size_t)(b * S_ + qp) * 512 + head * 64;
#pragma unroll
  for (int dt = 0; dt < 2; ++dt)
#pragma unroll
    for (int qd = 0; qd < 4; ++qd) {
      const int d = dt * 32 + 8 * qd + 4 * lh;
      *(uint2*)(dst + d) = make_uint2(pack2(O[dt][4 * qd] * inv, O[dt][4 * qd + 1] * inv),
                                      pack2(O[dt][4 * qd + 2] * inv, O[dt][4 * qd + 3] * inv));
    }
}

DI void phase2(const P& p, int layer, bf16_t* sm, unsigned* qhead, int dm = 0) {
  for (;;) {
    const int task = next_task(qhead, sm);
    if (task >= 16 + 512 + 512) break;
    if (task < 16) task_compress(p, layer, task, sm);
    else if (task < 16 + 512) task_attnA(p, layer, task - 16, sm, dm);
    else task_attnB(p, layer, task - 528, sm, dm);
  }
}

DI void task_nsa(const P& p, int layer, int task, bf16_t* sm, int dm) {
  const int tid = tidx(), lane = tid & 63, wv = tid >> 6, hr = wv & 3, qs = wv >> 2;
  const int lr = lane & 31, lh = lane >> 5;
  const int qb = 63 - (task >> 3), bg = task & 7, b = bg >> 1, g = bg & 1, head = g * 4 + hr;
  float* tabs = (float*)((unsigned char*)sm + 36864);
  float* cbuf = (float*)((unsigned char*)sm + 39168);
  unsigned long long* masks = (unsigned long long*)((unsigned char*)sm + 55808);
  float* outl = (float*)((unsigned char*)sm + 56320) + wv * 2048 + lane;
  int itc = 0;
  __syncthreads();
  for (int i = tid; i < 4 * 129; i += NTHR) {
    const int r = i / 129, d = i % 129;
    tabs[r * 132 + d] = ((const float*)(p.ws + O_TABS))[(12 + g * 4 + r) * 132 + d];
  }
  for (int i = tid; i < 64 * 65; i += NTHR) cbuf[i] = 0.f;
  const float* tab = tabs + hr * 132;
  const int q0 = qb * 64, qmin = q0 + qs * 32, ql = qs * 32 + lr, qp = q0 + ql;
  bf16_t* cq = (bf16_t*)(p.ws + O_CQ);
  bf16x8 q[4];
  {
    const bf16_t* qptr = cq + (size_t)(b * S_ + qp) * 512 + head * 64 + lh * 8;
#pragma unroll
    for (int ks = 0; ks < 4; ++ks) q[ks] = *(const bf16x8*)(qptr + ks * 16);
  }
  const float* cg = (const float*)(p.ws + O_CGS) + (size_t)(b * S_ + qp) * 24 + head * 3;
  const float g0 = cg[0], g1 = cg[1], g2 = cg[2];
  f32x16 O[2];
  KVRegs R;
  {
    int nct = (((q0 + 32) >> 4) + 1 + 63) >> 6; if (nct > 4) nct = 4;
    const bf16_t* kg = (const bf16_t*)(p.ws + O_KC) + (size_t)(b * 2 + g) * 256 * 64;
    const bf16_t* vg = (const bf16_t*)(p.ws + O_VCT) + (size_t)(b * 2 + g) * 64 * 256;
#pragma unroll
    for (int dt = 0; dt < 2; ++dt)
#pragma unroll
      for (int i = 0; i < 16; ++i) O[dt][i] = 0.f;
    float m = -1e30f, l = 0.f;
    kv_gload(R, kg, 64, vg, 256, 0);
    for (int ct = 0; ct < nct; ++ct, ++itc) {
      bf16_t* Kl = sm + (itc & 1) * 9216; bf16_t* Vl = Kl + 4608;
      kv_lstore(R, Kl, Vl);
      if (ct + 1 < nct) kv_gload(R, kg, 64, vg, 256, (ct + 1) * 64);
      __syncthreads();
      attn_tile<2, 2, true>(Kl, 72, Vl, q, O, m, l, ct * 64, qp, 0, 0.f, tab, true);
    }
    const float lt = l + xor32(l);
    const float inv = lt > 0.f ? 1.f / lt : 0.f;
    {
      const float sc = g0 * inv;
#pragma unroll
      for (int dt = 0; dt < 2; ++dt)
#pragma unroll
        for (int i = 0; i < 16; ++i) outl[(dt * 16 + i) * 64] = sc * O[dt][i];
    }
    float carry = 0.f;
    kv_gload(R, kg, 64, vg, 256, 0);
    for (int ct = 0; ct < nct; ++ct, ++itc) {
      bf16_t* Kl = sm + (itc & 1) * 9216; bf16_t* Vl = Kl + 4608;
      kv_lstore(R, Kl, Vl);
      if (ct + 1 < nct) kv_gload(R, kg, 64, vg, 256, (ct + 1) * 64);
      __syncthreads();
      float val[2][4];
#pragma unroll
      for (int st = 0; st < 2; ++st) {
        f32x16 s;
#pragma unroll
        for (int i = 0; i < 16; ++i) s[i] = 0.f;
#pragma unroll
        for (int ks = 0; ks < 4; ++ks) {
          bf16x8 kf = *(const bf16x8*)(Kl + (st * 32 + lr) * 72 + ks * 16 + lh * 8);
          s = MFMA32(kf, q[ks], s);
        }
        float pq[4], pl[4], other[4];
#pragma unroll
        for (int g4 = 0; g4 < 4; ++g4) {
          float sum = 0.f, last = 0.f;
#pragma unroll
          for (int e = 0; e < 4; ++e) {
            const int cc = ct * 64 + st * 32 + 8 * g4 + 4 * lh + e;
            const float pe = (16 * cc + 31 <= qp) ? ex2(s[4 * g4 + e] - m) * inv : 0.f;
            sum += pe; last = pe;
          }
          pq[g4] = sum; pl[g4] = last;
        }
#pragma unroll
        for (int g4 = 0; g4 < 4; ++g4) other[g4] = xor32(pl[g4]);
        val[st][0] = pq[0] + (lh ? other[0] : carry);
        val[st][1] = pq[1] + (lh ? other[1] : other[0]);
        val[st][2] = pq[2] + (lh ? other[2] : other[1]);
        val[st][3] = pq[3] + (lh ? other[3] : other[2]);
        carry = other[3];
      }
      for (int w = 0; w < 4; ++w) {
        if (hr == w) {
#pragma unroll
          for (int st = 0; st < 2; ++st)
#pragma unroll
            for (int g4 = 0; g4 < 4; ++g4) cbuf[(ct * 16 + st * 8 + 2 * g4 + lh) * 65 + ql] += val[st][g4];
        }
        __syncthreads();
      }
    }
  }
  __syncthreads();
  for (int qi = 0; qi < 8; ++qi) {
    const int qq = wv * 8 + qi, qpos = q0 + qq, j = lane, cur = qpos >> 6;
    const float imp = cbuf[j * 65 + qq];
    const bool valid = j <= cur;
    const bool forced = (j == 0) || (j == cur) || (j == cur - 1);
    const float score = valid ? imp + (forced ? 1e4f : 0.f) : -1e30f;
    int rank = 0;
#pragma unroll 4
    for (int jp = 0; jp < 64; ++jp) {
      const float sj = __int_as_float(__builtin_amdgcn_readlane(__float_as_int(score), jp));
      rank += ((sj > score) || (sj == score && jp < j)) ? 1 : 0;
    }
    const unsigned long long mk = __ballot(rank < 16);
    if (lane == 0) masks[qq] = mk;
  }
  __syncthreads();
  const unsigned long long mymask = masks[ql];
  unsigned long long un = 0ull;
  for (int i = 0; i < 64; ++i) un |= masks[i];
  {
    const int cmax = qb;
    unsigned long long todo = un & (cmax == 63 ? ~0ull : ((1ull << (cmax + 1)) - 1ull));
    const bf16_t* kg = (const bf16_t*)(p.ws + O_KS) + (size_t)b * S_ * 128 + g * 64;
    const bf16_t* vg = (const bf16_t*)(p.ws + O_VST) + (size_t)((b * 2 + g) * 64) * S_;
#pragma unroll
    for (int dt = 0; dt < 2; ++dt)
#pragma unroll
      for (int i = 0; i < 16; ++i) O[dt][i] = 0.f;
    float m = -1e30f, l = 0.f;
    kv_gload(R, kg, 128, vg, S_, (__ffsll((long long)todo) - 1) * 64);
    for (; todo; ++itc) {
      const int j = __ffsll((long long)todo) - 1;
      todo &= todo - 1ull;
      bf16_t* Kl = sm + (itc & 1) * 9216; bf16_t* Vl = Kl + 4608;
      kv_lstore(R, Kl, Vl);
      if (todo) kv_gload(R, kg, 128, vg, S_, (__ffsll((long long)todo) - 1) * 64);
      __syncthreads();
      const bool on = (mymask >> j) & 1ull;
      if (j * 64 <= qmin + 31 && __ballot(on)) {
        if (j * 64 + 63 + 128 <= qmin)
          attn_tile<2, 0, false>(Kl, 72, Vl, q, O, m, l, j * 64, qp, 0, tab[128], tab, on);
        else
          attn_tile<2, 1, false>(Kl, 72, Vl, q, O, m, l, j * 64, qp, 1 << 30, 0.f, tab, on);
      }
    }
    const float lt = l + xor32(l);
    const float inv = lt > 0.f ? 1.f / lt : 0.f;
    {
      const float sc = g1 * inv;
#pragma unroll
      for (int dt = 0; dt < 2; ++dt)
#pragma unroll
        for (int i = 0; i < 16; ++i) outl[(dt * 16 + i) * 64] += sc * O[dt][i];
    }
  }
  {
    const bf16_t* kg = (const bf16_t*)(p.ws + O_KW) + (size_t)b * S_ * 128 + g * 64;
    const bf16_t* vg = (const bf16_t*)(p.ws + O_VWT) + (size_t)((b * 2 + g) * 64) * S_;
#pragma unroll
    for (int dt = 0; dt < 2; ++dt)
#pragma unroll
      for (int i = 0; i < 16; ++i) O[dt][i] = 0.f;
    float m = -1e30f, l = 0.f;
    const int kt_lo = q0 >= 511 ? (q0 - 511) >> 6 : 0, kt_hi = qb;
    kv_gload(R, kg, 128, vg, S_, kt_lo * 64);
    for (int kt = kt_lo; kt <= kt_hi; ++kt, ++itc) {
      bf16_t* Kl = sm + (itc & 1) * 9216; bf16_t* Vl = Kl + 4608;
      kv_lstore(R, Kl, Vl);
      if (kt < kt_hi) kv_gload(R, kg, 128, vg, S_, (kt + 1) * 64);
      __syncthreads();
      if (kt * 64 <= qmin + 31 && kt * 64 + 63 + 511 >= qmin) {
        if (kt * 64 + 63 + 128 <= qmin && qmin + 31 - kt * 64 < 512)
          attn_tile<2, 0, true>(Kl, 72, Vl, q, O, m, l, kt * 64, qp, 0, tab[128], tab, true);
        else
          attn_tile<2, 1, true>(Kl, 72, Vl, q, O, m, l, kt * 64, qp, 512, 0.f, tab, true);
      }
    }
    const float lt = l + xor32(l);
    const float inv = 1.f / lt;
    {
      const float sc = g2 * inv;
#pragma unroll
      for (int dt = 0; dt < 2; ++dt)
#pragma unroll
        for (int i = 0; i < 16; ++i) O[dt][i] = outl[(dt * 16 + i) * 64] + sc * O[dt][i];
    }
  }
  bf16_t* dst = (dm ? (bf16_t*)(p.ws + WS_END) : cq) + (size_t)(b * S_ + qp) * 512 + head * 64;
#pragma unroll
  for (int dt = 0; dt < 2; ++dt)
#pragma unroll
    for (int qd = 0; qd < 4; ++qd) {
      const int d = dt * 32 + 8 * qd + 4 * lh;
      *(uint2*)(dst + d) = make_uint2(pack2(O[dt][4 * qd], O[dt][4 * qd + 1]), pack2(O[dt][4 * qd + 2], O[dt][4 * qd + 3]));
    }
}

DI void phase3(const P& p, int layer, bf16_t* sm, unsigned* qhead, int dm = 0) {
  for (;;) {
    const int task = next_task(qhead, sm);
    if (task >= 512) break;
    task_nsa(p, layer, task, sm, dm);
  }
}

DI void phase_merge(const P& p, int layer, bf16_t* sm, const Geo& ge) {
  const int tid = tidx(), lane = tid & 63, wv = tid >> 6, wn = wv & 1, wm = wv >> 1;
  const int lr = lane & 31, lh = lane >> 5;
  const bf16_t* W = (const bf16_t*)(p.ws + O_WBR + layer * SZ_WBR);
  const bf16_t* mgs = (const bf16_t*)(p.ws + O_MGS);
  bf16_t* z = (bf16_t*)(p.ws + O_Z);
  TileWalk tw(8, ge);
  int mt_, nt_;
  while (tw.next(mt_, nt_)) {
    unsigned zp[2][2][8];
#pragma unroll
    for (int a_ = 0; a_ < 2; ++a_)
#pragma unroll
      for (int b_ = 0; b_ < 2; ++b_)
#pragma unroll
        for (int i = 0; i < 8; ++i) zp[a_][b_][i] = 0u;
    for (int n3 = 0; n3 < 3; ++n3) {
      const bf16_t* X = (const bf16_t*)(p.ws + (n3 == 0 ? O_AQ : (n3 == 1 ? O_BQ : O_CQ)));
      f32x16 acc[2][2]; zero_acc(acc);
      gemm_mid(W + ((size_t)n3 * 1024 + nt_ * 128) * 512, 512, X, 512, 1 << 30, 64, 8, mt_ * 256, acc, sm);
#pragma unroll
      for (int mt = 0; mt < 2; ++mt) {
        const int m = mt_ * 256 + wm * 64 + mt * 32 + lr;
#pragma unroll
        for (int nt = 0; nt < 2; ++nt)
#pragma unroll
          for (int qd = 0; qd < 4; ++qd) {
            const int n = nt_ * 128 + wn * 64 + nt * 32 + 8 * qd + 4 * lh;
            const uint2 gq = *(const uint2*)(mgs + ((size_t)((n3 * 1024 + n) >> 2) * T_ + m) * 4);
            const unsigned z01 = zp[nt][mt][2 * qd], z23 = zp[nt][mt][2 * qd + 1];
            const float v0 = bf2f((bf16_t)(z01 & 0xffff)) + bf2f((bf16_t)(gq.x & 0xffff)) * acc[nt][mt][4 * qd];
            const float v1 = bf2f((bf16_t)(z01 >> 16)) + bf2f((bf16_t)(gq.x >> 16)) * acc[nt][mt][4 * qd + 1];
            const float v2 = bf2f((bf16_t)(z23 & 0xffff)) + bf2f((bf16_t)(gq.y & 0xffff)) * acc[nt][mt][4 * qd + 2];
            const float v3 = bf2f((bf16_t)(z23 >> 16)) + bf2f((bf16_t)(gq.y >> 16)) * acc[nt][mt][4 * qd + 3];
            zp[nt][mt][2 * qd] = pack2(v0, v1);
            zp[nt][mt][2 * qd + 1] = pack2(v2, v3);
          }
      }
    }
    bf16_t* stg = sm + wv * (64 * 72);
#pragma unroll
    for (int mt = 0; mt < 2; ++mt)
#pragma unroll
      for (int nt = 0; nt < 2; ++nt)
#pragma unroll
        for (int qd = 0; qd < 4; ++qd)
          *(uint2*)(stg + (mt * 32 + lr) * 72 + nt * 32 + 8 * qd + 4 * lh) = make_uint2(zp[nt][mt][2 * qd], zp[nt][mt][2 * qd + 1]);
#pragma unroll
    for (int it = 0; it < 8; ++it) {
      const int row = it * 8 + (lane >> 3), c16 = lane & 7;
      const u32x4 v = *(const u32x4*)(stg + row * 72 + c16 * 8);
      *(u32x4*)(z + (size_t)(mt_ * 256 + wm * 64 + row) * LDK1 + nt_ * 128 + wn * 64 + c16 * 8) = v;
    }
  }
}

DI void phase_resid(const P& p, const bf16_t* W, const bf16_t* X, int K, bf16_t* sm, const Geo& ge, bool last) {
  const int tid = tidx(), lane = tid & 63, wv = tid >> 6, wn = wv & 1, wm = wv >> 1;
  const int lr = lane & 31, lh = lane >> 5;
  bf16_t* xb = (bf16_t*)(p.ws + O_XB);
  float* part = (float*)(p.ws + O_PART);
  TileWalk tw(4, ge);
  int mt_, nt_;
  while (tw.next(mt_, nt_)) {
    f32x16 acc[4][2]; zero_acc8(acc);
    const int ldk = K + 64;
    gemm_wide(W + (size_t)nt_ * 256 * ldk, ldk, X + (size_t)mt_ * 256 * ldk, ldk, K / 64, acc, sm);
    float* stg = (float*)sm + wv * (64 * 68);
    const int m0w = mt_ * 256 + wm * 64, n0w = nt_ * 256 + wn * 128;
#pragma unroll
    for (int cp = 0; cp < 2; ++cp) {
#pragma unroll 4
      for (int it = 0; it < 8; ++it) {
        const int row = it * 8 + (lane >> 3), c8 = (lane & 7) * 8;
        const u32x4 raw = *(const u32x4*)(xb + (size_t)(m0w + row) * LDK1 + n0w + cp * 64 + c8);
        float* d = stg + row * 68 + c8;
        *(float4*)(d) = make_float4(__uint_as_float(raw[0] << 16), __uint_as_float(raw[0] & 0xffff0000u),
                                    __uint_as_float(raw[1] << 16), __uint_as_float(raw[1] & 0xffff0000u));
        *(float4*)(d + 4) = make_float4(__uint_as_float(raw[2] << 16), __uint_as_float(raw[2] & 0xffff0000u),
                                        __uint_as_float(raw[3] << 16), __uint_as_float(raw[3] & 0xffff0000u));
      }
#pragma unroll
      for (int mt = 0; mt < 2; ++mt) {
        float ss = 0.f;
#pragma unroll
        for (int nh = 0; nh < 2; ++nh)
#pragma unroll
          for (int qd = 0; qd < 4; ++qd) {
            const int nt = cp * 2 + nh;
            float4* sp = (float4*)(stg + (mt * 32 + lr) * 68 + nh * 32 + 8 * qd + 4 * lh);
            float4 v = *sp;
            v.x += acc[nt][mt][4 * qd]; v.y += acc[nt][mt][4 * qd + 1]; v.z += acc[nt][mt][4 * qd + 2]; v.w += acc[nt][mt][4 * qd + 3];
            *sp = v;
            ss += v.x * v.x + v.y * v.y + v.z * v.z + v.w * v.w;
          }
        ss += xor32(ss);
        if (lh == 0) part[(size_t)(m0w + mt * 32 + lr) * 16 + nt_ * 4 + wn * 2 + cp] = ss;
      }
#pragma unroll 4
      for (int it = 0; it < 16; ++it) {
        const int row = it * 4 + (lane >> 4), c4 = (lane & 15) * 4;
        const float4 v = *(const float4*)(stg + row * 68 + c4);
        if (last) *(float4*)(p.out + (size_t)(m0w + row) * 1024 + n0w + cp * 64 + c4) = v;
        *(uint2*)(xb + (size_t)(m0w + row) * LDK1 + n0w + cp * 64 + c4) = make_uint2(pack2(v.x, v.y), pack2(v.z, v.w));
      }
    }
  }
}

DI void phase_up(const P& p, int layer, bf16_t* sm, const Geo& ge) {
  const int tid = tidx(), lane = tid & 63, wv = tid >> 6, wn = wv & 1, wm = wv >> 1;
  const int lr = lane & 31, lh = lane >> 5;
  const bf16_t* W = (const bf16_t*)(p.ws + O_WUP + layer * SZ_WUP);
  const bf16_t* X = (const bf16_t*)(p.ws + O_XB);
  const float* part = (const float*)(p.ws + O_PART);
  bf16_t* u = (bf16_t*)(p.ws + O_U);
  TileWalk tw(16, ge);
  int mt_, nt_, mt_have = -1;
  float rs0 = 0.f, rs1 = 0.f;
  while (tw.next(mt_, nt_)) {
    if (mt_ != mt_have) {
      rs0 = row_rstd(part, mt_ * 256 + wm * 64 + lr);
      rs1 = row_rstd(part, mt_ * 256 + wm * 64 + 32 + lr);
      mt_have = mt_;
    }
    f32x16 acc[4][2]; zero_acc8(acc);
    gemm_wide(W + (size_t)nt_ * 256 * LDK1, LDK1, X + (size_t)mt_ * 256 * LDK1, LDK1, 16, acc, sm);
    bf16_t* stg = sm + wv * (64 * 136);
#pragma unroll
    for (int mt = 0; mt < 2; ++mt) {
      const float rs = mt ? rs1 : rs0;
#pragma unroll
      for (int nt = 0; nt < 4; ++nt)
#pragma unroll
        for (int qd = 0; qd < 4; ++qd) {
          const int n = nt_ * 256 + wn * 128 + nt * 32 + 8 * qd + 4 * lh;
          float a = fmaxf(acc[nt][mt][4 * qd] * rs, 0.f), b = fmaxf(acc[nt][mt][4 * qd + 1] * rs, 0.f);
          float c = fmaxf(acc[nt][mt][4 * qd + 2] * rs, 0.f), d = fmaxf(acc[nt][mt][4 * qd + 3] * rs, 0.f);
          *(uint2*)(stg + (mt * 32 + lr) * 136 + nt * 32 + 8 * qd + 4 * lh) = make_uint2(pack2(a * a, b * b), pack2(c * c, d * d));
        }
    }
    stage_rows_store(stg, u + nt_ * 256 + wn * 128, LDK4, mt_ * 256 + wm * 64);
  }
}

DI unsigned xcc_id() { return (unsigned)__builtin_amdgcn_s_getreg((3 << 11) | 20) & 0xFu; }
struct BarCtx { unsigned* base; unsigned xcc, xcnt, nxcc, gen; };
DI void gbar(BarCtx& c) {
  ++c.gen;
  asm volatile("s_waitcnt vmcnt(0) lgkmcnt(0)" ::: "memory");
  __syncthreads();
  if (threadIdx.x == 0) {
    const unsigned old = __hip_atomic_fetch_add(c.base + (16 + c.xcc) * 32, 1u, __ATOMIC_RELAXED, __HIP_MEMORY_SCOPE_AGENT);
    if (old % c.xcnt == c.xcnt - 1) {
      __builtin_amdgcn_fence(__ATOMIC_RELEASE, "agent");
      asm volatile("s_waitcnt vmcnt(0)" ::: "memory");
      const unsigned t = __hip_atomic_fetch_add(c.base + 32 * 32, 1u, __ATOMIC_RELAXED, __HIP_MEMORY_SCOPE_AGENT);
      if (t % c.nxcc == c.nxcc - 1) {
        for (unsigned i = 0; i < 16; ++i)
          __hip_atomic_store(c.base + (33 + i) * 32, c.gen, __ATOMIC_RELAXED, __HIP_MEMORY_SCOPE_AGENT);
      }
    }
    while (__hip_atomic_load(c.base + (33 + c.xcc) * 32, __ATOMIC_RELAXED, __HIP_MEMORY_SCOPE_AGENT) < c.gen) __builtin_amdgcn_s_sleep(1);
    __builtin_amdgcn_fence(__ATOMIC_ACQUIRE, "agent");
    asm volatile("s_waitcnt vmcnt(0)" ::: "memory");
  }
  __syncthreads();
}

__global__ void __launch_bounds__(512, 2) mega(P p) {
  extern __shared__ __attribute__((aligned(16))) unsigned char smraw[];
  bf16_t* sm = (bf16_t*)smraw;
  cg::grid_group grid = cg::this_grid();
  if (threadIdx.x == 0)
    ((unsigned*)smraw)[0] = __hip_atomic_fetch_add((unsigned*)(p.ws + O_BAR) + xcc_id() * 32, 1u, __ATOMIC_RELAXED, __HIP_MEMORY_SCOPE_AGENT);
  __syncthreads();
  const unsigned my_rank = (unsigned)__builtin_amdgcn_readfirstlane((int)((volatile unsigned*)smraw)[0]);
  __syncthreads();
#ifndef PHMASK
#define PHMASK 0xff
#endif
  if (PHMASK & 1) phase0(p, sm);
  grid.sync();
  BarCtx bc;
  bc.base = (unsigned*)(p.ws + O_BAR); bc.xcc = xcc_id(); bc.gen = 0;
  bc.xcnt = (unsigned)__builtin_amdgcn_readfirstlane((int)__hip_atomic_load(bc.base + bc.xcc * 32, __ATOMIC_RELAXED, __HIP_MEMORY_SCOPE_AGENT));
  bc.nxcc = 0;
  for (unsigned i = 0; i < 16; ++i) bc.nxcc += __hip_atomic_load(bc.base + i * 32, __ATOMIC_RELAXED, __HIP_MEMORY_SCOPE_AGENT) ? 1u : 0u;
  bc.nxcc = (unsigned)__builtin_amdgcn_readfirstlane((int)bc.nxcc);
  unsigned hi_cnt = 0;
  for (unsigned i = 8; i < 16; ++i) hi_cnt += __hip_atomic_load(bc.base + i * 32, __ATOMIC_RELAXED, __HIP_MEMORY_SCOPE_AGENT);
  hi_cnt = (unsigned)__builtin_amdgcn_readfirstlane((int)hi_cnt);
  Geo ge;
  if (bc.nxcc == 8 && hi_cnt == 0) { ge.xcd = (int)bc.xcc; ge.loc = (int)my_rank; ge.nloc = (int)bc.xcnt; }
  else { ge.xcd = blockIdx.x & 7; ge.loc = blockIdx.x >> 3; ge.nloc = gridDim.x >> 3; }
  unsigned* qheads = bc.base + 64 * 32;
  for (int layer = 0; layer < NL; ++layer) {
    if (PHMASK & 2) phase_inproj(p, layer, sm, ge);
    gbar(bc);
    if (PHMASK & 4) phase2(p, layer, sm, qheads + (layer * 2) * 32);
    gbar(bc);
    if (PHMASK & 8) phase3(p, layer, sm, qheads + (layer * 2 + 1) * 32);
    gbar(bc);
    if (PHMASK & 16) phase_merge(p, layer, sm, ge);
    gbar(bc);
    if (PHMASK & 32) phase_resid(p, (const bf16_t*)(p.ws + O_WO + layer * SZ_WO), (const bf16_t*)(p.ws + O_Z), 1024, sm, ge, false);
    gbar(bc);
    if (PHMASK & 64) phase_up(p, layer, sm, ge);
    gbar(bc);
    if (PHMASK & 128) phase_resid(p, (const bf16_t*)(p.ws + O_WDN + layer * SZ_WDN), (const bf16_t*)(p.ws + O_U), 4096, sm, ge, layer == NL - 1);
    gbar(bc);
  }
}

extern "C" void kernel_launch(void* const* d_in, const int* in_sizes, int n_in, void* d_out, int out_size, void* d_ws,
                              size_t ws_size, hipStream_t stream) {
  static int grid_blocks = 0;
  if (!grid_blocks) {
    int dev = 0, cus = 0, per_cu = 0;
    (void)hipGetDevice(&dev);
    (void)hipDeviceGetAttribute(&cus, hipDeviceAttributeMultiprocessorCount, dev);
    (void)hipFuncSetAttribute((const void*)mega, hipFuncAttributeMaxDynamicSharedMemorySize, LDS_BYTES);
    (void)hipOccupancyMaxActiveBlocksPerMultiprocessor(&per_cu, (const void*)mega, NTHR, LDS_BYTES);
    if (per_cu < 1) per_cu = 1;
    if (per_cu > 1) per_cu = 1;
    grid_blocks = cus * per_cu;
    if (ws_size < WS_END) fprintf(stderr, "workspace too small: %zu < %zu\n", ws_size, (size_t)WS_END);
  }
  P p{};
  p.x = (const float*)d_in[0]; p.w_in = (const float*)d_in[1]; p.qk_gain = (const float*)d_in[2];
  p.diff_lambda = (const float*)d_in[3]; p.diff_subln = (const float*)d_in[4]; p.sinks = (const float*)d_in[5];
  p.cmp_pos = (const float*)d_in[6]; p.cmp_w1 = (const float*)d_in[7]; p.cmp_w2 = (const float*)d_in[8];
  p.w_branch = (const float*)d_in[9]; p.w_out = (const float*)d_in[10]; p.norm_mix = (const float*)d_in[11];
  p.norm_mlp = (const float*)d_in[12]; p.w_up = (const float*)d_in[13]; p.w_down = (const float*)d_in[14];
  p.rel_bias = (const float*)d_in[15];
  p.out = (float*)d_out; p.ws = (unsigned char*)d_ws;
  (void)hipMemsetAsync((unsigned char*)d_ws + O_BAR, 0, 80 * 128, stream);
  void* args[] = {&p};
  hipError_t e = hipLaunchCooperativeKernel((const void*)mega, dim3(grid_blocks), dim3(NTHR), args, LDS_BYTES, stream);
  if (e != hipSuccess) fprintf(stderr, "cooperative launch failed: %s (grid %d)\n", hipGetErrorString(e), grid_blocks);
}
```

```cpp
#include <hip/hip_runtime.h>
#include <hip/hip_cooperative_groups.h>
#include <cstdio>
namespace cg = cooperative_groups;

typedef unsigned short bf16_t;
using bf16x8 = __attribute__((ext_vector_type(8))) short;
using f32x16 = __attribute__((ext_vector_type(16))) float;
using u32x4 = __attribute__((ext_vector_type(4))) unsigned;
#define DI __device__ __forceinline__
#define MFMA32(a, b, c) __builtin_amdgcn_mfma_f32_32x32x16_bf16((a), (b), (c), 0, 0, 0)

constexpr int S_ = 4096, T_ = 16384, NL = 4;
constexpr int NIN = 6680, NINP = 6912;
constexpr int LDS_BYTES = 147456;
constexpr int NTHR = 512;
constexpr int LDT = 72;
constexpr int LDK1 = 1088, LDK4 = 4160;
constexpr int WT_E = 256 * LDT;

constexpr size_t SZ_WIN = (size_t)NINP * LDK1 * 2;
constexpr size_t SZ_WBR = (size_t)3 * 1024 * 512 * 2;
constexpr size_t SZ_WO = (size_t)1024 * LDK1 * 2;
constexpr size_t SZ_WUP = (size_t)4096 * LDK1 * 2;
constexpr size_t SZ_WDN = (size_t)1024 * LDK4 * 2;
constexpr size_t SZ_W1 = (size_t)2 * 256 * 2048 * 2;
constexpr size_t SZ_W2 = (size_t)2 * 128 * 256 * 2;
constexpr size_t O_WIN = 0;
constexpr size_t O_WBR = O_WIN + NL * SZ_WIN;
constexpr size_t O_WO = O_WBR + NL * SZ_WBR;
constexpr size_t O_WUP = O_WO + NL * SZ_WO;
constexpr size_t O_WDN = O_WUP + NL * SZ_WUP;
constexpr size_t O_W1 = O_WDN + NL * SZ_WDN;
constexpr size_t O_W2 = O_W1 + NL * SZ_W1;
constexpr size_t O_POSW1 = O_W2 + NL * SZ_W2;
constexpr size_t O_LAM = O_POSW1 + (size_t)NL * 2 * 256 * 4;
constexpr size_t O_TABS = O_LAM + 256;
constexpr size_t O_PART = O_TABS + 20 * 132 * 4 + 192;
constexpr size_t O_XB = ((O_PART + (size_t)T_ * 16 * 4 + 255) / 256) * 256;
constexpr size_t O_ACT = O_XB + (size_t)T_ * LDK1 * 2;
constexpr size_t O_AQ = O_ACT;
constexpr size_t O_BQ = O_AQ + (size_t)T_ * 512 * 2;
constexpr size_t O_CQ = O_BQ + (size_t)T_ * 512 * 2;
constexpr size_t O_AK = O_CQ + (size_t)T_ * 512 * 2;
constexpr size_t O_AVT = O_AK + (size_t)T_ * 512 * 2;
constexpr size_t O_Z = O_AK;
constexpr size_t O_BK = O_AVT + (size_t)T_ * 512 * 2;
constexpr size_t SZ_S = (size_t)T_ * 128 * 2;
constexpr size_t O_BVT = O_BK + SZ_S;
constexpr size_t O_CK = O_BVT + SZ_S;
constexpr size_t O_CV = O_CK + SZ_S;
constexpr size_t O_KS = O_CV + SZ_S + 65536;
constexpr size_t O_VST = O_KS + SZ_S;
constexpr size_t O_KW = O_VST + SZ_S;
constexpr size_t O_VWT = O_KW + SZ_S;
constexpr size_t O_CGS = O_VWT + SZ_S;
constexpr size_t O_MGS = O_CGS + (size_t)T_ * 24 * 4;
constexpr size_t O_HID = O_MGS + (size_t)T_ * 3072 * 2;
constexpr size_t O_KC = O_HID + (size_t)16 * 256 * 256 * 2;
constexpr size_t O_VCT = O_KC + (size_t)8 * 256 * 64 * 2;
constexpr size_t O_U = O_ACT;
constexpr size_t O_BAR = O_VCT + (size_t)8 * 256 * 64 * 2;
constexpr size_t WS_END = O_BAR + 80 * 128;
static_assert(O_Z + (size_t)T_ * LDK1 * 2 <= O_CGS && O_U + (size_t)T_ * LDK4 * 2 <= O_HID, "u must fit in the aliased region");

struct P {
  const float* x; const float* w_in; const float* qk_gain; const float* diff_lambda; const float* diff_subln;
  const float* sinks; const float* cmp_pos; const float* cmp_w1; const float* cmp_w2; const float* w_branch;
  const float* w_out; const float* norm_mix; const float* norm_mlp; const float* w_up; const float* w_down;
  const float* rel_bias;
  float* out; unsigned char* ws;
};

DI int tidx() { int t = threadIdx.x; asm volatile("" : "+v"(t)); return t; }
DI bf16_t f2bf(float x) { unsigned u = __float_as_uint(x); u += 0x7fffu + ((u >> 16) & 1u); return (bf16_t)(u >> 16); }
DI float bf2f(bf16_t b) { return __uint_as_float(((unsigned)b) << 16); }
typedef float f32x2_t __attribute__((ext_vector_type(2)));
typedef __bf16 bf16x2_t __attribute__((ext_vector_type(2)));
DI unsigned pack2(float a, float b) { f32x2_t v = {a, b}; bf16x2_t r = __builtin_convertvector(v, bf16x2_t); return __builtin_bit_cast(unsigned, r); }
constexpr float LOG2E = 1.4426950408889634f;
constexpr float QSCL = 0.125f * LOG2E;
DI float ex2(float x) { return __builtin_amdgcn_exp2f(x); }
DI float sigmoidf_(float x) { return __builtin_amdgcn_rcpf(1.f + ex2(-LOG2E * x)); }
DI float xor32(float v) { return __shfl_xor(v, 32); }

DI void gemm_wide(const bf16_t* __restrict__ W, int ldw, const bf16_t* __restrict__ X, int ldx, int nkt,
                  f32x16 (&acc)[4][2], bf16_t* lds) {
  const int tid = tidx(), lane = tid & 63, wv = tid >> 6, wn = wv & 1, wm = wv >> 1;
  const int lr = lane & 31, lh = lane >> 5;
  const int lrow = tid >> 3, lkc = (tid & 7) * 8;
  const bf16_t* wp = W + (size_t)lrow * ldw + lkc;
  const bf16_t* xp = X + (size_t)lrow * ldx + lkc;
  const size_t wst = (size_t)64 * ldw, xst = (size_t)64 * ldx;
  u32x4 rw0, rw1, rw2, rw3, rx0, rx1, rx2, rx3;
#define GW_GLOAD(KT) { const size_t ko_ = (size_t)(KT) * 64; \
    rw0 = *(const u32x4*)(wp + ko_); rw1 = *(const u32x4*)(wp + wst + ko_); \
    rw2 = *(const u32x4*)(wp + 2 * wst + ko_); rw3 = *(const u32x4*)(wp + 3 * wst + ko_); \
    rx0 = *(const u32x4*)(xp + ko_); rx1 = *(const u32x4*)(xp + xst + ko_); \
    rx2 = *(const u32x4*)(xp + 2 * xst + ko_); rx3 = *(const u32x4*)(xp + 3 * xst + ko_); }
#define GW_LSTORE(BUF) { bf16_t* wb_ = lds + (BUF) * 2 * WT_E + lrow * LDT + lkc; bf16_t* xb_ = wb_ + WT_E; \
    *(u32x4*)(wb_) = rw0; *(u32x4*)(wb_ + 64 * LDT) = rw1; *(u32x4*)(wb_ + 128 * LDT) = rw2; *(u32x4*)(wb_ + 192 * LDT) = rw3; \
    *(u32x4*)(xb_) = rx0; *(u32x4*)(xb_ + 64 * LDT) = rx1; *(u32x4*)(xb_ + 128 * LDT) = rx2; *(u32x4*)(xb_ + 192 * LDT) = rx3; }
  u32x4 sw0, sw1, sw2, sw3, sx0, sx1, sx2, sx3;
#define GW_GLOAD_B(KT) { const size_t ko_ = (size_t)(KT) * 64; \
    sw0 = *(const u32x4*)(wp + ko_); sw1 = *(const u32x4*)(wp + wst + ko_); \
    sw2 = *(const u32x4*)(wp + 2 * wst + ko_); sw3 = *(const u32x4*)(wp + 3 * wst + ko_); \
    sx0 = *(const u32x4*)(xp + ko_); sx1 = *(const u32x4*)(xp + xst + ko_); \
    sx2 = *(const u32x4*)(xp + 2 * xst + ko_); sx3 = *(const u32x4*)(xp + 3 * xst + ko_); }
#define GW_LSTORE_B(BUF) { bf16_t* wb_ = lds + (BUF) * 2 * WT_E + lrow * LDT + lkc; bf16_t* xb_ = wb_ + WT_E; \
    *(u32x4*)(wb_) = sw0; *(u32x4*)(wb_ + 64 * LDT) = sw1; *(u32x4*)(wb_ + 128 * LDT) = sw2; *(u32x4*)(wb_ + 192 * LDT) = sw3; \
    *(u32x4*)(xb_) = sx0; *(u32x4*)(xb_ + 64 * LDT) = sx1; *(u32x4*)(xb_ + 128 * LDT) = sx2; *(u32x4*)(xb_ + 192 * LDT) = sx3; }
#define GW_KS(KT, ks) { \
      const bf16_t* wb = lds + ((KT) & 1) * 2 * WT_E + (wn * 128 + lr) * LDT + lh * 8; \
      const bf16_t* xb = lds + ((KT) & 1) * 2 * WT_E + WT_E + (wm * 64 + lr) * LDT + lh * 8; \
      const bf16x8 b0 = *(const bf16x8*)(xb + (ks) * 16), b1 = *(const bf16x8*)(xb + 32 * LDT + (ks) * 16); \
      const bf16x8 a0 = *(const bf16x8*)(wb + (ks) * 16), a1 = *(const bf16x8*)(wb + 32 * LDT + (ks) * 16); \
      const bf16x8 a2 = *(const bf16x8*)(wb + 64 * LDT + (ks) * 16), a3 = *(const bf16x8*)(wb + 96 * LDT + (ks) * 16); \
      acc[0][0] = MFMA32(a0, b0, acc[0][0]); acc[0][1] = MFMA32(a0, b1, acc[0][1]); \
      acc[1][0] = MFMA32(a1, b0, acc[1][0]); acc[1][1] = MFMA32(a1, b1, acc[1][1]); \
      acc[2][0] = MFMA32(a2, b0, acc[2][0]); acc[2][1] = MFMA32(a2, b1, acc[2][1]); \
      acc[3][0] = MFMA32(a3, b0, acc[3][0]); acc[3][1] = MFMA32(a3, b1, acc[3][1]); }
#define GW_ST2(BUF, OFF, R0, R1) { bf16_t* d_ = lds + (BUF) * 2 * WT_E + (OFF) + lrow * LDT + lkc; \
      *(u32x4*)(d_) = R0; *(u32x4*)(d_ + 64 * LDT) = R1; }
  __syncthreads();
  GW_GLOAD(0)
  GW_LSTORE(0)
  GW_GLOAD(1)
  GW_GLOAD_B(nkt > 2 ? 2 : nkt - 1)
  __syncthreads();
  for (int kt = 0; kt < nkt; kt += 2) {
    __builtin_amdgcn_sched_barrier(0);
    GW_ST2(1, 0, rw0, rw1)                         GW_KS(kt, 0)
    GW_ST2(1, 128 * LDT, rw2, rw3)                 GW_KS(kt, 1)
    GW_ST2(1, WT_E, rx0, rx1)                      GW_KS(kt, 2)
    GW_ST2(1, WT_E + 128 * LDT, rx2, rx3)          GW_KS(kt, 3)
    __builtin_amdgcn_sched_barrier(0);
    GW_GLOAD(kt + 3 < nkt ? kt + 3 : nkt - 1)
    __syncthreads();
    __builtin_amdgcn_sched_barrier(0);
    GW_ST2(0, 0, sw0, sw1)                         GW_KS(kt + 1, 0)
    GW_ST2(0, 128 * LDT, sw2, sw3)                 GW_KS(kt + 1, 1)
    GW_ST2(0, WT_E, sx0, sx1)                      GW_KS(kt + 1, 2)
    GW_ST2(0, WT_E + 128 * LDT, sx2, sx3)          GW_KS(kt + 1, 3)
    __builtin_amdgcn_sched_barrier(0);
    GW_GLOAD_B(kt + 4 < nkt ? kt + 4 : nkt - 1)
    __syncthreads();
  }
#undef GW_KS
#undef GW_ST2
#undef GW_GLOAD_B
#undef GW_LSTORE_B
#undef GW_GLOAD
#undef GW_LSTORE
}

constexpr int MID_E = (128 + 256) * LDT;
DI void gemm_mid(const bf16_t* __restrict__ W, int ldw, const bf16_t* __restrict__ X, size_t ldx, int mclamp, int kts,
                 int nkt, int m0, f32x16 (&acc)[2][2], bf16_t* lds) {
  const int tid = tidx(), lane = tid & 63, wv = tid >> 6, wn = wv & 1, wm = wv >> 1;
  const int lr = lane & 31, lh = lane >> 5;
  const int lrow = tid >> 3, lkc = (tid & 7) * 8;
  const bf16_t* wp = W + (size_t)lrow * ldw + lkc;
  const size_t wst = (size_t)64 * ldw;
  const bf16_t *xp0, *xp1, *xp2, *xp3;
  { int m;
    m = m0 + lrow;       m = m < mclamp ? m : mclamp; xp0 = X + (size_t)m * ldx + lkc;
    m = m0 + lrow + 64;  m = m < mclamp ? m : mclamp; xp1 = X + (size_t)m * ldx + lkc;
    m = m0 + lrow + 128; m = m < mclamp ? m : mclamp; xp2 = X + (size_t)m * ldx + lkc;
    m = m0 + lrow + 192; m = m < mclamp ? m : mclamp; xp3 = X + (size_t)m * ldx + lkc; }
  u32x4 rw0, rw1, rx0, rx1, rx2, rx3;
#define GM_GLOAD(KT) { \
    rw0 = *(const u32x4*)(wp + (size_t)(KT) * 64); rw1 = *(const u32x4*)(wp + wst + (size_t)(KT) * 64); \
    rx0 = *(const u32x4*)(xp0 + (size_t)(KT) * kts); rx1 = *(const u32x4*)(xp1 + (size_t)(KT) * kts); \
    rx2 = *(const u32x4*)(xp2 + (size_t)(KT) * kts); rx3 = *(const u32x4*)(xp3 + (size_t)(KT) * kts); }
#define GM_LSTORE(BUF) { bf16_t* wb_ = lds + (BUF) * MID_E + lrow * LDT + lkc; bf16_t* xb_ = wb_ + 128 * LDT; \
    *(u32x4*)(wb_) = rw0; *(u32x4*)(wb_ + 64 * LDT) = rw1; \
    *(u32x4*)(xb_) = rx0; *(u32x4*)(xb_ + 64 * LDT) = rx1; *(u32x4*)(xb_ + 128 * LDT) = rx2; *(u32x4*)(xb_ + 192 * LDT) = rx3; }
  __syncthreads();
  GM_GLOAD(0)
  GM_LSTORE(0)
  __syncthreads();
  for (int kt = 0; kt < nkt; ++kt) {
    const bool more = kt + 1 < nkt;
    if (more) GM_GLOAD(kt + 1)
    __builtin_amdgcn_sched_barrier(0);
    {
      const bf16_t* wb = lds + (kt & 1) * MID_E + (wn * 64 + lr) * LDT + lh * 8;
      const bf16_t* xb = lds + (kt & 1) * MID_E + 128 * LDT + (wm * 64 + lr) * LDT + lh * 8;
#pragma unroll
      for (int ks = 0; ks < 4; ++ks) {
        const bf16x8 a0 = *(const bf16x8*)(wb + ks * 16), a1 = *(const bf16x8*)(wb + 32 * LDT + ks * 16);
        const bf16x8 b0 = *(const bf16x8*)(xb + ks * 16), b1 = *(const bf16x8*)(xb + 32 * LDT + ks * 16);
        acc[0][0] = MFMA32(a0, b0, acc[0][0]); acc[0][1] = MFMA32(a0, b1, acc[0][1]);
        acc[1][0] = MFMA32(a1, b0, acc[1][0]); acc[1][1] = MFMA32(a1, b1, acc[1][1]);
      }
    }
    __builtin_amdgcn_sched_barrier(0);
    if (more) GM_LSTORE((kt + 1) & 1)
    __syncthreads();
  }
#undef GM_GLOAD
#undef GM_LSTORE
}

DI void zero_acc(f32x16 (&acc)[2][2]) {
#pragma unroll
  for (int a = 0; a < 2; ++a)
#pragma unroll
    for (int b = 0; b < 2; ++b)
#pragma unroll
      for (int i = 0; i < 16; ++i) acc[a][b][i] = 0.f;
}
DI void zero_acc8(f32x16 (&acc)[4][2]) {
#pragma unroll
  for (int a = 0; a < 4; ++a)
#pragma unroll
    for (int b = 0; b < 2; ++b)
#pragma unroll
      for (int i = 0; i < 16; ++i) acc[a][b][i] = 0.f;
}

DI const float* tile_rstd(const float* __restrict__ part, int m0, bf16_t* sm) {
  float* rs = (float*)((unsigned char*)sm + 139264);
  const int tid = tidx();
  if (tid < 256) {
    const float4* p4 = (const float4*)(part + (size_t)(m0 + tid) * 16);
    float s = 0.f;
#pragma unroll
    for (int i = 0; i < 4; ++i) { float4 v = p4[i]; s += v.x + v.y + v.z + v.w; }
    rs[tid] = rsqrtf(s * (1.f / 1024.f) + 1e-6f);
  }
  __syncthreads();
  return rs;
}
DI float row_rstd(const float* __restrict__ part, int m) {
  const float4* p4 = (const float4*)(part + (size_t)m * 16);
  float s = 0.f;
#pragma unroll
  for (int i = 0; i < 4; ++i) { float4 v = p4[i]; s += v.x + v.y + v.z + v.w; }
  return rsqrtf(s * (1.f / 1024.f) + 1e-6f);
}

struct Geo { int xcd, loc, nloc; };
struct TileWalk {
  int xcd, loc, nloc, ng, NT, g, i;
  DI TileWalk(int NT_, const Geo& ge) : xcd(ge.xcd), loc(ge.loc), nloc(ge.nloc), ng((NT_ + 7) >> 3), NT(NT_), g(0), i(ge.loc) {}
  DI bool next(int& mt, int& nt) {
    for (;;) {
      if (g >= ng) return false;
      if (i >= 64) { i = loc; ++g; continue; }
      mt = xcd * 8 + (i & 7); nt = g * 8 + (i >> 3);
      i += nloc;
      if (nt < NT) return true;
    }
  }
};

DI int next_task(unsigned* ctr, bf16_t* sm) {
  volatile int* slot = (volatile int*)((unsigned char*)sm + LDS_BYTES - 16);
  __syncthreads();
  if (threadIdx.x == 0) *slot = (int)__hip_atomic_fetch_add(ctr, 1u, __ATOMIC_RELAXED, __HIP_MEMORY_SCOPE_AGENT);
  __syncthreads();
  return __builtin_amdgcn_readfirstlane(*slot);
}

DI void tr_tile(const float* __restrict__ src, int ldS, int C, int r0, int c0, bf16_t* __restrict__ dst, int ldd,
                const float* __restrict__ g, int remap, float* tl) {
  const int tid = tidx() & 255;
  __syncthreads();
  {
    const int c4 = (tid & 15) * 4;
#pragma unroll
    for (int i = 0; i < 4; ++i) {
      const int r = (tid >> 4) + 16 * i;
      float4 v = make_float4(0.f, 0.f, 0.f, 0.f);
      if (c0 + c4 < C) {
        v = *(const float4*)(src + (size_t)(r0 + r) * ldS + c0 + c4);
        if (g) { const float gg = g[r0 + r]; v.x *= gg; v.y *= gg; v.z *= gg; v.w *= gg; }
      }
      float* t4 = tl + r * 65 + c4;
      t4[0] = v.x; t4[1] = v.y; t4[2] = v.z; t4[3] = v.w;
    }
  }
  __syncthreads();
  {
    const int c = tid >> 2, rq = (tid & 3) * 16;
    if (c0 + c < C) {
      int dr = c0 + c;
      if (remap) { if (dr >= 3608) dr -= 24; else if (dr >= 3584) dr += 6656 - 3584; }
      unsigned w[8];
#pragma unroll
      for (int k = 0; k < 8; ++k) w[k] = pack2(tl[(rq + 2 * k) * 65 + c], tl[(rq + 2 * k + 1) * 65 + c]);
      uint4* d4 = (uint4*)(dst + (size_t)dr * ldd + r0 + rq);
      d4[0] = make_uint4(w[0], w[1], w[2], w[3]);
      d4[1] = make_uint4(w[4], w[5], w[6], w[7]);
    }
  }
}

DI void tr_tile_wave(const float* __restrict__ src, int ldS, int C, int r0, int c0, bf16_t* __restrict__ dst, int ldd,
                     const float* __restrict__ g, int remap, float* tl) {
  const int lane = tidx() & 63;
  {
    const int c4 = (lane & 15) * 4;
    float4 v[16];
#pragma unroll
    for (int i = 0; i < 16; ++i) {
      const int r = (lane >> 4) + 4 * i;
      v[i] = make_float4(0.f, 0.f, 0.f, 0.f);
      if (c0 + c4 < C) v[i] = *(const float4*)(src + (size_t)(r0 + r) * ldS + c0 + c4);
    }
#pragma unroll
    for (int i = 0; i < 16; ++i) {
      const int r = (lane >> 4) + 4 * i;
      const float gg = g ? g[r0 + r] : 1.f;
      float* t4 = tl + r * 65 + c4;
      t4[0] = v[i].x * gg; t4[1] = v[i].y * gg; t4[2] = v[i].z * gg; t4[3] = v[i].w * gg;
    }
  }
  __builtin_amdgcn_fence(__ATOMIC_RELEASE, "wavefront");
  __builtin_amdgcn_wave_barrier();
#pragma unroll
  for (int j = 0; j < 4; ++j) {
    const int c = (lane >> 2) + 16 * j, rq = (lane & 3) * 16;
    if (c0 + c < C) {
      int dr = c0 + c;
      if (remap) { if (dr >= 3608) dr -= 24; else if (dr >= 3584) dr += 6656 - 3584; }
      unsigned w[8];
#pragma unroll
      for (int k = 0; k < 8; ++k) w[k] = pack2(tl[(rq + 2 * k) * 65 + c], tl[(rq + 2 * k + 1) * 65 + c]);
      uint4* d4 = (uint4*)(dst + (size_t)dr * ldd + r0 + rq);
      d4[0] = make_uint4(w[0], w[1], w[2], w[3]);
      d4[1] = make_uint4(w[4], w[5], w[6], w[7]);
    }
  }
  __builtin_amdgcn_wave_barrier();
}

DI void phase0(const P& p, bf16_t* sm) {
  const int tid5 = tidx(), half = tid5 >> 8, tid = tid5 & 255, lane = tid5 & 63, wv8 = tid5 >> 6;
  float* tl = (float*)sm + half * (64 * 65);
  constexpr int NTR_L = 1680 + 384 + 256 + 1024 + 1024 + 256 + 8;
  {
    float* tlw = (float*)sm + wv8 * (64 * 65);
    for (int t = blockIdx.x * 8 + wv8; t < NTR_L * NL; t += gridDim.x * 8) {
      const int layer = t / NTR_L; int r = t % NTR_L;
      if (r < 1680) {
        tr_tile_wave(p.w_in + (size_t)layer * 1024 * NIN, NIN, NIN, (r / 105) * 64, (r % 105) * 64,
                     (bf16_t*)(p.ws + O_WIN + layer * SZ_WIN), LDK1, p.norm_mix + layer * 1024, 1, tlw);
      } else if ((r -= 1680) < 384) {
        const int n3 = r / 128; r %= 128;
        tr_tile_wave(p.w_branch + ((size_t)layer * 3 + n3) * 512 * 1024, 1024, 1024, (r / 16) * 64, (r % 16) * 64,
                     (bf16_t*)(p.ws + O_WBR + layer * SZ_WBR) + (size_t)n3 * 1024 * 512, 512, nullptr, 0, tlw);
      } else if ((r -= 384) < 256) {
        tr_tile_wave(p.w_out + (size_t)layer * 1024 * 1024, 1024, 1024, (r / 16) * 64, (r % 16) * 64,
                     (bf16_t*)(p.ws + O_WO + layer * SZ_WO), LDK1, nullptr, 0, tlw);
      } else if ((r -= 256) < 1024) {
        tr_tile_wave(p.w_up + (size_t)layer * 1024 * 4096, 4096, 4096, (r / 64) * 64, (r % 64) * 64,
                     (bf16_t*)(p.ws + O_WUP + layer * SZ_WUP), LDK1, p.norm_mlp + layer * 1024, 0, tlw);
      } else if ((r -= 1024) < 1024) {
        tr_tile_wave(p.w_down + (size_t)layer * 4096 * 1024, 1024, 1024, (r / 16) * 64, (r % 16) * 64,
                     (bf16_t*)(p.ws + O_WDN + layer * SZ_WDN), LDK4, nullptr, 0, tlw);
      } else if ((r -= 1024) < 256) {
        const int kv = r / 128; r %= 128;
        tr_tile_wave(p.cmp_w1 + ((size_t)layer * 2 + kv) * 2048 * 256, 256, 256, (r / 4) * 64, (r % 4) * 64,
                     (bf16_t*)(p.ws + O_W1 + layer * SZ_W1) + (size_t)kv * 256 * 2048, 2048, nullptr, 0, tlw);
      } else {
        r -= 256;
        const int kv = r / 4; r %= 4;
        tr_tile_wave(p.cmp_w2 + ((size_t)layer * 2 + kv) * 256 * 64, 64, 64, r * 64, 0,
                     (bf16_t*)(p.ws + O_W2 + layer * SZ_W2) + (size_t)kv * 128 * 256, 256, nullptr, 0, tlw);
      }
    }
    __syncthreads();
  }
  constexpr int J_TR = 0;
  constexpr int J_X = J_TR + T_ / 8;
  constexpr int J_POS = J_X + 32;
  constexpr int J_MISC = J_POS + 1;
  constexpr int ZW_PER = ((NINP - NIN) * LDK1 / 8 + 511) / 512;
  constexpr int J_ZW = J_MISC + NL * ZW_PER;
  constexpr int J_ZW2 = J_ZW + 32;
  for (int job = blockIdx.x; job < J_ZW2; job += gridDim.x) {
    if (job < J_TR) {
      const int t = job * 2 + half;
      const int layer = t / NTR_L; int r = t % NTR_L;
      if (r < 1680) {
        tr_tile(p.w_in + (size_t)layer * 1024 * NIN, NIN, NIN, (r / 105) * 64, (r % 105) * 64,
                (bf16_t*)(p.ws + O_WIN + layer * SZ_WIN), LDK1, p.norm_mix + layer * 1024, 1, tl);
      } else if ((r -= 1680) < 384) {
        const int n3 = r / 128; r %= 128;
        tr_tile(p.w_branch + ((size_t)layer * 3 + n3) * 512 * 1024, 1024, 1024, (r / 16) * 64, (r % 16) * 64,
                (bf16_t*)(p.ws + O_WBR + layer * SZ_WBR) + (size_t)n3 * 1024 * 512, 512, nullptr, 0, tl);
      } else if ((r -= 384) < 256) {
        tr_tile(p.w_out + (size_t)layer * 1024 * 1024, 1024, 1024, (r / 16) * 64, (r % 16) * 64,
                (bf16_t*)(p.ws + O_WO + layer * SZ_WO), LDK1, nullptr, 0, tl);
      } else if ((r -= 256) < 1024) {
        tr_tile(p.w_up + (size_t)layer * 1024 * 4096, 4096, 4096, (r / 64) * 64, (r % 64) * 64,
                (bf16_t*)(p.ws + O_WUP + layer * SZ_WUP), LDK1, p.norm_mlp + layer * 1024, 0, tl);
      } else if ((r -= 1024) < 1024) {
        tr_tile(p.w_down + (size_t)layer * 4096 * 1024, 1024, 1024, (r / 16) * 64, (r % 16) * 64,
                (bf16_t*)(p.ws + O_WDN + layer * SZ_WDN), LDK4, nullptr, 0, tl);
      } else if ((r -= 1024) < 256) {
        const int kv = r / 128; r %= 128;
        tr_tile(p.cmp_w1 + ((size_t)layer * 2 + kv) * 2048 * 256, 256, 256, (r / 4) * 64, (r % 4) * 64,
                (bf16_t*)(p.ws + O_W1 + layer * SZ_W1) + (size_t)kv * 256 * 2048, 2048, nullptr, 0, tl);
      } else {
        r -= 256;
        const int kv = r / 4; r %= 4;
        tr_tile(p.cmp_w2 + ((size_t)layer * 2 + kv) * 256 * 64, 64, 64, r * 64, 0,
                (bf16_t*)(p.ws + O_W2 + layer * SZ_W2) + (size_t)kv * 128 * 256, 256, nullptr, 0, tl);
      }
    } else if (job < J_X) {
      const int row = (job - J_TR) * 8 + wv8;
      const float4* src = (const float4*)(p.x + (size_t)row * 1024);
      bf16_t* xb = (bf16_t*)(p.ws + O_XB) + (size_t)row * LDK1;
      float ss = 0.f;
#pragma unroll
      for (int i = 0; i < 4; ++i) {
        float4 v = src[lane + 64 * i];
        ss += v.x * v.x + v.y * v.y + v.z * v.z + v.w * v.w;
        *(uint2*)(xb + (lane + 64 * i) * 4) = make_uint2(pack2(v.x, v.y), pack2(v.z, v.w));
      }
#pragma unroll
      for (int o = 32; o >= 1; o >>= 1) ss += __shfl_xor(ss, o);
      float* part = (float*)(p.ws + O_PART) + (size_t)row * 16;
      if (lane < 16) part[lane] = lane == 0 ? ss : 0.f;
    } else if (job < J_POS) {
      const int jj = (job - J_X) * 2 + half; const int lk = jj >> 3, ng = jj & 7;
      const int col = ng * 32 + (tid & 31), ksl = tid >> 5;
      const float* pos = p.cmp_pos + (size_t)lk * 2048;
      const float* w1 = p.cmp_w1 + (size_t)lk * 2048 * 256;
      float s = 0.f;
      for (int k = ksl * 256; k < ksl * 256 + 256; ++k) s += pos[k] * w1[(size_t)k * 256 + col];
      __syncthreads();
      tl[tid] = s;
      __syncthreads();
      if (tid < 32) {
        float t = 0.f;
        for (int q = 0; q < 8; ++q) t += tl[q * 32 + tid];
        ((float*)(p.ws + O_POSW1))[lk * 256 + col] = t;
      }
    } else if (job < J_MISC) {
      float* tabs = (float*)(p.ws + O_TABS);
      for (int i = tid5; i < 20 * 129; i += NTHR) {
        const int h = i / 129, d = i % 129;
        int bk;
        if (d < 16) bk = d;
        else { bk = 16 + (int)(logf((float)d / 16.f) / 2.0794415416798357f * 16.f); if (bk > 31) bk = 31; }
        tabs[h * 132 + d] = p.rel_bias[bk * 20 + h] * LOG2E;
      }
      if (wv8 == 0) {
        for (int layer = 0; layer < NL; ++layer) {
          const float* lm = p.diff_lambda + layer * 256;
          float a = lm[lane] * lm[64 + lane], b = lm[128 + lane] * lm[192 + lane];
#pragma unroll
          for (int o = 32; o >= 1; o >>= 1) { a += __shfl_xor(a, o); b += __shfl_xor(b, o); }
          const float li = 0.8f - 0.6f * expf(-0.3f * (float)layer);
          if (lane == 0) ((float*)(p.ws + O_LAM))[layer] = expf(a) - expf(b) + li;
        }
      }
    } else if (job < J_ZW) {
      const int jj = job - J_MISC; const int layer = jj / ZW_PER, q = jj % ZW_PER;
      uint4* d = (uint4*)(p.ws + O_WIN + layer * SZ_WIN + (size_t)NIN * LDK1 * 2) + q * 512 + tid5;
      if (q * 512 + tid5 < (NINP - NIN) * LDK1 / 8) *d = make_uint4(0, 0, 0, 0);
    } else {
      const int jj = job - J_ZW; const int lk = jj >> 2, q = jj & 3;
      uint4* d = (uint4*)(p.ws + O_W2 + (size_t)lk * 128 * 256 * 2 + 64 * 256 * 2) + q * 512 + tid5;
      *d = make_uint4(0, 0, 0, 0);
    }
  }
}

DI bool epi_inproj_chunk(const P& p, int layer, int ch, int m0w, f32x16 (&a0)[2], f32x16 (&a1)[2], bf16_t* stg, int cp,
                         bf16_t*& rdst, int& rldd, int& rcoff, float rs0, float rs1) {
  const int lane = tidx() & 63;
  const int lr = lane & 31, lh = lane >> 5;
  enum { NORM, RAW, TRANS, SIG, CG };
  int type = RAW, ldd = 512, coff = 0, nh = 2, dv = 64, hd = 0, doff = 0;
  bf16_t* dst = nullptr; const float* gain = nullptr; float scl = 1.f;
  const float* gains = p.qk_gain + layer * 512;
  unsigned char* ws = p.ws;
  if (ch < 8) { type = NORM; dst = (bf16_t*)(ws + O_AQ); coff = ch * 64; gain = gains; scl = QSCL; }
  else if (ch < 16) { type = NORM; dst = (bf16_t*)(ws + O_AK); coff = (ch - 8) * 64; gain = gains + 64; }
  else if (ch < 24) { type = TRANS; dst = (bf16_t*)(ws + O_AVT); nh = 4; dv = 128; hd = (ch - 16) >> 1; doff = ((ch - 16) & 1) * 64; }
  else if (ch < 32) { type = NORM; dst = (bf16_t*)(ws + O_BQ); coff = (ch - 24) * 64; gain = gains + 128; scl = QSCL; }
  else if (ch < 34) { type = NORM; dst = (bf16_t*)(ws + O_BK); ldd = 128; coff = (ch - 32) * 64; gain = gains + 192; }
  else if (ch < 36) { type = TRANS; dst = (bf16_t*)(ws + O_BVT); hd = ch - 34; }
  else if (ch < 44) { type = NORM; dst = (bf16_t*)(ws + O_CQ); coff = (ch - 36) * 64; gain = gains + 256; scl = QSCL; }
  else if (ch < 46) { type = RAW; dst = (bf16_t*)(ws + O_CK); ldd = 128; coff = (ch - 44) * 64; }
  else if (ch < 48) { type = RAW; dst = (bf16_t*)(ws + O_CV); ldd = 128; coff = (ch - 46) * 64; }
  else if (ch < 50) { type = NORM; dst = (bf16_t*)(ws + O_KS); ldd = 128; coff = (ch - 48) * 64; gain = gains + 384; }
  else if (ch < 52) { type = TRANS; dst = (bf16_t*)(ws + O_VST); hd = ch - 50; }
  else if (ch < 54) { type = NORM; dst = (bf16_t*)(ws + O_KW); ldd = 128; coff = (ch - 52) * 64; gain = gains + 448; }
  else if (ch < 56) { type = TRANS; dst = (bf16_t*)(ws + O_VWT); hd = ch - 54; }
  else if (ch < 104) { type = SIG; dst = (bf16_t*)(ws + O_MGS); ldd = 3072; coff = (ch - 56) * 64; }
  else if (ch == 104) { type = CG; }
  else return false;
  rdst = dst; rldd = ldd; rcoff = coff;
#pragma unroll
  for (int mt = 0; mt < 2; ++mt) {
    const int m = m0w + mt * 32 + lr;
    const float rs = mt ? rs1 : rs0;
    float v[2][16];
    float ss = 0.f;
#pragma unroll
    for (int i = 0; i < 16; ++i) { float t = a0[mt][i] * rs; v[0][i] = t; ss += t * t; }
#pragma unroll
    for (int i = 0; i < 16; ++i) { float t = a1[mt][i] * rs; v[1][i] = t; ss += t * t; }
    if (type == NORM) {
      ss += xor32(ss);
      const float r = rsqrtf(ss * (1.f / 64.f) + 1e-6f) * scl;
#pragma unroll
      for (int nt = 0; nt < 2; ++nt)
#pragma unroll
        for (int qd = 0; qd < 4; ++qd) {
          const int n = nt * 32 + 8 * qd + 4 * lh;
          const float4 g4 = *(const float4*)(gain + n);
          *(uint2*)(stg + (mt * 32 + lr) * 136 + cp * 64 + n) =
              make_uint2(pack2(v[nt][4 * qd] * r * g4.x, v[nt][4 * qd + 1] * r * g4.y),
                         pack2(v[nt][4 * qd + 2] * r * g4.z, v[nt][4 * qd + 3] * r * g4.w));
        }
    } else if (type == RAW || type == SIG) {
#pragma unroll
      for (int nt = 0; nt < 2; ++nt)
#pragma unroll
        for (int qd = 0; qd < 4; ++qd) {
          const int n = nt * 32 + 8 * qd + 4 * lh;
          float a = v[nt][4 * qd], b = v[nt][4 * qd + 1], c = v[nt][4 * qd + 2], d = v[nt][4 * qd + 3];
          if (type == SIG) { a = sigmoidf_(a); b = sigmoidf_(b); c = sigmoidf_(c); d = sigmoidf_(d); }
          if (type == SIG)
            *(uint2*)(dst + ((size_t)((coff + n) >> 2) * T_ + m) * 4) = make_uint2(pack2(a, b), pack2(c, d));
          else
            *(uint2*)(stg + (mt * 32 + lr) * 136 + cp * 64 + n) = make_uint2(pack2(a, b), pack2(c, d));
        }
    } else if (type == TRANS) {
      const int b = m >> 12, s = m & 4095;
      bf16_t* base = dst + ((size_t)(b * nh + hd) * dv + doff) * S_ + s;
#pragma unroll
      for (int nt = 0; nt < 2; ++nt)
#pragma unroll
        for (int i = 0; i < 16; ++i) {
          const int n = nt * 32 + 8 * (i >> 2) + 4 * lh + (i & 3);
          base[(size_t)n * S_] = f2bf(v[nt][i]);
        }
    } else {
      float* cg = (float*)(ws + O_CGS) + (size_t)m * 24;
#pragma unroll
      for (int i = 0; i < 16; ++i) {
        const int n = 8 * (i >> 2) + 4 * lh + (i & 3);
        if (n < 24) cg[n] = sigmoidf_(v[0][i]);
      }
    }
  }
  return type == NORM || type == RAW;
}

DI void stage_rows_store(const bf16_t* stg, bf16_t* dst, size_t ldd, int m0w) {
  const int lane = tidx() & 63;
#pragma unroll
  for (int it = 0; it < 16; ++it) {
    const int row = it * 4 + (lane >> 4), c16 = lane & 15;
    const u32x4 v = *(const u32x4*)(stg + row * 136 + c16 * 8);
    *(u32x4*)(dst + (size_t)(m0w + row) * ldd + c16 * 8) = v;
  }
}

DI void phase_inproj(const P& p, int layer, bf16_t* sm, const Geo& ge) {
  const bf16_t* W = (const bf16_t*)(p.ws + O_WIN + layer * SZ_WIN);
  const bf16_t* X = (const bf16_t*)(p.ws + O_XB);
  TileWalk tw(27, ge);
  int mt, nt, mt_have = -1;
  float rs0 = 0.f, rs1 = 0.f;
  while (tw.next(mt, nt)) {
    if (mt != mt_have) {
      const int lane_ = tidx() & 63, wm_ = (tidx() >> 6) >> 1;
      rs0 = row_rstd((const float*)(p.ws + O_PART), mt * 256 + wm_ * 64 + (lane_ & 31));
      rs1 = row_rstd((const float*)(p.ws + O_PART), mt * 256 + wm_ * 64 + 32 + (lane_ & 31));
      mt_have = mt;
    }
    f32x16 acc[4][2]; zero_acc8(acc);
    gemm_wide(W + (size_t)nt * 256 * LDK1, LDK1, X + (size_t)mt * 256 * LDK1, LDK1, 16, acc, sm);
    const int wv = tidx() >> 6, wn = wv & 1, wm = wv >> 1;
    bf16_t* stg = sm + wv * (64 * 136);
    bf16_t *d0 = nullptr, *d1 = nullptr; int ld0 = 0, ld1 = 0, co0 = 0, co1 = 0;
    const bool s0 = epi_inproj_chunk(p, layer, nt * 4 + wn * 2, mt * 256 + wm * 64, acc[0], acc[1], stg, 0, d0, ld0, co0, rs0, rs1);
    const bool s1 = epi_inproj_chunk(p, layer, nt * 4 + wn * 2 + 1, mt * 256 + wm * 64, acc[2], acc[3], stg, 1, d1, ld1, co1, rs0, rs1);
    if (s0 && s1) stage_rows_store(stg, d0 + co0, ld0, mt * 256 + wm * 64);
  }
}

template <int NDT, int MODE, bool ALLON>
DI void attn_tile(const bf16_t* Kl, int kst, const bf16_t* Vl, const bf16x8 (&q)[4], f32x16 (&O)[NDT], float& m, float& l,
                  int kbase, int qp, int win, float cbias, const float* tab, bool lane_on) {
  const int lane = tidx() & 63, lr = lane & 31, lh = lane >> 5;
  f32x16 s[2];
#pragma unroll
  for (int st = 0; st < 2; ++st) {
#pragma unroll
    for (int i = 0; i < 16; ++i) s[st][i] = 0.f;
  }
#pragma unroll
  for (int ks = 0; ks < 4; ++ks) {
    const bf16x8 k0 = *(const bf16x8*)(Kl + lr * kst + ks * 16 + lh * 8);
    const bf16x8 k1 = *(const bf16x8*)(Kl + (32 + lr) * kst + ks * 16 + lh * 8);
    s[0] = MFMA32(k0, q[ks], s[0]);
    s[1] = MFMA32(k1, q[ks], s[1]);
  }
  float alpha, psum = 0.f;
  if (MODE == 0) {
    float tmax = fmaxf(s[0][0], s[1][0]);
#pragma unroll
    for (int i = 1; i < 16; ++i) tmax = fmaxf(tmax, fmaxf(s[0][i], s[1][i]));
    tmax = fmaxf(tmax, xor32(tmax)) + cbias;
    if (!ALLON) tmax = lane_on ? tmax : -1e30f;
    const float mn = fmaxf(m, tmax);
    alpha = ex2(m - mn);
    m = mn;
    const float mc = (ALLON || lane_on) ? mn - cbias : 1e30f;
#pragma unroll
    for (int st = 0; st < 2; ++st)
#pragma unroll
      for (int i = 0; i < 16; ++i) { const float pe = ex2(s[st][i] - mc); psum += pe; s[st][i] = pe; }
  } else {
    float tmax = -1e30f;
#pragma unroll
    for (int st = 0; st < 2; ++st)
#pragma unroll
      for (int i = 0; i < 16; ++i) {
        const int key = kbase + st * 32 + 8 * (i >> 2) + 4 * lh + (i & 3);
        float v;
        if (MODE == 1) {
          const int dist = qp - key;
          const bool ok = (ALLON || lane_on) && dist >= 0 && dist < win;
          const int di = dist < 0 ? 0 : (dist > 128 ? 128 : dist);
          v = ok ? s[st][i] + tab[di] : -1e30f;
        } else {
          v = (16 * key + 31 <= qp) ? s[st][i] : -1e30f;
        }
        s[st][i] = v;
        tmax = fmaxf(tmax, v);
      }
    tmax = fmaxf(tmax, xor32(tmax));
    const float mn = fmaxf(m, tmax);
    alpha = ex2(m - mn);
    m = mn;
#pragma unroll
    for (int st = 0; st < 2; ++st)
#pragma unroll
      for (int i = 0; i < 16; ++i) {
        const float pe = s[st][i] > -5e29f ? ex2(s[st][i] - mn) : 0.f;
        psum += pe;
        s[st][i] = pe;
      }
  }
  l = l * alpha + psum;
  if (__ballot(alpha != 1.f)) {
#pragma unroll
    for (int dt = 0; dt < NDT; ++dt)
#pragma unroll
      for (int i = 0; i < 16; ++i) O[dt][i] *= alpha;
  }
#pragma unroll
  for (int st = 0; st < 2; ++st)
#pragma unroll
    for (int sk = 0; sk < 2; ++sk) {
      u32x4 pu;
      pu[0] = pack2(s[st][8 * sk + 0], s[st][8 * sk + 1]);
      pu[1] = pack2(s[st][8 * sk + 2], s[st][8 * sk + 3]);
      pu[2] = pack2(s[st][8 * sk + 4], s[st][8 * sk + 5]);
      pu[3] = pack2(s[st][8 * sk + 6], s[st][8 * sk + 7]);
      const bf16x8 pf = __builtin_bit_cast(bf16x8, pu);
#pragma unroll
      for (int dt = 0; dt < NDT; ++dt) {
        const bf16_t* vp = Vl + (dt * 32 + lr) * 72 + st * 32 + sk * 16 + 4 * lh;
        const uint2 v0 = *(const uint2*)(vp);
        const uint2 v1 = *(const uint2*)(vp + 8);
        u32x4 vu; vu[0] = v0.x; vu[1] = v0.y; vu[2] = v1.x; vu[3] = v1.y;
        O[dt] = MFMA32(__builtin_bit_cast(bf16x8, vu), pf, O[dt]);
      }
    }
}

DI float gelu_tanh(float x) {
  const float u = 0.7978845608028654f * (x + 0.044715f * x * x * x);
  const float e = __expf(2.f * u);
  const float th = 1.f - 2.f * __builtin_amdgcn_rcpf(e + 1.f);
  return 0.5f * x * (1.f + th);
}

DI void task_compress(const P& p, int layer, int task, bf16_t* sm) {
  const int tid = tidx(), lane = tid & 63, wv = tid >> 6, wn = wv & 1, wm = wv >> 1;
  const int lr = lane & 31, lh = lane >> 5;
  const int b = task & 3, g = (task >> 2) & 1, kv = task >> 3;
  const bf16_t* src = (const bf16_t*)(p.ws + (kv ? O_CV : O_CK)) + (size_t)b * S_ * 128 + g * 64;
  const bf16_t* W1 = (const bf16_t*)(p.ws + O_W1 + layer * SZ_W1) + (size_t)kv * 256 * 2048;
  const bf16_t* W2 = (const bf16_t*)(p.ws + O_W2 + layer * SZ_W2) + (size_t)kv * 128 * 256;
  bf16_t* hid = (bf16_t*)(p.ws + O_HID) + (size_t)((kv * 2 + g) * 4 + b) * 65536;
  const float* pw = (const float*)(p.ws + O_POSW1) + (layer * 2 + kv) * 256;
  for (int nt2 = 0; nt2 < 2; ++nt2) {
    f32x16 acc[2][2]; zero_acc(acc);
    gemm_mid(W1 + (size_t)nt2 * 128 * 2048, 2048, src, 16 * 128, 254, 128, 32, 0, acc, sm);
#pragma unroll
    for (int mt = 0; mt < 2; ++mt) {
      const int m = wm * 64 + mt * 32 + lr;
#pragma unroll
      for (int nt = 0; nt < 2; ++nt)
#pragma unroll
        for (int qd = 0; qd < 4; ++qd) {
          const int n = nt2 * 128 + wn * 64 + nt * 32 + 8 * qd + 4 * lh;
          const float4 pw4 = *(const float4*)(pw + n);
          *(uint2*)(hid + (size_t)m * 256 + n) =
              make_uint2(pack2(gelu_tanh(acc[nt][mt][4 * qd] + pw4.x), gelu_tanh(acc[nt][mt][4 * qd + 1] + pw4.y)),
                         pack2(gelu_tanh(acc[nt][mt][4 * qd + 2] + pw4.z), gelu_tanh(acc[nt][mt][4 * qd + 3] + pw4.w)));
        }
    }
  }
  __threadfence();
  __syncthreads();
  {
    f32x16 acc[2][2]; zero_acc(acc);
    gemm_mid(W2, 256, hid, 256, 1 << 30, 64, 4, 0, acc, sm);
    if (wn == 0) {
      const float* gain = p.qk_gain + layer * 512 + 320;
#pragma unroll
      for (int mt = 0; mt < 2; ++mt) {
        const int m = wm * 64 + mt * 32 + lr;
        if (kv == 0) {
          float ss = 0.f;
#pragma unroll
          for (int nt = 0; nt < 2; ++nt)
#pragma unroll
            for (int i = 0; i < 16; ++i) ss += acc[nt][mt][i] * acc[nt][mt][i];
          ss += xor32(ss);
          const float r = rsqrtf(ss * (1.f / 64.f) + 1e-6f);
          bf16_t* kc = (bf16_t*)(p.ws + O_KC) + ((size_t)(b * 2 + g) * 256 + m) * 64;
#pragma unroll
          for (int nt = 0; nt < 2; ++nt)
#pragma unroll
            for (int qd = 0; qd < 4; ++qd) {
              const int n = nt * 32 + 8 * qd + 4 * lh;
              const float4 g4 = *(const float4*)(gain + n);
              *(uint2*)(kc + n) = make_uint2(pack2(acc[nt][mt][4 * qd] * r * g4.x, acc[nt][mt][4 * qd + 1] * r * g4.y),
                                             pack2(acc[nt][mt][4 * qd + 2] * r * g4.z, acc[nt][mt][4 * qd + 3] * r * g4.w));
            }
        } else {
          bf16_t* vc = (bf16_t*)(p.ws + O_VCT) + (size_t)(b * 2 + g) * 64 * 256 + m;
#pragma unroll
          for (int nt = 0; nt < 2; ++nt)
#pragma unroll
            for (int i = 0; i < 16; ++i) {
              const int n = nt * 32 + 8 * (i >> 2) + 4 * lh + (i & 3);
              vc[(size_t)n * 256] = f2bf(acc[nt][mt][i]);
            }
        }
      }
    }
  }
}

DI void task_attnA(const P& p, int layer, int task, bf16_t* sm, int dm) {
  const int tid = tidx(), lane = tid & 63, wv = tid >> 6, c = wv & 1, qs = wv >> 1;
  const int lr = lane & 31, lh = lane >> 5;
  const int qb = 31 - (task >> 4), bh = task & 15, b = bh >> 2, h = bh & 3;
  float* tab = (float*)((unsigned char*)sm + 71680);
  bf16x8* qlds = (bf16x8*)((unsigned char*)sm + 72704) + wv * 256 + lane;
  float* xbuf = (float*)((unsigned char*)sm);
  __syncthreads();
  if (tid < 129) tab[tid] = ((const float*)(p.ws + O_TABS))[h * 132 + tid];
  const int q0 = qb * 128, qmin = q0 + qs * 32, qp = qmin + lr;
  bf16_t* aq = (bf16_t*)(p.ws + O_AQ);
  {
    const bf16_t* qptr = aq + (size_t)(b * S_ + qp) * 512 + h * 128 + c * 64 + lh * 8;
#pragma unroll
    for (int ks = 0; ks < 4; ++ks) qlds[ks * 64] = *(const bf16x8*)(qptr + ks * 16);
  }
  f32x16 O[4];
#pragma unroll
  for (int dt = 0; dt < 4; ++dt)
#pragma unroll
    for (int i = 0; i < 16; ++i) O[dt][i] = 0.f;
  float m = -1e30f, l = 0.f;
  const bf16_t* kg = (const bf16_t*)(p.ws + O_AK) + (size_t)b * S_ * 512 + h * 128;
  const bf16_t* vg = (const bf16_t*)(p.ws + O_AVT) + (size_t)((b * 4 + h) * 128) * S_;
  u32x4 rk0, rk1, rv0, rv1;
#define A_GLOAD(i, KT) { const int chk = tid + 512 * i; \
    rk##i = *(const u32x4*)(kg + (size_t)((KT) * 64 + (chk >> 4)) * 512 + (chk & 15) * 8); \
    rv##i = *(const u32x4*)(vg + (size_t)(chk >> 3) * S_ + (KT) * 64 + (chk & 7) * 8); }
#define A_LSTORE(i) { const int chk = tid + 512 * i; \
    *(u32x4*)(Kl + (chk >> 4) * 136 + (chk & 15) * 8) = rk##i; \
    *(u32x4*)(Kl + 64 * 136 + (chk >> 3) * 72 + (chk & 7) * 8) = rv##i; }
  const int kt_hi = 2 * qb + 1;
  A_GLOAD(0, 0) A_GLOAD(1, 0)
  for (int kt = 0; kt <= kt_hi; ++kt) {
    bf16_t* Kl = sm + (kt & 1) * 17920; const bf16_t* Vl = Kl + 64 * 136;
    A_LSTORE(0) A_LSTORE(1)
    if (kt < kt_hi) { A_GLOAD(0, kt + 1) A_GLOAD(1, kt + 1) }
    __syncthreads();
    if (kt * 64 <= qmin + 31) {
      bf16x8 q[4];
#pragma unroll
      for (int ks = 0; ks < 4; ++ks) q[ks] = qlds[ks * 64];
      if (kt * 64 + 63 + 128 <= qmin)
        attn_tile<4, 0, true>(Kl + c * 64, 136, Vl, q, O, m, l, kt * 64, qp, 0, tab[128], tab, true);
      else
        attn_tile<4, 1, true>(Kl + c * 64, 136, Vl, q, O, m, l, kt * 64, qp, 1 << 30, 0.f, tab, true);
    }
  }
#undef A_GLOAD
#undef A_LSTORE
  const float lt = l + xor32(l);
  const float inv = 1.f / lt;
  __syncthreads();
  if (c == 1) {
#pragma unroll
    for (int dt = 0; dt < 4; ++dt)
#pragma unroll
      for (int i = 0; i < 16; ++i) {
        const int d = dt * 32 + 8 * (i >> 2) + 4 * lh + (i & 3);
        xbuf[(qs * 128 + d) * 32 + lr] = O[dt][i] * inv;
      }
  }
  __syncthreads();
  if (c == 0) {
    const float lam = ((const float*)(p.ws + O_LAM))[layer];
    const float li = 0.8f - 0.6f * expf(-0.3f * (float)layer);
    float ss = 0.f;
#pragma unroll
    for (int dt = 0; dt < 4; ++dt)
#pragma unroll
      for (int i = 0; i < 16; ++i) {
        const int d = dt * 32 + 8 * (i >> 2) + 4 * lh + (i & 3);
        const float o = O[dt][i] * inv - lam * xbuf[(qs * 128 + d) * 32 + lr];
        O[dt][i] = o;
        ss += o * o;
      }
    ss += xor32(ss);
    const float r = rsqrtf(ss * (1.f / 128.f) + 1e-6f) * (1.f - li);
    const float* sub = p.diff_subln + layer * 128;
    bf16_t* dst = (dm ? (bf16_t*)(p.ws + WS_END) : aq) + (size_t)(b * S_ + qp) * 512 + h * 128;
#pragma unroll
    for (int dt = 0; dt < 4; ++dt)
#pragma unroll
      for (int qd = 0; qd < 4; ++qd) {
        const int d = dt * 32 + 8 * qd + 4 * lh;
        const float4 g4 = *(const float4*)(sub + d);
        *(uint2*)(dst + d) = make_uint2(pack2(O[dt][4 * qd] * r * g4.x, O[dt][4 * qd + 1] * r * g4.y),
                                        pack2(O[dt][4 * qd + 2] * r * g4.z, O[dt][4 * qd + 3] * r * g4.w));
      }
  }
}

struct KVRegs { u32x4 k0, v0; };
DI void kv_gload(KVRegs& r, const bf16_t* kg, size_t kld, const bf16_t* vg, size_t vld, int key0) {
  const int c0 = tidx();
  r.k0 = *(const u32x4*)(kg + (size_t)(key0 + (c0 >> 3)) * kld + (c0 & 7) * 8);
  r.v0 = *(const u32x4*)(vg + (size_t)(c0 >> 3) * vld + key0 + (c0 & 7) * 8);
}
DI void kv_lstore(const KVRegs& r, bf16_t* Kl, bf16_t* Vl) {
  const int c0 = tidx();
  *(u32x4*)(Kl + (c0 >> 3) * 72 + (c0 & 7) * 8) = r.k0;
  *(u32x4*)(Vl + (c0 >> 3) * 72 + (c0 & 7) * 8) = r.v0;
}

DI void task_attnB(const P& p, int layer, int task, bf16_t* sm, int dm) {
  const int tid = tidx(), lane = tid & 63, wv = tid >> 6, hr = wv & 3, qs = wv >> 2;
  const int lr = lane & 31, lh = lane >> 5;
  const int qb = 63 - (task >> 3), bg = task & 7, b = bg >> 1, g = bg & 1, head = g * 4 + hr;
  float* tabs = (float*)((unsigned char*)sm + 36864);
  __syncthreads();
  for (int i = tid; i < 4 * 129; i += NTHR) {
    const int r = i / 129, d = i % 129;
    tabs[r * 132 + d] = ((const float*)(p.ws + O_TABS))[(4 + g * 4 + r) * 132 + d];
  }
  const int q0 = qb * 64, qmin = q0 + qs * 32, qp = qmin + lr;
  bf16_t* bq = (bf16_t*)(p.ws + O_BQ);
  bf16x8 q[4];
  {
    const bf16_t* qptr = bq + (size_t)(b * S_ + qp) * 512 + head * 64 + lh * 8;
#pragma unroll
    for (int ks = 0; ks < 4; ++ks) q[ks] = *(const bf16x8*)(qptr + ks * 16);
  }
  f32x16 O[2];
#pragma unroll
  for (int dt = 0; dt < 2; ++dt)
#pragma unroll
    for (int i = 0; i < 16; ++i) O[dt][i] = 0.f;
  float m = p.sinks[layer * 8 + head] * LOG2E, l = lh == 0 ? 1.f : 0.f;
  const bf16_t* kg = (const bf16_t*)(p.ws + O_BK) + (size_t)b * S_ * 128 + g * 64;
  const bf16_t* vg = (const bf16_t*)(p.ws + O_BVT) + (size_t)((b * 2 + g) * 64) * S_;
  const int kt_lo = q0 >= 127 ? (q0 - 127) >> 6 : 0, kt_hi = qb;
  KVRegs R;
  kv_gload(R, kg, 128, vg, S_, kt_lo * 64);
  for (int kt = kt_lo; kt <= kt_hi; ++kt) {
    bf16_t* Kl = sm + (kt & 1) * 9216; bf16_t* Vl = Kl + 4608;
    kv_lstore(R, Kl, Vl);
    if (kt < kt_hi) kv_gload(R, kg, 128, vg, S_, (kt + 1) * 64);
    __syncthreads();
    if (kt * 64 <= qmin + 31 && kt * 64 + 63 + 127 >= qmin)
      attn_tile<2, 1, true>(Kl, 72, Vl, q, O, m, l, kt * 64, qp, 128, 0.f, tabs + hr * 132, true);
  }
  const float lt = l + xor32(l);
  const float inv = 1.f / lt;
  bf16_t* dst = (dm ? (bf16_t*)(p.ws + WS_END) : bq) + (size_t)(b * S_ + qp) * 512 + head * 64;
#pragma unroll
  for (int dt = 0; dt < 2; ++dt)
#pragma unroll
    for (int qd = 0; qd < 4; ++qd) {
      const int d = dt * 32 + 8 * qd + 4 * lh;
      *(uint2*)(dst + d) = make_uint2(pack2(O[dt][4 * qd] * inv, O[dt][4 * qd + 1] * inv),
                                      pack2(O[dt][4 * qd + 2] * inv, O[dt][4 * qd + 3] * inv));
    }
}

DI void phase2(const P& p, int layer, bf16_t* sm, unsigned* qhead, int dm = 0) {
  for (;;) {
    const int task = next_task(qhead, sm);
    if (task >= 16 + 512 + 512) break;
    if (task < 16) task_compress(p, layer, task, sm);
    else if (task < 16 + 512) task_attnA(p, layer, task - 16, sm, dm);
    else task_attnB(p, layer, task - 528, sm, dm);
  }
}

DI void task_nsa(const P& p, int layer, int task, bf16_t* sm, int dm) {
  const int tid = tidx(), lane = tid & 63, wv = tid >> 6, hr = wv & 3, qs = wv >> 2;
  const int lr = lane & 31, lh = lane >> 5;
  const int qb = 63 - (task >> 3), bg = task & 7, b = bg >> 1, g = bg & 1, head = g * 4 + hr;
  float* tabs = (float*)((unsigned char*)sm + 36864);
  float* cbuf = (float*)((unsigned char*)sm + 39168);
  unsigned long long* masks = (unsigned long long*)((unsigned char*)sm + 55808);
  float* outl = (float*)((unsigned char*)sm + 56320) + wv * 2048 + lane;
  int itc = 0;
  __syncthreads();
  for (int i = tid; i < 4 * 129; i += NTHR) {
    const int r = i / 129, d = i % 129;
    tabs[r * 132 + d] = ((const float*)(p.ws + O_TABS))[(12 + g * 4 + r) * 132 + d];
  }
  for (int i = tid; i < 64 * 65; i += NTHR) cbuf[i] = 0.f;
  const float* tab = tabs + hr * 132;
  const int q0 = qb * 64, qmin = q0 + qs * 32, ql = qs * 32 + lr, qp = q0 + ql;
  bf16_t* cq = (bf16_t*)(p.ws + O_CQ);
  bf16x8 q[4];
  {
    const bf16_t* qptr = cq + (size_t)(b * S_ + qp) * 512 + head * 64 + lh * 8;
#pragma unroll
    for (int ks = 0; ks < 4; ++ks) q[ks] = *(const bf16x8*)(qptr + ks * 16);
  }
  const float* cg = (const float*)(p.ws + O_CGS) + (size_t)(b * S_ + qp) * 24 + head * 3;
  const float g0 = cg[0], g1 = cg[1], g2 = cg[2];
  f32x16 O[2];
  KVRegs R;
  {
    int nct = (((q0 + 32) >> 4) + 1 + 63) >> 6; if (nct > 4) nct = 4;
    const bf16_t* kg = (const bf16_t*)(p.ws + O_KC) + (size_t)(b * 2 + g) * 256 * 64;
    const bf16_t* vg = (const bf16_t*)(p.ws + O_VCT) + (size_t)(b * 2 + g) * 64 * 256;
#pragma unroll
    for (int dt = 0; dt < 2; ++dt)
#pragma unroll
      for (int i = 0; i < 16; ++i) O[dt][i] = 0.f;
    float m = -1e30f, l = 0.f;
    kv_gload(R, kg, 64, vg, 256, 0);
    for (int ct = 0; ct < nct; ++ct, ++itc) {
      bf16_t* Kl = sm + (itc & 1) * 9216; bf16_t* Vl = Kl + 4608;
      kv_lstore(R, Kl, Vl);
      if (ct + 1 < nct) kv_gload(R, kg, 64, vg, 256, (ct + 1) * 64);
      __syncthreads();
      attn_tile<2, 2, true>(Kl, 72, Vl, q, O, m, l, ct * 64, qp, 0, 0.f, tab, true);
    }
    const float lt = l + xor32(l);
    const float inv = lt > 0.f ? 1.f / lt : 0.f;
    {
      const float sc = g0 * inv;
#pragma unroll
      for (int dt = 0; dt < 2; ++dt)
#pragma unroll
        for (int i = 0; i < 16; ++i) outl[(dt * 16 + i) * 64] = sc * O[dt][i];
    }
    float carry = 0.f;
    kv_gload(R, kg, 64, vg, 256, 0);
    for (int ct = 0; ct < nct; ++ct, ++itc) {
      bf16_t* Kl = sm + (itc & 1) * 9216; bf16_t* Vl = Kl + 4608;
      kv_lstore(R, Kl, Vl);
      if (ct + 1 < nct) kv_gload(R, kg, 64, vg, 256, (ct + 1) * 64);
      __syncthreads();
      float val[2][4];
#pragma unroll
      for (int st = 0; st < 2; ++st) {
        f32x16 s;
#pragma unroll
        for (int i = 0; i < 16; ++i) s[i] = 0.f;
#pragma unroll
        for (int ks = 0; ks < 4; ++ks) {
          bf16x8 kf = *(const bf16x8*)(Kl + (st * 32 + lr) * 72 + ks * 16 + lh * 8);
          s = MFMA32(kf, q[ks], s);
        }
        float pq[4], pl[4], other[4];
#pragma unroll
        for (int g4 = 0; g4 < 4; ++g4) {
          float sum = 0.f, last = 0.f;
#pragma unroll
          for (int e = 0; e < 4; ++e) {
            const int cc = ct * 64 + st * 32 + 8 * g4 + 4 * lh + e;
            const float pe = (16 * cc + 31 <= qp) ? ex2(s[4 * g4 + e] - m) * inv : 0.f;
            sum += pe; last = pe;
          }
          pq[g4] = sum; pl[g4] = last;
        }
#pragma unroll
        for (int g4 = 0; g4 < 4; ++g4) other[g4] = xor32(pl[g4]);
        val[st][0] = pq[0] + (lh ? other[0] : carry);
        val[st][1] = pq[1] + (lh ? other[1] : other[0]);
        val[st][2] = pq[2] + (lh ? other[2] : other[1]);
        val[st][3] = pq[3] + (lh ? other[3] : other[2]);
        carry = other[3];
      }
      for (int w = 0; w < 4; ++w) {
        if (hr == w) {
#pragma unroll
          for (int st = 0; st < 2; ++st)
#pragma unroll
            for (int g4 = 0; g4 < 4; ++g4) cbuf[(ct * 16 + st * 8 + 2 * g4 + lh) * 65 + ql] += val[st][g4];
        }
        __syncthreads();
      }
    }
  }
  __syncthreads();
  for (int qi = 0; qi < 8; ++qi) {
    const int qq = wv * 8 + qi, qpos = q0 + qq, j = lane, cur = qpos >> 6;
    const float imp = cbuf[j * 65 + qq];
    const bool valid = j <= cur;
    const bool forced = (j == 0) || (j == cur) || (j == cur - 1);
    const float score = valid ? imp + (forced ? 1e4f : 0.f) : -1e30f;
    int rank = 0;
#pragma unroll 4
    for (int jp = 0; jp < 64; ++jp) {
      const float sj = __int_as_float(__builtin_amdgcn_readlane(__float_as_int(score), jp));
      rank += ((sj > score) || (sj == score && jp < j)) ? 1 : 0;
    }
    const unsigned long long mk = __ballot(rank < 16);
    if (lane == 0) masks[qq] = mk;
  }
  __syncthreads();
  const unsigned long long mymask = masks[ql];
  unsigned long long un = 0ull;
  for (int i = 0; i < 64; ++i) un |= masks[i];
  {
    const int cmax = qb;
    unsigned long long todo = un & (cmax == 63 ? ~0ull : ((1ull << (cmax + 1)) - 1ull));
    const bf16_t* kg = (const bf16_t*)(p.ws + O_KS) + (size_t)b * S_ * 128 + g * 64;
    const bf16_t* vg = (const bf16_t*)(p.ws + O_VST) + (size_t)((b * 2 + g) * 64) * S_;
#pragma unroll
    for (int dt = 0; dt < 2; ++dt)
#pragma unroll
      for (int i = 0; i < 16; ++i) O[dt][i] = 0.f;
    float m = -1e30f, l = 0.f;
    kv_gload(R, kg, 128, vg, S_, (__ffsll((long long)todo) - 1) * 64);
    for (; todo; ++itc) {
      const int j = __ffsll((long long)todo) - 1;
      todo &= todo - 1ull;
      bf16_t* Kl = sm + (itc & 1) * 9216; bf16_t* Vl = Kl + 4608;
      kv_lstore(R, Kl, Vl);
      if (todo) kv_gload(R, kg, 128, vg, S_, (__ffsll((long long)todo) - 1) * 64);
      __syncthreads();
      const bool on = (mymask >> j) & 1ull;
      if (j * 64 <= qmin + 31 && __ballot(on)) {
        if (j * 64 + 63 + 128 <= qmin)
          attn_tile<2, 0, false>(Kl, 72, Vl, q, O, m, l, j * 64, qp, 0, tab[128], tab, on);
        else
          attn_tile<2, 1, false>(Kl, 72, Vl, q, O, m, l, j * 64, qp, 1 << 30, 0.f, tab, on);
      }
    }
    const float lt = l + xor32(l);
    const float inv = lt > 0.f ? 1.f / lt : 0.f;
    {
      const float sc = g1 * inv;
#pragma unroll
      for (int dt = 0; dt < 2; ++dt)
#pragma unroll
        for (int i = 0; i < 16; ++i) outl[(dt * 16 + i) * 64] += sc * O[dt][i];
    }
  }
  {
    const bf16_t* kg = (const bf16_t*)(p.ws + O_KW) + (size_t)b * S_ * 128 + g * 64;
    const bf16_t* vg = (const bf16_t*)(p.ws + O_VWT) + (size_t)((b * 2 + g) * 64) * S_;
#pragma unroll
    for (int dt = 0; dt < 2; ++dt)
#pragma unroll
      for (int i = 0; i < 16; ++i) O[dt][i] = 0.f;
    float m = -1e30f, l = 0.f;
    const int kt_lo = q0 >= 511 ? (q0 - 511) >> 6 : 0, kt_hi = qb;
    kv_gload(R, kg, 128, vg, S_, kt_lo * 64);
    for (int kt = kt_lo; kt <= kt_hi; ++kt, ++itc) {
      bf16_t* Kl = sm + (itc & 1) * 9216; bf16_t* Vl = Kl + 4608;
      kv_lstore(R, Kl, Vl);
      if (kt < kt_hi) kv_gload(R, kg, 128, vg, S_, (kt + 1) * 64);
      __syncthreads();
      if (kt * 64 <= qmin + 31 && kt * 64 + 63 + 511 >= qmin) {
        if (kt * 64 + 63 + 128 <= qmin && qmin + 31 - kt * 64 < 512)
          attn_tile<2, 0, true>(Kl, 72, Vl, q, O, m, l, kt * 64, qp, 0, tab[128], tab, true);
        else
          attn_tile<2, 1, true>(Kl, 72, Vl, q, O, m, l, kt * 64, qp, 512, 0.f, tab, true);
      }
    }
    const float lt = l + xor32(l);
    const float inv = 1.f / lt;
    {
      const float sc = g2 * inv;
#pragma unroll
      for (int dt = 0; dt < 2; ++dt)
#pragma unroll
        for (int i = 0; i < 16; ++i) O[dt][i] = outl[(dt * 16 + i) * 64] + sc * O[dt][i];
    }
  }
  bf16_t* dst = (dm ? (bf16_t*)(p.ws + WS_END) : cq) + (size_t)(b * S_ + qp) * 512 + head * 64;
#pragma unroll
  for (int dt = 0; dt < 2; ++dt)
#pragma unroll
    for (int qd = 0; qd < 4; ++qd) {
      const int d = dt * 32 + 8 * qd + 4 * lh;
      *(uint2*)(dst + d) = make_uint2(pack2(O[dt][4 * qd], O[dt][4 * qd + 1]), pack2(O[dt][4 * qd + 2], O[dt][4 * qd + 3]));
    }
}

DI void phase3(const P& p, int layer, bf16_t* sm, unsigned* qhead, int dm = 0) {
  for (;;) {
    const int task = next_task(qhead, sm);
    if (task >= 512) break;
    task_nsa(p, layer, task, sm, dm);
  }
}

DI void phase_merge(const P& p, int layer, bf16_t* sm, const Geo& ge) {
  const int tid = tidx(), lane = tid & 63, wv = tid >> 6, wn = wv & 1, wm = wv >> 1;
  const int lr = lane & 31, lh = lane >> 5;
  const bf16_t* W = (const bf16_t*)(p.ws + O_WBR + layer * SZ_WBR);
  const bf16_t* mgs = (const bf16_t*)(p.ws + O_MGS);
  bf16_t* z = (bf16_t*)(p.ws + O_Z);
  TileWalk tw(8, ge);
  int mt_, nt_;
  while (tw.next(mt_, nt_)) {
    unsigned zp[2][2][8];
#pragma unroll
    for (int a_ = 0; a_ < 2; ++a_)
#pragma unroll
      for (int b_ = 0; b_ < 2; ++b_)
#pragma unroll
        for (int i = 0; i < 8; ++i) zp[a_][b_][i] = 0u;
    for (int n3 = 0; n3 < 3; ++n3) {
      const bf16_t* X = (const bf16_t*)(p.ws + (n3 == 0 ? O_AQ : (n3 == 1 ? O_BQ : O_CQ)));
      f32x16 acc[2][2]; zero_acc(acc);
      gemm_mid(W + ((size_t)n3 * 1024 + nt_ * 128) * 512, 512, X, 512, 1 << 30, 64, 8, mt_ * 256, acc, sm);
#pragma unroll
      for (int mt = 0; mt < 2; ++mt) {
        const int m = mt_ * 256 + wm * 64 + mt * 32 + lr;
#pragma unroll
        for (int nt = 0; nt < 2; ++nt)
#pragma unroll
          for (int qd = 0; qd < 4; ++qd) {
            const int n = nt_ * 128 + wn * 64 + nt * 32 + 8 * qd + 4 * lh;
            const uint2 gq = *(const uint2*)(mgs + ((size_t)((n3 * 1024 + n) >> 2) * T_ + m) * 4);
            const unsigned z01 = zp[nt][mt][2 * qd], z23 = zp[nt][mt][2 * qd + 1];
            const float v0 = bf2f((bf16_t)(z01 & 0xffff)) + bf2f((bf16_t)(gq.x & 0xffff)) * acc[nt][mt][4 * qd];
            const float v1 = bf2f((bf16_t)(z01 >> 16)) + bf2f((bf16_t)(gq.x >> 16)) * acc[nt][mt][4 * qd + 1];
            const float v2 = bf2f((bf16_t)(z23 & 0xffff)) + bf2f((bf16_t)(gq.y & 0xffff)) * acc[nt][mt][4 * qd + 2];
            const float v3 = bf2f((bf16_t)(z23 >> 16)) + bf2f((bf16_t)(gq.y >> 16)) * acc[nt][mt][4 * qd + 3];
            zp[nt][mt][2 * qd] = pack2(v0, v1);
            zp[nt][mt][2 * qd + 1] = pack2(v2, v3);
          }
      }
    }
    bf16_t* stg = sm + wv * (64 * 72);
#pragma unroll
    for (int mt = 0; mt < 2; ++mt)
#pragma unroll
      for (int nt = 0; nt < 2; ++nt)
#pragma unroll
        for (int qd = 0; qd < 4; ++qd)
          *(uint2*)(stg + (mt * 32 + lr) * 72 + nt * 32 + 8 * qd + 4 * lh) = make_uint2(zp[nt][mt][2 * qd], zp[nt][mt][2 * qd + 1]);
#pragma unroll
    for (int it = 0; it < 8; ++it) {
      const int row = it * 8 + (lane >> 3), c16 = lane & 7;
      const u32x4 v = *(const u32x4*)(stg + row * 72 + c16 * 8);
      *(u32x4*)(z + (size_t)(mt_ * 256 + wm * 64 + row) * LDK1 + nt_ * 128 + wn * 64 + c16 * 8) = v;
    }
  }
}

DI void phase_resid(const P& p, const bf16_t* W, const bf16_t* X, int K, bf16_t* sm, const Geo& ge, bool last) {
  const int tid = tidx(), lane = tid & 63, wv = tid >> 6, wn = wv & 1, wm = wv >> 1;
  const int lr = lane & 31, lh = lane >> 5;
  bf16_t* xb = (bf16_t*)(p.ws + O_XB);
  float* part = (float*)(p.ws + O_PART);
  TileWalk tw(4, ge);
  int mt_, nt_;
  while (tw.next(mt_, nt_)) {
    f32x16 acc[4][2]; zero_acc8(acc);
    const int ldk = K + 64;
    gemm_wide(W + (size_t)nt_ * 256 * ldk, ldk, X + (size_t)mt_ * 256 * ldk, ldk, K / 64, acc, sm);
    float* stg = (float*)sm + wv * (64 * 68);
    const int m0w = mt_ * 256 + wm * 64, n0w = nt_ * 256 + wn * 128;
#pragma unroll
    for (int cp = 0; cp < 2; ++cp) {
#pragma unroll 4
      for (int it = 0; it < 8; ++it) {
        const int row = it * 8 + (lane >> 3), c8 = (lane & 7) * 8;
        const u32x4 raw = *(const u32x4*)(xb + (size_t)(m0w + row) * LDK1 + n0w + cp * 64 + c8);
        float* d = stg + row * 68 + c8;
        *(float4*)(d) = make_float4(__uint_as_float(raw[0] << 16), __uint_as_float(raw[0] & 0xffff0000u),
                                    __uint_as_float(raw[1] << 16), __uint_as_float(raw[1] & 0xffff0000u));
        *(float4*)(d + 4) = make_float4(__uint_as_float(raw[2] << 16), __uint_as_float(raw[2] & 0xffff0000u),
                                        __uint_as_float(raw[3] << 16), __uint_as_float(raw[3] & 0xffff0000u));
      }
#pragma unroll
      for (int mt = 0; mt < 2; ++mt) {
        float ss = 0.f;
#pragma unroll
        for (int nh = 0; nh < 2; ++nh)
#pragma unroll
          for (int qd = 0; qd < 4; ++qd) {
            const int nt = cp * 2 + nh;
            float4* sp = (float4*)(stg + (mt * 32 + lr) * 68 + nh * 32 + 8 * qd + 4 * lh);
            float4 v = *sp;
            v.x += acc[nt][mt][4 * qd]; v.y += acc[nt][mt][4 * qd + 1]; v.z += acc[nt][mt][4 * qd + 2]; v.w += acc[nt][mt][4 * qd + 3];
            *sp = v;
            ss += v.x * v.x + v.y * v.y + v.z * v.z + v.w * v.w;
          }
        ss += xor32(ss);
        if (lh == 0) part[(size_t)(m0w + mt * 32 + lr) * 16 + nt_ * 4 + wn * 2 + cp] = ss;
      }
#pragma unroll 4
      for (int it = 0; it < 16; ++it) {
        const int row = it * 4 + (lane >> 4), c4 = (lane & 15) * 4;
        const float4 v = *(const float4*)(stg + row * 68 + c4);
        if (last) *(float4*)(p.out + (size_t)(m0w + row) * 1024 + n0w + cp * 64 + c4) = v;
        *(uint2*)(xb + (size_t)(m0w + row) * LDK1 + n0w + cp * 64 + c4) = make_uint2(pack2(v.x, v.y), pack2(v.z, v.w));
      }
    }
  }
}

DI void phase_up(const P& p, int layer, bf16_t* sm, const Geo& ge) {
  const int tid = tidx(), lane = tid & 63, wv = tid >> 6, wn = wv & 1, wm = wv >> 1;
  const int lr = lane & 31, lh = lane >> 5;
  const bf16_t* W = (const bf16_t*)(p.ws + O_WUP + layer * SZ_WUP);
  const bf16_t* X = (const bf16_t*)(p.ws + O_XB);
  const float* part = (const float*)(p.ws + O_PART);
  bf16_t* u = (bf16_t*)(p.ws + O_U);
  TileWalk tw(16, ge);
  int mt_, nt_, mt_have = -1;
  float rs0 = 0.f, rs1 = 0.f;
  while (tw.next(mt_, nt_)) {
    if (mt_ != mt_have) {
      rs0 = row_rstd(part, mt_ * 256 + wm * 64 + lr);
      rs1 = row_rstd(part, mt_ * 256 + wm * 64 + 32 + lr);
      mt_have = mt_;
    }
    f32x16 acc[4][2]; zero_acc8(acc);
    gemm_wide(W + (size_t)nt_ * 256 * LDK1, LDK1, X + (size_t)mt_ * 256 * LDK1, LDK1, 16, acc, sm);
    bf16_t* stg = sm + wv * (64 * 136);
#pragma unroll
    for (int mt = 0; mt < 2; ++mt) {
      const float rs = mt ? rs1 : rs0;
#pragma unroll
      for (int nt = 0; nt < 4; ++nt)
#pragma unroll
        for (int qd = 0; qd < 4; ++qd) {
          const int n = nt_ * 256 + wn * 128 + nt * 32 + 8 * qd + 4 * lh;
          float a = fmaxf(acc[nt][mt][4 * qd] * rs, 0.f), b = fmaxf(acc[nt][mt][4 * qd + 1] * rs, 0.f);
          float c = fmaxf(acc[nt][mt][4 * qd + 2] * rs, 0.f), d = fmaxf(acc[nt][mt][4 * qd + 3] * rs, 0.f);
          *(uint2*)(stg + (mt * 32 + lr) * 136 + nt * 32 + 8 * qd + 4 * lh) = make_uint2(pack2(a * a, b * b), pack2(c * c, d * d));
        }
    }
    stage_rows_store(stg, u + nt_ * 256 + wn * 128, LDK4, mt_ * 256 + wm * 64);
  }
}

DI unsigned xcc_id() { return (unsigned)__builtin_amdgcn_s_getreg((3 << 11) | 20) & 0xFu; }
struct BarCtx { unsigned* base; unsigned xcc, xcnt, nxcc, gen; };
DI void gbar(BarCtx& c) {
  ++c.gen;
  asm volatile("s_waitcnt vmcnt(0) lgkmcnt(0)" ::: "memory");
  __syncthreads();
  if (threadIdx.x == 0) {
    const unsigned old = __hip_atomic_fetch_add(c.base + (16 + c.xcc) * 32, 1u, __ATOMIC_RELAXED, __HIP_MEMORY_SCOPE_AGENT);
    if (old % c.xcnt == c.xcnt - 1) {
      __builtin_amdgcn_fence(__ATOMIC_RELEASE, "agent");
      asm volatile("s_waitcnt vmcnt(0)" ::: "memory");
      const unsigned t = __hip_atomic_fetch_add(c.base + 32 * 32, 1u, __ATOMIC_RELAXED, __HIP_MEMORY_SCOPE_AGENT);
      if (t % c.nxcc == c.nxcc - 1) {
        for (unsigned i = 0; i < 16; ++i)
          __hip_atomic_store(c.base + (33 + i) * 32, c.gen, __ATOMIC_RELAXED, __HIP_MEMORY_SCOPE_AGENT);
      }
    }
    while (__hip_atomic_load(c.base + (33 + c.xcc) * 32, __ATOMIC_RELAXED, __HIP_MEMORY_SCOPE_AGENT) < c.gen) __builtin_amdgcn_s_sleep(1);
    __builtin_amdgcn_fence(__ATOMIC_ACQUIRE, "agent");
    asm volatile("s_waitcnt vmcnt(0)" ::: "memory");
  }
  __syncthreads();
}

__global__ void __launch_bounds__(512, 2) mega(P p) {
  extern __shared__ __attribute__((aligned(16))) unsigned char smraw[];
  bf16_t* sm = (bf16_t*)smraw;
  cg::grid_group grid = cg::this_grid();
  if (threadIdx.x == 0)
    ((unsigned*)smraw)[0] = __hip_atomic_fetch_add((unsigned*)(p.ws + O_BAR) + xcc_id() * 32, 1u, __ATOMIC_RELAXED, __HIP_MEMORY_SCOPE_AGENT);
  __syncthreads();
  const unsigned my_rank = (unsigned)__builtin_amdgcn_readfirstlane((int)((volatile unsigned*)smraw)[0]);
  __syncthreads();
#ifndef PHMASK
#define PHMASK 0xff
#endif
  if (PHMASK & 1) phase0(p, sm);
  grid.sync();
  BarCtx bc;
  bc.base = (unsigned*)(p.ws + O_BAR); bc.xcc = xcc_id(); bc.gen = 0;
  bc.xcnt = (unsigned)__builtin_amdgcn_readfirstlane((int)__hip_atomic_load(bc.base + bc.xcc * 32, __ATOMIC_RELAXED, __HIP_MEMORY_SCOPE_AGENT));
  bc.nxcc = 0;
  for (unsigned i = 0; i < 16; ++i) bc.nxcc += __hip_atomic_load(bc.base + i * 32, __ATOMIC_RELAXED, __HIP_MEMORY_SCOPE_AGENT) ? 1u : 0u;
  bc.nxcc = (unsigned)__builtin_amdgcn_readfirstlane((int)bc.nxcc);
  unsigned hi_cnt = 0;
  for (unsigned i = 8; i < 16; ++i) hi_cnt += __hip_atomic_load(bc.base + i * 32, __ATOMIC_RELAXED, __HIP_MEMORY_SCOPE_AGENT);
  hi_cnt = (unsigned)__builtin_amdgcn_readfirstlane((int)hi_cnt);
  Geo ge;
  if (bc.nxcc == 8 && hi_cnt == 0) { ge.xcd = (int)bc.xcc; ge.loc = (int)my_rank; ge.nloc = (int)bc.xcnt; }
  else { ge.xcd = blockIdx.x & 7; ge.loc = blockIdx.x >> 3; ge.nloc = gridDim.x >> 3; }
  unsigned* qheads = bc.base + 64 * 32;
  for (int layer = 0; layer < NL; ++layer) {
    if (PHMASK & 2) phase_inproj(p, layer, sm, ge);
    gbar(bc);
    if (PHMASK & 4) phase2(p, layer, sm, qheads + (layer * 2) * 32);
    gbar(bc);
    if (PHMASK & 8) phase3(p, layer, sm, qheads + (layer * 2 + 1) * 32);
    gbar(bc);
    if (PHMASK & 16) phase_merge(p, layer, sm, ge);
    gbar(bc);
    if (PHMASK & 32) phase_resid(p, (const bf16_t*)(p.ws + O_WO + layer * SZ_WO), (const bf16_t*)(p.ws + O_Z), 1024, sm, ge, false);
    gbar(bc);
    if (PHMASK & 64) phase_up(p, layer, sm, ge);
    gbar(bc);
    if (PHMASK & 128) phase_resid(p, (const bf16_t*)(p.ws + O_WDN + layer * SZ_WDN), (const bf16_t*)(p.ws + O_U), 4096, sm, ge, layer == NL - 1);
    gbar(bc);
  }
}

extern "C" void kernel_launch(void* const* d_in, const int* in_sizes, int n_in, void* d_out, int out_size, void* d_ws,
                              size_t ws_size, hipStream_t stream) {
  static int grid_blocks = 0;
  if (!grid_blocks) {
    int dev = 0, cus = 0, per_cu = 0;
    (void)hipGetDevice(&dev);
    (void)hipDeviceGetAttribute(&cus, hipDeviceAttributeMultiprocessorCount, dev);
    (void)hipFuncSetAttribute((const void*)mega, hipFuncAttributeMaxDynamicSharedMemorySize, LDS_BYTES);
    (void)hipOccupancyMaxActiveBlocksPerMultiprocessor(&per_cu, (const void*)mega, NTHR, LDS_BYTES);
    if (per_cu < 1) per_cu = 1;
    if (per_cu > 1) per_cu = 1;
    grid_blocks = cus * per_cu;
    if (ws_size < WS_END) fprintf(stderr, "workspace too small: %zu < %zu\n", ws_size, (size_t)WS_END);
  }
  P p{};
  p.x = (const float*)d_in[0]; p.w_in = (const float*)d_in[1]; p.qk_gain = (const float*)d_in[2];
  p.diff_lambda = (const float*)d_in[3]; p.diff_subln = (const float*)d_in[4]; p.sinks = (const float*)d_in[5];
  p.cmp_pos = (const float*)d_in[6]; p.cmp_w1 = (const float*)d_in[7]; p.cmp_w2 = (const float*)d_in[8];
  p.w_branch = (const float*)d_in[9]; p.w_out = (const float*)d_in[10]; p.norm_mix = (const float*)d_in[11];
  p.norm_mlp = (const float*)d_in[12]; p.w_up = (const float*)d_in[13]; p.w_down = (const float*)d_in[14];
  p.rel_bias = (const float*)d_in[15];
  p.out = (float*)d_out; p.ws = (unsigned char*)d_ws;
  (void)hipMemsetAsync((unsigned char*)d_ws + O_BAR, 0, 80 * 128, stream);
  void* args[] = {&p};
  hipError_t e = hipLaunchCooperativeKernel((const void*)mega, dim3(grid_blocks), dim3(NTHR), args, LDS_BYTES, stream);
  if (e != hipSuccess) fprintf(stderr, "cooperative launch failed: %s (grid %d)\n", hipGetErrorString(e), grid_blocks);
}
```

```cpp
#include <hip/hip_runtime.h>
#include <hip/hip_cooperative_groups.h>
#include <cstdio>
namespace cg = cooperative_groups;

typedef unsigned short bf16_t;
using bf16x8 = __attribute__((ext_vector_type(8))) short;
using f32x16 = __attribute__((ext_vector_type(16))) float;
using u32x4 = __attribute__((ext_vector_type(4))) unsigned;
#define DI __device__ __forceinline__
#define MFMA32(a, b, c) __builtin_amdgcn_mfma_f32_32x32x16_bf16((a), (b), (c), 0, 0, 0)

constexpr int S_ = 4096, T_ = 16384, NL = 4;
constexpr int NIN = 6680, NINP = 6912;
constexpr int LDS_BYTES = 147456;
constexpr int NTHR = 512;
constexpr int LDT = 72;
constexpr int LDK1 = 1088, LDK4 = 4160;
constexpr int WT_E = 256 * LDT;

constexpr size_t SZ_WIN = (size_t)NINP * LDK1 * 2;
constexpr size_t SZ_WBR = (size_t)3 * 1024 * 512 * 2;
constexpr size_t SZ_WO = (size_t)1024 * LDK1 * 2;
constexpr size_t SZ_WUP = (size_t)4096 * LDK1 * 2;
constexpr size_t SZ_WDN = (size_t)1024 * LDK4 * 2;
constexpr size_t SZ_W1 = (size_t)2 * 256 * 2048 * 2;
constexpr size_t SZ_W2 = (size_t)2 * 128 * 256 * 2;
constexpr size_t O_WIN = 0;
constexpr size_t O_WBR = O_WIN + NL * SZ_WIN;
constexpr size_t O_WO = O_WBR + NL * SZ_WBR;
constexpr size_t O_WUP = O_WO + NL * SZ_WO;
constexpr size_t O_WDN = O_WUP + NL * SZ_WUP;
constexpr size_t O_W1 = O_WDN + NL * SZ_WDN;
constexpr size_t O_W2 = O_W1 + NL * SZ_W1;
constexpr size_t O_POSW1 = O_W2 + NL * SZ_W2;
constexpr size_t O_LAM = O_POSW1 + (size_t)NL * 2 * 256 * 4;
constexpr size_t O_TABS = O_LAM + 256;
constexpr size_t O_PART = O_TABS + 20 * 132 * 4 + 192;
constexpr size_t O_XB = ((O_PART + (size_t)T_ * 16 * 4 + 255) / 256) * 256;
constexpr size_t O_ACT = O_XB + (size_t)T_ * LDK1 * 2;
constexpr size_t O_AQ = O_ACT;
constexpr size_t O_BQ = O_AQ + (size_t)T_ * 512 * 2;
constexpr size_t O_CQ = O_BQ + (size_t)T_ * 512 * 2;
constexpr size_t O_AK = O_CQ + (size_t)T_ * 512 * 2;
constexpr size_t O_AVT = O_AK + (size_t)T_ * 512 * 2;
constexpr size_t O_Z = O_AK;
constexpr size_t O_BK = O_AVT + (size_t)T_ * 512 * 2;
constexpr size_t SZ_S = (size_t)T_ * 128 * 2;
constexpr size_t O_BVT = O_BK + SZ_S;
constexpr size_t O_CK = O_BVT + SZ_S;
constexpr size_t O_CV = O_CK + SZ_S;
constexpr size_t O_KS = O_CV + SZ_S + 65536;
constexpr size_t O_VST = O_KS + SZ_S;
constexpr size_t O_KW = O_VST + SZ_S;
constexpr size_t O_VWT = O_KW + SZ_S;
constexpr size_t O_CGS = O_VWT + SZ_S;
constexpr size_t O_MGS = O_CGS + (size_t)T_ * 24 * 4;
constexpr size_t O_HID = O_MGS + (size_t)T_ * 3072 * 2;
constexpr size_t O_KC = O_HID + (size_t)16 * 256 * 256 * 2;
constexpr size_t O_VCT = O_KC + (size_t)8 * 256 * 64 * 2;
constexpr size_t O_U = O_ACT;
constexpr size_t O_BAR = O_VCT + (size_t)8 * 256 * 64 * 2;
constexpr size_t WS_END = O_BAR + 80 * 128;
static_assert(O_Z + (size_t)T_ * LDK1 * 2 <= O_CGS && O_U + (size_t)T_ * LDK4 * 2 <= O_HID, "u must fit in the aliased region");

struct P {
  const float* x; const float* w_in; const float* qk_gain; const float* diff_lambda; const float* diff_subln;
  const float* sinks; const float* cmp_pos; const float* cmp_w1; const float* cmp_w2; const float* w_branch;
  const float* w_out; const float* norm_mix; const float* norm_mlp; const float* w_up; const float* w_down;
  const float* rel_bias;
  float* out; unsigned char* ws;
};

DI int tidx() { int t = threadIdx.x; asm volatile("" : "+v"(t)); return t; }
DI bf16_t f2bf(float x) { unsigned u = __float_as_uint(x); u += 0x7fffu + ((u >> 16) & 1u); return (bf16_t)(u >> 16); }
DI float bf2f(bf16_t b) { return __uint_as_float(((unsigned)b) << 16); }
typedef float f32x2_t __attribute__((ext_vector_type(2)));
typedef __bf16 bf16x2_t __attribute__((ext_vector_type(2)));
DI unsigned pack2(float a, float b) { f32x2_t v = {a, b}; bf16x2_t r = __builtin_convertvector(v, bf16x2_t); return __builtin_bit_cast(unsigned, r); }
constexpr float LOG2E = 1.4426950408889634f;
constexpr float QSCL = 0.125f * LOG2E;
DI float ex2(float x) { return __builtin_amdgcn_exp2f(x); }
DI float sigmoidf_(float x) { return __builtin_amdgcn_rcpf(1.f + ex2(-LOG2E * x)); }
DI float xor32(float v) { return __shfl_xor(v, 32); }

DI void gemm_wide(const bf16_t* __restrict__ W, int ldw, const bf16_t* __restrict__ X, int ldx, int nkt,
                  f32x16 (&acc)[4][2], bf16_t* lds) {
  const int tid = tidx(), lane = tid & 63, wv = tid >> 6, wn = wv & 1, wm = wv >> 1;
  const int lr = lane & 31, lh = lane >> 5;
  const int lrow = tid >> 3, lkc = (tid & 7) * 8;
  const bf16_t* wp = W + (size_t)lrow * ldw + lkc;
  const bf16_t* xp = X + (size_t)lrow * ldx + lkc;
  const size_t wst = (size_t)64 * ldw, xst = (size_t)64 * ldx;
  u32x4 rw0, rw1, rw2, rw3, rx0, rx1, rx2, rx3;
#define GW_GLOAD(KT) { const size_t ko_ = (size_t)(KT) * 64; \
    rw0 = *(const u32x4*)(wp + ko_); rw1 = *(const u32x4*)(wp + wst + ko_); \
    rw2 = *(const u32x4*)(wp + 2 * wst + ko_); rw3 = *(const u32x4*)(wp + 3 * wst + ko_); \
    rx0 = *(const u32x4*)(xp + ko_); rx1 = *(const u32x4*)(xp + xst + ko_); \
    rx2 = *(const u32x4*)(xp + 2 * xst + ko_); rx3 = *(const u32x4*)(xp + 3 * xst + ko_); }
#define GW_LSTORE(BUF) { bf16_t* wb_ = lds + (BUF) * 2 * WT_E + lrow * LDT + lkc; bf16_t* xb_ = wb_ + WT_E; \
    *(u32x4*)(wb_) = rw0; *(u32x4*)(wb_ + 64 * LDT) = rw1; *(u32x4*)(wb_ + 128 * LDT) = rw2; *(u32x4*)(wb_ + 192 * LDT) = rw3; \
    *(u32x4*)(xb_) = rx0; *(u32x4*)(xb_ + 64 * LDT) = rx1; *(u32x4*)(xb_ + 128 * LDT) = rx2; *(u32x4*)(xb_ + 192 * LDT) = rx3; }
  u32x4 sw0, sw1, sw2, sw3, sx0, sx1, sx2, sx3;
#define GW_GLOAD_B(KT) { const size_t ko_ = (size_t)(KT) * 64; \
    sw0 = *(const u32x4*)(wp + ko_); sw1 = *(const u32x4*)(wp + wst + ko_); \
    sw2 = *(const u32x4*)(wp + 2 * wst + ko_); sw3 = *(const u32x4*)(wp + 3 * wst + ko_); \
    sx0 = *(const u32x4*)(xp + ko_); sx1 = *(const u32x4*)(xp + xst + ko_); \
    sx2 = *(const u32x4*)(xp + 2 * xst + ko_); sx3 = *(const u32x4*)(xp + 3 * xst + ko_); }
#define GW_LSTORE_B(BUF) { bf16_t* wb_ = lds + (BUF) * 2 * WT_E + lrow * LDT + lkc; bf16_t* xb_ = wb_ + WT_E; \
    *(u32x4*)(wb_) = sw0; *(u32x4*)(wb_ + 64 * LDT) = sw1; *(u32x4*)(wb_ + 128 * LDT) = sw2; *(u32x4*)(wb_ + 192 * LDT) = sw3; \
    *(u32x4*)(xb_) = sx0; *(u32x4*)(xb_ + 64 * LDT) = sx1; *(u32x4*)(xb_ + 128 * LDT) = sx2; *(u32x4*)(xb_ + 192 * LDT) = sx3; }
#define GW_KS(KT, ks) { \
      const bf16_t* wb = lds + ((KT) & 1) * 2 * WT_E + (wn * 128 + lr) * LDT + lh * 8; \
      const bf16_t* xb = lds + ((KT) & 1) * 2 * WT_E + WT_E + (wm * 64 + lr) * LDT + lh * 8; \
      const bf16x8 b0 = *(const bf16x8*)(xb + (ks) * 16), b1 = *(const bf16x8*)(xb + 32 * LDT + (ks) * 16); \
      const bf16x8 a0 = *(const bf16x8*)(wb + (ks) * 16), a1 = *(const bf16x8*)(wb + 32 * LDT + (ks) * 16); \
      const bf16x8 a2 = *(const bf16x8*)(wb + 64 * LDT + (ks) * 16), a3 = *(const bf16x8*)(wb + 96 * LDT + (ks) * 16); \
      acc[0][0] = MFMA32(a0, b0, acc[0][0]); acc[0][1] = MFMA32(a0, b1, acc[0][1]); \
      acc[1][0] = MFMA32(a1, b0, acc[1][0]); acc[1][1] = MFMA32(a1, b1, acc[1][1]); \
      acc[2][0] = MFMA32(a2, b0, acc[2][0]); acc[2][1] = MFMA32(a2, b1, acc[2][1]); \
      acc[3][0] = MFMA32(a3, b0, acc[3][0]); acc[3][1] = MFMA32(a3, b1, acc[3][1]); }
#define GW_ST2(BUF, OFF, R0, R1) { bf16_t* d_ = lds + (BUF) * 2 * WT_E + (OFF) + lrow * LDT + lkc; \
      *(u32x4*)(d_) = R0; *(u32x4*)(d_ + 64 * LDT) = R1; }
  __syncthreads();
  GW_GLOAD(0)
  GW_LSTORE(0)
  GW_GLOAD(1)
  GW_GLOAD_B(nkt > 2 ? 2 : nkt - 1)
  __syncthreads();
  for (int kt = 0; kt < nkt; kt += 2) {
    __builtin_amdgcn_sched_barrier(0);
    GW_ST2(1, 0, rw0, rw1)                         GW_KS(kt, 0)
    GW_ST2(1, 128 * LDT, rw2, rw3)                 GW_KS(kt, 1)
    GW_ST2(1, WT_E, rx0, rx1)                      GW_KS(kt, 2)
    GW_ST2(1, WT_E + 128 * LDT, rx2, rx3)          GW_KS(kt, 3)
    __builtin_amdgcn_sched_barrier(0);
    GW_GLOAD(kt + 3 < nkt ? kt + 3 : nkt - 1)
    __syncthreads();
    __builtin_amdgcn_sched_barrier(0);
    GW_ST2(0, 0, sw0, sw1)                         GW_KS(kt + 1, 0)
    GW_ST2(0, 128 * LDT, sw2, sw3)                 GW_KS(kt + 1, 1)
    GW_ST2(0, WT_E, sx0, sx1)                      GW_KS(kt + 1, 2)
    GW_ST2(0, WT_E + 128 * LDT, sx2, sx3)          GW_KS(kt + 1, 3)
    __builtin_amdgcn_sched_barrier(0);
    GW_GLOAD_B(kt + 4 < nkt ? kt + 4 : nkt - 1)
    __syncthreads();
  }
#undef GW_KS
#undef GW_ST2
#undef GW_GLOAD_B
#undef GW_LSTORE_B
#undef GW_GLOAD
#undef GW_LSTORE
}

constexpr int MID_E = (128 + 256) * LDT;
DI void gemm_mid(const bf16_t* __restrict__ W, int ldw, const bf16_t* __restrict__ X, size_t ldx, int mclamp, int kts,
                 int nkt, int m0, f32x16 (&acc)[2][2], bf16_t* lds) {
  const int tid = tidx(), lane = tid & 63, wv = tid >> 6, wn = wv & 1, wm = wv >> 1;
  const int lr = lane & 31, lh = lane >> 5;
  const int lrow = tid >> 3, lkc = (tid & 7) * 8;
  const bf16_t* wp = W + (size_t)lrow * ldw + lkc;
  const size_t wst = (size_t)64 * ldw;
  const bf16_t *xp0, *xp1, *xp2, *xp3;
  { int m;
    m = m0 + lrow;       m = m < mclamp ? m : mclamp; xp0 = X + (size_t)m * ldx + lkc;
    m = m0 + lrow + 64;  m = m < mclamp ? m : mclamp; xp1 = X + (size_t)m * ldx + lkc;
    m = m0 + lrow + 128; m = m < mclamp ? m : mclamp; xp2 = X + (size_t)m * ldx + lkc;
    m = m0 + lrow + 192; m = m < mclamp ? m : mclamp; xp3 = X + (size_t)m * ldx + lkc; }
  u32x4 rw0, rw1, rx0, rx1, rx2, rx3;
#define GM_GLOAD(KT) { \
    rw0 = *(const u32x4*)(wp + (size_t)(KT) * 64); rw1 = *(const u32x4*)(wp + wst + (size_t)(KT) * 64); \
    rx0 = *(const u32x4*)(xp0 + (size_t)(KT) * kts); rx1 = *(const u32x4*)(xp1 + (size_t)(KT) * kts); \
    rx2 = *(const u32x4*)(xp2 + (size_t)(KT) * kts); rx3 = *(const u32x4*)(xp3 + (size_t)(KT) * kts); }
#define GM_LSTORE(BUF) { bf16_t* wb_ = lds + (BUF) * MID_E + lrow * LDT + lkc; bf16_t* xb_ = wb_ + 128 * LDT; \
    *(u32x4*)(wb_) = rw0; *(u32x4*)(wb_ + 64 * LDT) = rw1; \
    *(u32x4*)(xb_) = rx0; *(u32x4*)(xb_ + 64 * LDT) = rx1; *(u32x4*)(xb_ + 128 * LDT) = rx2; *(u32x4*)(xb_ + 192 * LDT) = rx3; }
  __syncthreads();
  GM_GLOAD(0)
  GM_LSTORE(0)
  __syncthreads();
  for (int kt = 0; kt < nkt; ++kt) {
    const bool more = kt + 1 < nkt;
    if (more) GM_GLOAD(kt + 1)
    __builtin_amdgcn_sched_barrier(0);
    {
      const bf16_t* wb = lds + (kt & 1) * MID_E + (wn * 64 + lr) * LDT + lh * 8;
      const bf16_t* xb = lds + (kt & 1) * MID_E + 128 * LDT + (wm * 64 + lr) * LDT + lh * 8;
#pragma unroll
      for (int ks = 0; ks < 4; ++ks) {
        const bf16x8 a0 = *(const bf16x8*)(wb + ks * 16), a1 = *(const bf16x8*)(wb + 32 * LDT + ks * 16);
        const bf16x8 b0 = *(const bf16x8*)(xb + ks * 16), b1 = *(const bf16x8*)(xb + 32 * LDT + ks * 16);
        acc[0][0] = MFMA32(a0, b0, acc[0][0]); acc[0][1] = MFMA32(a0, b1, acc[0][1]);
        acc[1][0] = MFMA32(a1, b0, acc[1][0]); acc[1][1] = MFMA32(a1, b1, acc[1][1]);
      }
    }
    __builtin_amdgcn_sched_barrier(0);
    if (more) GM_LSTORE((kt + 1) & 1)
    __syncthreads();
  }
#undef GM_GLOAD
#undef GM_LSTORE
}

DI void zero_acc(f32x16 (&acc)[2][2]) {
#pragma unroll
  for (int a = 0; a < 2; ++a)
#pragma unroll
    for (int b = 0; b < 2; ++b)
#pragma unroll
      for (int i = 0; i < 16; ++i) acc[a][b][i] = 0.f;
}
DI void zero_acc8(f32x16 (&acc)[4][2]) {
#pragma unroll
  for (int a = 0; a < 4; ++a)
#pragma unroll
    for (int b = 0; b < 2; ++b)
#pragma unroll
      for (int i = 0; i < 16; ++i) acc[a][b][i] = 0.f;
}

DI const float* tile_rstd(const float* __restrict__ part, int m0, bf16_t* sm) {
  float* rs = (float*)((unsigned char*)sm + 139264);
  const int tid = tidx();
  if (tid < 256) {
    const float4* p4 = (const float4*)(part + (size_t)(m0 + tid) * 16);
    float s = 0.f;
#pragma unroll
    for (int i = 0; i < 4; ++i) { float4 v = p4[i]; s += v.x + v.y + v.z + v.w; }
    rs[tid] = rsqrtf(s * (1.f / 1024.f) + 1e-6f);
  }
  __syncthreads();
  return rs;
}
DI float row_rstd(const float* __restrict__ part, int m) {
  const float4* p4 = (const float4*)(part + (size_t)m * 16);
  float s = 0.f;
#pragma unroll
  for (int i = 0; i < 4; ++i) { float4 v = p4[i]; s += v.x + v.y + v.z + v.w; }
  return rsqrtf(s * (1.f / 1024.f) + 1e-6f);
}

struct Geo { int xcd, loc, nloc; };
struct TileWalk {
  int xcd, loc, nloc, ng, NT, g, i;
  DI TileWalk(int NT_, const Geo& ge) : xcd(ge.xcd), loc(ge.loc), nloc(ge.nloc), ng((NT_ + 7) >> 3), NT(NT_), g(0), i(ge.loc) {}
  DI bool next(int& mt, int& nt) {
    for (;;) {
      if (g >= ng) return false;
      if (i >= 64) { i = loc; ++g; continue; }
      mt = xcd * 8 + (i & 7); nt = g * 8 + (i >> 3);
      i += nloc;
      if (nt < NT) return true;
    }
  }
};

DI int next_task(unsigned* ctr, bf16_t* sm) {
  volatile int* slot = (volatile int*)((unsigned char*)sm + LDS_BYTES - 16);
  __syncthreads();
  if (threadIdx.x == 0) *slot = (int)__hip_atomic_fetch_add(ctr, 1u, __ATOMIC_RELAXED, __HIP_MEMORY_SCOPE_AGENT);
  __syncthreads();
  return __builtin_amdgcn_readfirstlane(*slot);
}

DI void tr_tile(const float* __restrict__ src, int ldS, int C, int r0, int c0, bf16_t* __restrict__ dst, int ldd,
                const float* __restrict__ g, int remap, float* tl) {
  const int tid = tidx() & 255;
  __syncthreads();
  {
    const int c4 = (tid & 15) * 4;
#pragma unroll
    for (int i = 0; i < 4; ++i) {
      const int r = (tid >> 4) + 16 * i;
      float4 v = make_float4(0.f, 0.f, 0.f, 0.f);
      if (c0 + c4 < C) {
        v = *(const float4*)(src + (size_t)(r0 + r) * ldS + c0 + c4);
        if (g) { const float gg = g[r0 + r]; v.x *= gg; v.y *= gg; v.z *= gg; v.w *= gg; }
      }
      float* t4 = tl + r * 65 + c4;
      t4[0] = v.x; t4[1] = v.y; t4[2] = v.z; t4[3] = v.w;
    }
  }
  __syncthreads();
  {
    const int c = tid >> 2, rq = (tid & 3) * 16;
    if (c0 + c < C) {
      int dr = c0 + c;
      if (remap) { if (dr >= 3608) dr -= 24; else if (dr >= 3584) dr += 6656 - 3584; }
      unsigned w[8];
#pragma unroll
      for (int k = 0; k < 8; ++k) w[k] = pack2(tl[(rq + 2 * k) * 65 + c], tl[(rq + 2 * k + 1) * 65 + c]);
      uint4* d4 = (uint4*)(dst + (size_t)dr * ldd + r0 + rq);
      d4[0] = make_uint4(w[0], w[1], w[2], w[3]);
      d4[1] = make_uint4(w[4], w[5], w[6], w[7]);
    }
  }
}

DI void tr_tile_wave(const float* __restrict__ src, int ldS, int C, int r0, int c0, bf16_t* __restrict__ dst, int ldd,
                     const float* __restrict__ g, int remap, float* tl) {
  const int lane = tidx() & 63;
  {
    const int c4 = (lane & 15) * 4;
    float4 v[16];
#pragma unroll
    for (int i = 0; i < 16; ++i) {
      const int r = (lane >> 4) + 4 * i;
      v[i] = make_float4(0.f, 0.f, 0.f, 0.f);
      if (c0 + c4 < C) v[i] = *(const float4*)(src + (size_t)(r0 + r) * ldS + c0 + c4);
    }
#pragma unroll
    for (int i = 0; i < 16; ++i) {
      const int r = (lane >> 4) + 4 * i;
      const float gg = g ? g[r0 + r] : 1.f;
      float* t4 = tl + r * 65 + c4;
      t4[0] = v[i].x * gg; t4[1] = v[i].y * gg; t4[2] = v[i].z * gg; t4[3] = v[i].w * gg;
    }
  }
  __builtin_amdgcn_fence(__ATOMIC_RELEASE, "wavefront");
  __builtin_amdgcn_wave_barrier();
#pragma unroll
  for (int j = 0; j < 4; ++j) {
    const int c = (lane >> 2) + 16 * j, rq = (lane & 3) * 16;
    if (c0 + c < C) {
      int dr = c0 + c;
      if (remap) { if (dr >= 3608) dr -= 24; else if (dr >= 3584) dr += 6656 - 3584; }
      unsigned w[8];
#pragma unroll
      for (int k = 0; k < 8; ++k) w[k] = pack2(tl[(rq + 2 * k) * 65 + c], tl[(rq + 2 * k + 1) * 65 + c]);
      uint4* d4 = (uint4*)(dst + (size_t)dr * ldd + r0 + rq);
      d4[0] = make_uint4(w[0], w[1], w[2], w[3]);
      d4[1] = make_uint4(w[4], w[5], w[6], w[7]);
    }
  }
  __builtin_amdgcn_wave_barrier();
}

DI void phase0(const P& p, bf16_t* sm) {
  const int tid5 = tidx(), half = tid5 >> 8, tid = tid5 & 255, lane = tid5 & 63, wv8 = tid5 >> 6;
  float* tl = (float*)sm + half * (64 * 65);
  constexpr int NTR_L = 1680 + 384 + 256 + 1024 + 1024 + 256 + 8;
  {
    float* tlw = (float*)sm + wv8 * (64 * 65);
    for (int t = blockIdx.x * 8 + wv8; t < NTR_L * NL; t += gridDim.x * 8) {
      const int layer = t / NTR_L; int r = t % NTR_L;
      if (r < 1680) {
        tr_tile_wave(p.w_in + (size_t)layer * 1024 * NIN, NIN, NIN, (r / 105) * 64, (r % 105) * 64,
                     (bf16_t*)(p.ws + O_WIN + layer * SZ_WIN), LDK1, p.norm_mix + layer * 1024, 1, tlw);
      } else if ((r -= 1680) < 384) {
        const int n3 = r / 128; r %= 128;
        tr_tile_wave(p.w_branch + ((size_t)layer * 3 + n3) * 512 * 1024, 1024, 1024, (r / 16) * 64, (r % 16) * 64,
                     (bf16_t*)(p.ws + O_WBR + layer * SZ_WBR) + (size_t)n3 * 1024 * 512, 512, nullptr, 0, tlw);
      } else if ((r -= 384) < 256) {
        tr_tile_wave(p.w_out + (size_t)layer * 1024 * 1024, 1024, 1024, (r / 16) * 64, (r % 16) * 64,
                     (bf16_t*)(p.ws + O_WO + layer * SZ_WO), LDK1, nullptr, 0, tlw);
      } else if ((r -= 256) < 1024) {
        tr_tile_wave(p.w_up + (size_t)layer * 1024 * 4096, 4096, 4096, (r / 64) * 64, (r % 64) * 64,
                     (bf16_t*)(p.ws + O_WUP + layer * SZ_WUP), LDK1, p.norm_mlp + layer * 1024, 0, tlw);
      } else if ((r -= 1024) < 1024) {
        tr_tile_wave(p.w_down + (size_t)layer * 4096 * 1024, 1024, 1024, (r / 16) * 64, (r % 16) * 64,
                     (bf16_t*)(p.ws + O_WDN + layer * SZ_WDN), LDK4, nullptr, 0, tlw);
      } else if ((r -= 1024) < 256) {
        const int kv = r / 128; r %= 128;
        tr_tile_wave(p.cmp_w1 + ((size_t)layer * 2 + kv) * 2048 * 256, 256, 256, (r / 4) * 64, (r % 4) * 64,
                     (bf16_t*)(p.ws + O_W1 + layer * SZ_W1) + (size_t)kv * 256 * 2048, 2048, nullptr, 0, tlw);
      } else {
        r -= 256;
        const int kv = r / 4; r %= 4;
        tr_tile_wave(p.cmp_w2 + ((size_t)layer * 2 + kv) * 256 * 64, 64, 64, r * 64, 0,
                     (bf16_t*)(p.ws + O_W2 + layer * SZ_W2) + (size_t)kv * 128 * 256, 256, nullptr, 0, tlw);
      }
    }
    __syncthreads();
  }
  constexpr int J_TR = 0;
  constexpr int J_X = J_TR + T_ / 8;
  constexpr int J_POS = J_X + 32;
  constexpr int J_MISC = J_POS + 1;
  constexpr int ZW_PER = ((NINP - NIN) * LDK1 / 8 + 511) / 512;
  constexpr int J_ZW = J_MISC + NL * ZW_PER;
  constexpr int J_ZW2 = J_ZW + 32;
  for (int job = blockIdx.x; job < J_ZW2; job += gridDim.x) {
    if (job < J_TR) {
      const int t = job * 2 + half;
      const int layer = t / NTR_L; int r = t % NTR_L;
      if (r < 1680) {
        tr_tile(p.w_in + (size_t)layer * 1024 * NIN, NIN, NIN, (r / 105) * 64, (r % 105) * 64,
                (bf16_t*)(p.ws + O_WIN + layer * SZ_WIN), LDK1, p.norm_mix + layer * 1024, 1, tl);
      } else if ((r -= 1680) < 384) {
        const int n3 = r / 128; r %= 128;
        tr_tile(p.w_branch + ((size_t)layer * 3 + n3) * 512 * 1024, 1024, 1024, (r / 16) * 64, (r % 16) * 64,
                (bf16_t*)(p.ws + O_WBR + layer * SZ_WBR) + (size_t)n3 * 1024 * 512, 512, nullptr, 0, tl);
      } else if ((r -= 384) < 256) {
        tr_tile(p.w_out + (size_t)layer * 1024 * 1024, 1024, 1024, (r / 16) * 64, (r % 16) * 64,
                (bf16_t*)(p.ws + O_WO + layer * SZ_WO), LDK1, nullptr, 0, tl);
      } else if ((r -= 256) < 1024) {
        tr_tile(p.w_up + (size_t)layer * 1024 * 4096, 4096, 4096, (r / 64) * 64, (r % 64) * 64,
                (bf16_t*)(p.ws + O_WUP + layer * SZ_WUP), LDK1, p.norm_mlp + layer * 1024, 0, tl);
      } else if ((r -= 1024) < 1024) {
        tr_tile(p.w_down + (size_t)layer * 4096 * 1024, 1024, 1024, (r / 16) * 64, (r % 16) * 64,
                (bf16_t*)(p.ws + O_WDN + layer * SZ_WDN), LDK4, nullptr, 0, tl);
      } else if ((r -= 1024) < 256) {
        const int kv = r / 128; r %= 128;
        tr_tile(p.cmp_w1 + ((size_t)layer * 2 + kv) * 2048 * 256, 256, 256, (r / 4) * 64, (r % 4) * 64,
                (bf16_t*)(p.ws + O_W1 + layer * SZ_W1) + (size_t)kv * 256 * 2048, 2048, nullptr, 0, tl);
      } else {
        r -= 256;
        const int kv = r / 4; r %= 4;
        tr_tile(p.cmp_w2 + ((size_t)layer * 2 + kv) * 256 * 64, 64, 64, r * 64, 0,
                (bf16_t*)(p.ws + O_W2 + layer * SZ_W2) + (size_t)kv * 128 * 256, 256, nullptr, 0, tl);
      }
    } else if (job < J_X) {
      const int row = (job - J_TR) * 8 + wv8;
      const float4* src = (const float4*)(p.x + (size_t)row * 1024);
      bf16_t* xb = (bf16_t*)(p.ws + O_XB) + (size_t)row * LDK1;
      float ss = 0.f;
#pragma unroll
      for (int i = 0; i < 4; ++i) {
        float4 v = src[lane + 64 * i];
        ss += v.x * v.x + v.y * v.y + v.z * v.z + v.w * v.w;
        *(uint2*)(xb + (lane + 64 * i) * 4) = make_uint2(pack2(v.x, v.y), pack2(v.z, v.w));
      }
#pragma unroll
      for (int o = 32; o >= 1; o >>= 1) ss += __shfl_xor(ss, o);
      float* part = (float*)(p.ws + O_PART) + (size_t)row * 16;
      if (lane < 16) part[lane] = lane == 0 ? ss : 0.f;
    } else if (job < J_POS) {
      const int jj = (job - J_X) * 2 + half; const int lk = jj >> 3, ng = jj & 7;
      const int col = ng * 32 + (tid & 31), ksl = tid >> 5;
      const float* pos = p.cmp_pos + (size_t)lk * 2048;
      const float* w1 = p.cmp_w1 + (size_t)lk * 2048 * 256;
      float s = 0.f;
      for (int k = ksl * 256; k < ksl * 256 + 256; ++k) s += pos[k] * w1[(size_t)k * 256 + col];
      __syncthreads();
      tl[tid] = s;
      __syncthreads();
      if (tid < 32) {
        float t = 0.f;
        for (int q = 0; q < 8; ++q) t += tl[q * 32 + tid];
        ((float*)(p.ws + O_POSW1))[lk * 256 + col] = t;
      }
    } else if (job < J_MISC) {
      float* tabs = (float*)(p.ws + O_TABS);
      for (int i = tid5; i < 20 * 129; i += NTHR) {
        const int h = i / 129, d = i % 129;
        int bk;
        if (d < 16) bk = d;
        else { bk = 16 + (int)(logf((float)d / 16.f) / 2.0794415416798357f * 16.f); if (bk > 31) bk = 31; }
        tabs[h * 132 + d] = p.rel_bias[bk * 20 + h] * LOG2E;
      }
      if (wv8 == 0) {
        for (int layer = 0; layer < NL; ++layer) {
          const float* lm = p.diff_lambda + layer * 256;
          float a = lm[lane] * lm[64 + lane], b = lm[128 + lane] * lm[192 + lane];
#pragma unroll
          for (int o = 32; o >= 1; o >>= 1) { a += __shfl_xor(a, o); b += __shfl_xor(b, o); }
          const float li = 0.8f - 0.6f * expf(-0.3f * (float)layer);
          if (lane == 0) ((float*)(p.ws + O_LAM))[layer] = expf(a) - expf(b) + li;
        }
      }
    } else if (job < J_ZW) {
      const int jj = job - J_MISC; const int layer = jj / ZW_PER, q = jj % ZW_PER;
      uint4* d = (uint4*)(p.ws + O_WIN + layer * SZ_WIN + (size_t)NIN * LDK1 * 2) + q * 512 + tid5;
      if (q * 512 + tid5 < (NINP - NIN) * LDK1 / 8) *d = make_uint4(0, 0, 0, 0);
    } else {
      const int jj = job - J_ZW; const int lk = jj >> 2, q = jj & 3;
      uint4* d = (uint4*)(p.ws + O_W2 + (size_t)lk * 128 * 256 * 2 + 64 * 256 * 2) + q * 512 + tid5;
      *d = make_uint4(0, 0, 0, 0);
    }
  }
}

DI bool epi_inproj_chunk(const P& p, int layer, int ch, int m0w, f32x16 (&a0)[2], f32x16 (&a1)[2], bf16_t* stg, int cp,
                         bf16_t*& rdst, int& rldd, int& rcoff, float rs0, float rs1) {
  const int lane = tidx() & 63;
  const int lr = lane & 31, lh = lane >> 5;
  enum { NORM, RAW, TRANS, SIG, CG };
  int type = RAW, ldd = 512, coff = 0, nh = 2, dv = 64, hd = 0, doff = 0;
  bf16_t* dst = nullptr; const float* gain = nullptr; float scl = 1.f;
  const float* gains = p.qk_gain + layer * 512;
  unsigned char* ws = p.ws;
  if (ch < 8) { type = NORM; dst = (bf16_t*)(ws + O_AQ); coff = ch * 64; gain = gains; scl = QSCL; }
  else if (ch < 16) { type = NORM; dst = (bf16_t*)(ws + O_AK); coff = (ch - 8) * 64; gain = gains + 64; }
  else if (ch < 24) { type = TRANS; dst = (bf16_t*)(ws + O_AVT); nh = 4; dv = 128; hd = (ch - 16) >> 1; doff = ((ch - 16) & 1) * 64; }
  else if (ch < 32) { type = NORM; dst = (bf16_t*)(ws + O_BQ); coff = (ch - 24) * 64; gain = gains + 128; scl = QSCL; }
  else if (ch < 34) { type = NORM; dst = (bf16_t*)(ws + O_BK); ldd = 128; coff = (ch - 32) * 64; gain = gains + 192; }
  else if (ch < 36) { type = TRANS; dst = (bf16_t*)(ws + O_BVT); hd = ch - 34; }
  else if (ch < 44) { type = NORM; dst = (bf16_t*)(ws + O_CQ); coff = (ch - 36) * 64; gain = gains + 256; scl = QSCL; }
  else if (ch < 46) { type = RAW; dst = (bf16_t*)(ws + O_CK); ldd = 128; coff = (ch - 44) * 64; }
  else if (ch < 48) { type = RAW; dst = (bf16_t*)(ws + O_CV); ldd = 128; coff = (ch - 46) * 64; }
  else if (ch < 50) { type = NORM; dst = (bf16_t*)(ws + O_KS); ldd = 128; coff = (ch - 48) * 64; gain = gains + 384; }
  else if (ch < 52) { type = TRANS; dst = (bf16_t*)(ws + O_VST); hd = ch - 50; }
  else if (ch < 54) { type = NORM; dst = (bf16_t*)(ws + O_KW); ldd = 128; coff = (ch - 52) * 64; gain = gains + 448; }
  else if (ch < 56) { type = TRANS; dst = (bf16_t*)(ws + O_VWT); hd = ch - 54; }
  else if (ch < 104) { type = SIG; dst = (bf16_t*)(ws + O_MGS); ldd = 3072; coff = (ch - 56) * 64; }
  else if (ch == 104) { type = CG; }
  else return false;
  rdst = dst; rldd = ldd; rcoff = coff;
#pragma unroll
  for (int mt = 0; mt < 2; ++mt) {
    const int m = m0w + mt * 32 + lr;
    const float rs = mt ? rs1 : rs0;
    float v[2][16];
    float ss = 0.f;
#pragma unroll
    for (int i = 0; i < 16; ++i) { float t = a0[mt][i] * rs; v[0][i] = t; ss += t * t; }
#pragma unroll
    for (int i = 0; i < 16; ++i) { float t = a1[mt][i] * rs; v[1][i] = t; ss += t * t; }
    if (type == NORM) {
      ss += xor32(ss);
      const float r = rsqrtf(ss * (1.f / 64.f) + 1e-6f) * scl;
#pragma unroll
      for (int nt = 0; nt < 2; ++nt)
#pragma unroll
        for (int qd = 0; qd < 4; ++qd) {
          const int n = nt * 32 + 8 * qd + 4 * lh;
          const float4 g4 = *(const float4*)(gain + n);
          *(uint2*)(stg + (mt * 32 + lr) * 136 + cp * 64 + n) =
              make_uint2(pack2(v[nt][4 * qd] * r * g4.x, v[nt][4 * qd + 1] * r * g4.y),
                         pack2(v[nt][4 * qd + 2] * r * g4.z, v[nt][4 * qd + 3] * r * g4.w));
        }
    } else if (type == RAW || type == SIG) {
#pragma unroll
      for (int nt = 0; nt < 2; ++nt)
#pragma unroll
        for (int qd = 0; qd < 4; ++qd) {
          const int n = nt * 32 + 8 * qd + 4 * lh;
          float a = v[nt][4 * qd], b = v[nt][4 * qd + 1], c = v[nt][4 * qd + 2], d = v[nt][4 * qd + 3];
          if (type == SIG) { a = sigmoidf_(a); b = sigmoidf_(b); c = sigmoidf_(c); d = sigmoidf_(d); }
          if (type == SIG)
            *(uint2*)(dst + ((size_t)((coff + n) >> 2) * T_ + m) * 4) = make_uint2(pack2(a, b), pack2(c, d));
          else
            *(uint2*)(stg + (mt * 32 + lr) * 136 + cp * 64 + n) = make_uint2(pack2(a, b), pack2(c, d));
        }
    } else if (type == TRANS) {
      const int b = m >> 12, s = m & 4095;
      bf16_t* base = dst + ((size_t)(b * nh + hd) * dv + doff) * S_ + s;
#pragma unroll
      for (int nt = 0; nt < 2; ++nt)
#pragma unroll
        for (int i = 0; i < 16; ++i) {
          const int n = nt * 32 + 8 * (i >> 2) + 4 * lh + (i & 3);
          base[(size_t)n * S_] = f2bf(v[nt][i]);
        }
    } else {
      float* cg = (float*)(ws + O_CGS) + (size_t)m * 24;
#pragma unroll
      for (int i = 0; i < 16; ++i) {
        const int n = 8 * (i >> 2) + 4 * lh + (i & 3);
        if (n < 24) cg[n] = sigmoidf_(v[0][i]);
      }
    }
  }
  return type == NORM || type == RAW;
}

DI void stage_rows_store(const bf16_t* stg, bf16_t* dst, size_t ldd, int m0w) {
  const int lane = tidx() & 63;
#pragma unroll
  for (int it = 0; it < 16; ++it) {
    const int row = it * 4 + (lane >> 4), c16 = lane & 15;
    const u32x4 v = *(const u32x4*)(stg + row * 136 + c16 * 8);
    *(u32x4*)(dst + (size_t)(m0w + row) * ldd + c16 * 8) = v;
  }
}

DI void phase_inproj(const P& p, int layer, bf16_t* sm, const Geo& ge) {
  const bf16_t* W = (const bf16_t*)(p.ws + O_WIN + layer * SZ_WIN);
  const bf16_t* X = (const bf16_t*)(p.ws + O_XB);
  TileWalk tw(27, ge);
  int mt, nt, mt_have = -1;
  float rs0 = 0.f, rs1 = 0.f;
  while (tw.next(mt, nt)) {
    if (mt != mt_have) {
      const int lane_ = tidx() & 63, wm_ = (tidx() >> 6) >> 1;
      rs0 = row_rstd((const float*)(p.ws + O_PART), mt * 256 + wm_ * 64 + (lane_ & 31));
      rs1 = row_rstd((const float*)(p.ws + O_PART), mt * 256 + wm_ * 64 + 32 + (lane_ & 31));
      mt_have = mt;
    }
    f32x16 acc[4][2]; zero_acc8(acc);
    gemm_wide(W + (size_t)nt * 256 * LDK1, LDK1, X + (size_t)mt * 256 * LDK1, LDK1, 16, acc, sm);
    const int wv = tidx() >> 6, wn = wv & 1, wm = wv >> 1;
    bf16_t* stg = sm + wv * (64 * 136);
    bf16_t *d0 = nullptr, *d1 = nullptr; int ld0 = 0, ld1 = 0, co0 = 0, co1 = 0;
    const bool s0 = epi_inproj_chunk(p, layer, nt * 4 + wn * 2, mt * 256 + wm * 64, acc[0], acc[1], stg, 0, d0, ld0, co0, rs0, rs1);
    const bool s1 = epi_inproj_chunk(p, layer, nt * 4 + wn * 2 + 1, mt * 256 + wm * 64, acc[2], acc[3], stg, 1, d1, ld1, co1, rs0, rs1);
    if (s0 && s1) stage_rows_store(stg, d0 + co0, ld0, mt * 256 + wm * 64);
  }
}

template <int NDT, int MODE, bool ALLON>
DI void attn_tile(const bf16_t* Kl, int kst, const bf16_t* Vl, const bf16x8 (&q)[4], f32x16 (&O)[NDT], float& m, float& l,
                  int kbase, int qp, int win, float cbias, const float* tab, bool lane_on) {
  const int lane = tidx() & 63, lr = lane & 31, lh = lane >> 5;
  f32x16 s[2];
#pragma unroll
  for (int st = 0; st < 2; ++st) {
#pragma unroll
    for (int i = 0; i < 16; ++i) s[st][i] = 0.f;
  }
#pragma unroll
  for (int ks = 0; ks < 4; ++ks) {
    const bf16x8 k0 = *(const bf16x8*)(Kl + lr * kst + ks * 16 + lh * 8);
    const bf16x8 k1 = *(const bf16x8*)(Kl + (32 + lr) * kst + ks * 16 + lh * 8);
    s[0] = MFMA32(k0, q[ks], s[0]);
    s[1] = MFMA32(k1, q[ks], s[1]);
  }
  float alpha, psum = 0.f;
  if (MODE == 0) {
    float tmax = fmaxf(s[0][0], s[1][0]);
#pragma unroll
    for (int i = 1; i < 16; ++i) tmax = fmaxf(tmax, fmaxf(s[0][i], s[1][i]));
    tmax = fmaxf(tmax, xor32(tmax)) + cbias;
    if (!ALLON) tmax = lane_on ? tmax : -1e30f;
    const float mn = fmaxf(m, tmax);
    alpha = ex2(m - mn);
    m = mn;
    const float mc = (ALLON || lane_on) ? mn - cbias : 1e30f;
#pragma unroll
    for (int st = 0; st < 2; ++st)
#pragma unroll
      for (int i = 0; i < 16; ++i) { const float pe = ex2(s[st][i] - mc); psum += pe; s[st][i] = pe; }
  } else {
    float tmax = -1e30f;
#pragma unroll
    for (int st = 0; st < 2; ++st)
#pragma unroll
      for (int i = 0; i < 16; ++i) {
        const int key = kbase + st * 32 + 8 * (i >> 2) + 4 * lh + (i & 3);
        float v;
        if (MODE == 1) {
          const int dist = qp - key;
          const bool ok = (ALLON || lane_on) && dist >= 0 && dist < win;
          const int di = dist < 0 ? 0 : (dist > 128 ? 128 : dist);
          v = ok ? s[st][i] + tab[di] : -1e30f;
        } else {
          v = (16 * key + 31 <= qp) ? s[st][i] : -1e30f;
        }
        s[st][i] = v;
        tmax = fmaxf(tmax, v);
      }
    tmax = fmaxf(tmax, xor32(tmax));
    const float mn = fmaxf(m, tmax);
    alpha = ex2(m - mn);
    m = mn;
#pragma unroll
    for (int st = 0; st < 2; ++st)
#pragma unroll
      for (int i = 0; i < 16; ++i) {
        const float pe = s[st][i] > -5e29f ? ex2(s[st][i] - mn) : 0.f;
        psum += pe;
        s[st][i] = pe;
      }
  }
  l = l * alpha + psum;
  if (__ballot(alpha != 1.f)) {
#pragma unroll
    for (int dt = 0; dt < NDT; ++dt)
#pragma unroll
      for (int i = 0; i < 16; ++i) O[dt][i] *= alpha;
  }
#pragma unroll
  for (int st = 0; st < 2; ++st)
#pragma unroll
    for (int sk = 0; sk < 2; ++sk) {
      u32x4 pu;
      pu[0] = pack2(s[st][8 * sk + 0], s[st][8 * sk + 1]);
      pu[1] = pack2(s[st][8 * sk + 2], s[st][8 * sk + 3]);
      pu[2] = pack2(s[st][8 * sk + 4], s[st][8 * sk + 5]);
      pu[3] = pack2(s[st][8 * sk + 6], s[st][8 * sk + 7]);
      const bf16x8 pf = __builtin_bit_cast(bf16x8, pu);
#pragma unroll
      for (int dt = 0; dt < NDT; ++dt) {
        const bf16_t* vp = Vl + (dt * 32 + lr) * 72 + st * 32 + sk * 16 + 4 * lh;
        const uint2 v0 = *(const uint2*)(vp);
        const uint2 v1 = *(const uint2*)(vp + 8);
        u32x4 vu; vu[0] = v0.x; vu[1] = v0.y; vu[2] = v1.x; vu[3] = v1.y;
        O[dt] = MFMA32(__builtin_bit_cast(bf16x8, vu), pf, O[dt]);
      }
    }
}

DI float gelu_tanh(float x) {
  const float u = 0.7978845608028654f * (x + 0.044715f * x * x * x);
  const float e = __expf(2.f * u);
  const float th = 1.f - 2.f * __builtin_amdgcn_rcpf(e + 1.f);
  return 0.5f * x * (1.f + th);
}

DI void task_compress(const P& p, int layer, int task, bf16_t* sm) {
  const int tid = tidx(), lane = tid & 63, wv = tid >> 6, wn = wv & 1, wm = wv >> 1;
  const int lr = lane & 31, lh = lane >> 5;
  const int b = task & 3, g = (task >> 2) & 1, kv = task >> 3;
  const bf16_t* src = (const bf16_t*)(p.ws + (kv ? O_CV : O_CK)) + (size_t)b * S_ * 128 + g * 64;
  const bf16_t* W1 = (const bf16_t*)(p.ws + O_W1 + layer * SZ_W1) + (size_t)kv * 256 * 2048;
  const bf16_t* W2 = (const bf16_t*)(p.ws + O_W2 + layer * SZ_W2) + (size_t)kv * 128 * 256;
  bf16_t* hid = (bf16_t*)(p.ws + O_HID) + (size_t)((kv * 2 + g) * 4 + b) * 65536;
  const float* pw = (const float*)(p.ws + O_POSW1) + (layer * 2 + kv) * 256;
  for (int nt2 = 0; nt2 < 2; ++nt2) {
    f32x16 acc[2][2]; zero_acc(acc);
    gemm_mid(W1 + (size_t)nt2 * 128 * 2048, 2048, src, 16 * 128, 254, 128, 32, 0, acc, sm);
#pragma unroll
    for (int mt = 0; mt < 2; ++mt) {
      const int m = wm * 64 + mt * 32 + lr;
#pragma unroll
      for (int nt = 0; nt < 2; ++nt)
#pragma unroll
        for (int qd = 0; qd < 4; ++qd) {
          const int n = nt2 * 128 + wn * 64 + nt * 32 + 8 * qd + 4 * lh;
          const float4 pw4 = *(const float4*)(pw + n);
          *(uint2*)(hid + (size_t)m * 256 + n) =
              make_uint2(pack2(gelu_tanh(acc[nt][mt][4 * qd] + pw4.x), gelu_tanh(acc[nt][mt][4 * qd + 1] + pw4.y)),
                         pack2(gelu_tanh(acc[nt][mt][4 * qd + 2] + pw4.z), gelu_tanh(acc[nt][mt][4 * qd + 3] + pw4.w)));
        }
    }
  }
  __threadfence();
  __syncthreads();
  {
    f32x16 acc[2][2]; zero_acc(acc);
    gemm_mid(W2, 256, hid, 256, 1 << 30, 64, 4, 0, acc, sm);
    if (wn == 0) {
      const float* gain = p.qk_gain + layer * 512 + 320;
#pragma unroll
      for (int mt = 0; mt < 2; ++mt) {
        const int m = wm * 64 + mt * 32 + lr;
        if (kv == 0) {
          float ss = 0.f;
#pragma unroll
          for (int nt = 0; nt < 2; ++nt)
#pragma unroll
            for (int i = 0; i < 16; ++i) ss += acc[nt][mt][i] * acc[nt][mt][i];
          ss += xor32(ss);
          const float r = rsqrtf(ss * (1.f / 64.f) + 1e-6f);
          bf16_t* kc = (bf16_t*)(p.ws + O_KC) + ((size_t)(b * 2 + g) * 256 + m) * 64;
#pragma unroll
          for (int nt = 0; nt < 2; ++nt)
#pragma unroll
            for (int qd = 0; qd < 4; ++qd) {
              const int n = nt * 32 + 8 * qd + 4 * lh;
              const float4 g4 = *(const float4*)(gain + n);
              *(uint2*)(kc + n) = make_uint2(pack2(acc[nt][mt][4 * qd] * r * g4.x, acc[nt][mt][4 * qd + 1] * r * g4.y),
                                             pack2(acc[nt][mt][4 * qd + 2] * r * g4.z, acc[nt][mt][4 * qd + 3] * r * g4.w));
            }
        } else {
          bf16_t* vc = (bf16_t*)(p.ws + O_VCT) + (size_t)(b * 2 + g) * 64 * 256 + m;
#pragma unroll
          for (int nt = 0; nt < 2; ++nt)
#pragma unroll
            for (int i = 0; i < 16; ++i) {
              const int n = nt * 32 + 8 * (i >> 2) + 4 * lh + (i & 3);
              vc[(size_t)n * 256] = f2bf(acc[nt][mt][i]);
            }
        }
      }
    }
  }
}

DI void task_attnA(const P& p, int layer, int task, bf16_t* sm, int dm) {
  const int tid = tidx(), lane = tid & 63, wv = tid >> 6, c = wv & 1, qs = wv >> 1;
  const int lr = lane & 31, lh = lane >> 5;
  const int qb = 31 - (task >> 4), bh = task & 15, b = bh >> 2, h = bh & 3;
  float* tab = (float*)((unsigned char*)sm + 71680);
  bf16x8* qlds = (bf16x8*)((unsigned char*)sm + 72704) + wv * 256 + lane;
  float* xbuf = (float*)((unsigned char*)sm);
  __syncthreads();
  if (tid < 129) tab[tid] = ((const float*)(p.ws + O_TABS))[h * 132 + tid];
  const int q0 = qb * 128, qmin = q0 + qs * 32, qp = qmin + lr;
  bf16_t* aq = (bf16_t*)(p.ws + O_AQ);
  {
    const bf16_t* qptr = aq + (size_t)(b * S_ + qp) * 512 + h * 128 + c * 64 + lh * 8;
#pragma unroll
    for (int ks = 0; ks < 4; ++ks) qlds[ks * 64] = *(const bf16x8*)(qptr + ks * 16);
  }
  f32x16 O[4];
#pragma unroll
  for (int dt = 0; dt < 4; ++dt)
#pragma unroll
    for (int i = 0; i < 16; ++i) O[dt][i] = 0.f;
  float m = -1e30f, l = 0.f;
  const bf16_t* kg = (const bf16_t*)(p.ws + O_AK) + (size_t)b * S_ * 512 + h * 128;
  const bf16_t* vg = (const bf16_t*)(p.ws + O_AVT) + (size_t)((b * 4 + h) * 128) * S_;
  u32x4 rk0, rk1, rv0, rv1;
#define A_GLOAD(i, KT) { const int chk = tid + 512 * i; \
    rk##i = *(const u32x4*)(kg + (size_t)((KT) * 64 + (chk >> 4)) * 512 + (chk & 15) * 8); \
    rv##i = *(const u32x4*)(vg + (size_t)(chk >> 3) * S_ + (KT) * 64 + (chk & 7) * 8); }
#define A_LSTORE(i) { const int chk = tid + 512 * i; \
    *(u32x4*)(Kl + (chk >> 4) * 136 + (chk & 15) * 8) = rk##i; \
    *(u32x4*)(Kl + 64 * 136 + (chk >> 3) * 72 + (chk & 7) * 8) = rv##i; }
  const int kt_hi = 2 * qb + 1;
  A_GLOAD(0, 0) A_GLOAD(1, 0)
  for (int kt = 0; kt <= kt_hi; ++kt) {
    bf16_t* Kl = sm + (kt & 1) * 17920; const bf16_t* Vl = Kl + 64 * 136;
    A_LSTORE(0) A_LSTORE(1)
    if (kt < kt_hi) { A_GLOAD(0, kt + 1) A_GLOAD(1, kt + 1) }
    __syncthreads();
    if (kt * 64 <= qmin + 31) {
      bf16x8 q[4];
#pragma unroll
      for (int ks = 0; ks < 4; ++ks) q[ks] = qlds[ks * 64];
      if (kt * 64 + 63 + 128 <= qmin)
        attn_tile<4, 0, true>(Kl + c * 64, 136, Vl, q, O, m, l, kt * 64, qp, 0, tab[128], tab, true);
      else
        attn_tile<4, 1, true>(Kl + c * 64, 136, Vl, q, O, m, l, kt * 64, qp, 1 << 30, 0.f, tab, true);
    }
  }
#undef A_GLOAD
#undef A_LSTORE
  const float lt = l + xor32(l);
  const float inv = 1.f / lt;
  __syncthreads();
  if (c == 1) {
#pragma unroll
    for (int dt = 0; dt < 4; ++dt)
#pragma unroll
      for (int i = 0; i < 16; ++i) {
        const int d = dt * 32 + 8 * (i >> 2) + 4 * lh + (i & 3);
        xbuf[(qs * 128 + d) * 32 + lr] = O[dt][i] * inv;
      }
  }
  __syncthreads();
  if (c == 0) {
    const float lam = ((const float*)(p.ws + O_LAM))[layer];
    const float li = 0.8f - 0.6f * expf(-0.3f * (float)layer);
    float ss = 0.f;
#pragma unroll
    for (int dt = 0; dt < 4; ++dt)
#pragma unroll
      for (int i = 0; i < 16; ++i) {
        const int d = dt * 32 + 8 * (i >> 2) + 4 * lh + (i & 3);
        const float o = O[dt][i] * inv - lam * xbuf[(qs * 128 + d) * 32 + lr];
        O[dt][i] = o;
        ss += o * o;
      }
    ss += xor32(ss);
    const float r = rsqrtf(ss * (1.f / 128.f) + 1e-6f) * (1.f - li);
    const float* sub = p.diff_subln + layer * 128;
    bf16_t* dst = (dm ? (bf16_t*)(p.ws + WS_END) : aq) + (size_t)(b * S_ + qp) * 512 + h * 128;
#pragma unroll
    for (int dt = 0; dt < 4; ++dt)
#pragma unroll
      for (int qd = 0; qd < 4; ++qd) {
        const int d = dt * 32 + 8 * qd + 4 * lh;
        const float4 g4 = *(const float4*)(sub + d);
        *(uint2*)(dst + d) = make_uint2(pack2(O[dt][4 * qd] * r * g4.x, O[dt][4 * qd + 1] * r * g4.y),
                                        pack2(O[dt][4 * qd + 2] * r * g4.z, O[dt][4 * qd + 3] * r * g4.w));
      }
  }
}

struct KVRegs { u32x4 k0, v0; };
DI void kv_gload(KVRegs& r, const bf16_t* kg, size_t kld, const bf16_t* vg, size_t vld, int key0) {
  const int c0 = tidx();
  r.k0 = *(const u32x4*)(kg + (size_t)(key0 + (c0 >> 3)) * kld + (c0 & 7) * 8);
  r.v0 = *(const u32x4*)(vg + (size_t)(c0 >> 3) * vld + key0 + (c0 & 7) * 8);
}
DI void kv_lstore(const KVRegs& r, bf16_t* Kl, bf16_t* Vl) {
  const int c0 = tidx();
  *(u32x4*)(Kl + (c0 >> 3) * 72 + (c0 & 7) * 8) = r.k0;
  *(u32x4*)(Vl + (c0 >> 3) * 72 + (c0 & 7) * 8) = r.v0;
}

DI void task_attnB(const P& p, int layer, int task, bf16_t* sm, int dm) {
  const int tid = tidx(), lane = tid & 63, wv = tid >> 6, hr = wv & 3, qs = wv >> 2;
  const int lr = lane & 31, lh = lane >> 5;
  const int qb = 63 - (task >> 3), bg = task & 7, b = bg >> 1, g = bg & 1, head = g * 4 + hr;
  float* tabs = (float*)((unsigned char*)sm + 36864);
  __syncthreads();
  for (int i = tid; i < 4 * 129; i += NTHR) {
    const int r = i / 129, d = i % 129;
    tabs[r * 132 + d] = ((const float*)(p.ws + O_TABS))[(4 + g * 4 + r) * 132 + d];
  }
  const int q0 = qb * 64, qmin = q0 + qs * 32, qp = qmin + lr;
  bf16_t* bq = (bf16_t*)(p.ws + O_BQ);
  bf16x8 q[4];
  {
    const bf16_t* qptr = bq + (size_t)(b * S_ + qp) * 512 + head * 64 + lh * 8;
#pragma unroll
    for (int ks = 0; ks < 4; ++ks) q[ks] = *(const bf16x8*)(qptr + ks * 16);
  }
  f32x16 O[2];
#pragma unroll
  for (int dt = 0; dt < 2; ++dt)
#pragma unroll
    for (int i = 0; i < 16; ++i) O[dt][i] = 0.f;
  float m = p.sinks[layer * 8 + head] * LOG2E, l = lh == 0 ? 1.f : 0.f;
  const bf16_t* kg = (const bf16_t*)(p.ws + O_BK) + (size_t)b * S_ * 128 + g * 64;
  const bf16_t* vg = (const bf16_t*)(p.ws + O_BVT) + (size_t)((b * 2 + g) * 64) * S_;
  const int kt_lo = q0 >= 127 ? (q0 - 127) >> 6 : 0, kt_hi = qb;
  KVRegs R;
  kv_gload(R, kg, 128, vg, S_, kt_lo * 64);
  for (int kt = kt_lo; kt <= kt_hi; ++kt) {
    bf16_t* Kl = sm + (kt & 1) * 9216; bf16_t* Vl = Kl + 4608;
    kv_lstore(R, Kl, Vl);
    if (kt < kt_hi) kv_gload(R, kg, 128, vg, S_, (kt + 1) * 64);
    __syncthreads();
    if (kt * 64 <= qmin + 31 && kt * 64 + 63 + 127 >= qmin)
      attn_tile<2, 1, true>(Kl, 72, Vl, q, O, m, l, kt * 64, qp, 128, 0.f, tabs + hr * 132, true);
  }
  const float lt = l + xor32(l);
  const float inv = 1.f / lt;
  bf16_t* dst = (dm ? (bf16_t*)(p.ws + WS_END) : bq) + (size_t)(b * S_ + qp) * 512 + head * 64;
#pragma unroll
  for (int dt = 0; dt < 2; ++dt)
#pragma unroll
    for (int qd = 0; qd < 4; ++qd) {
      const int d = dt * 32 + 8 * qd + 4 * lh;
      *(uint2*)(dst + d) = make_uint2(pack2(O[dt][4 * qd] * inv, O[dt][4 * qd + 1] * inv),
                                      pack2(O[dt][4 * qd + 2] * inv, O[dt][4 * qd + 3] * inv));
    }
}

DI void phase2(const P& p, int layer, bf16_t* sm, unsigned* qhead, int dm = 0) {
  for (;;) {
    const int task = next_task(qhead, sm);
    if (task >= 16 + 512 + 512) break;
    if (task < 16) task_compress(p, layer, task, sm);
    else if (task < 16 + 512) task_attnA(p, layer, task - 16, sm, dm);
    else task_attnB(p, layer, task - 528, sm, dm);
  }
}

DI void task_nsa(const P& p, int layer, int task, bf16_t* sm, int dm) {
  const int tid = tidx(), lane = tid & 63, wv = tid >> 6, hr = wv & 3, qs = wv >> 2;
  const int lr = lane & 31, lh = lane >> 5;
  const int qb = 63 - (task >> 3), bg = task & 7, b = bg >> 1, g = bg & 1, head = g * 4 + hr;
  float* tabs = (float*)((unsigned char*)sm + 36864);
  float* cbuf = (float*)((unsigned char*)sm + 39168);
  unsigned long long* masks = (unsigned long long*)((unsigned char*)sm + 55808);
  float* outl = (float*)((unsigned char*)sm + 56320) + wv * 2048 + lane;
  int itc = 0;
  __syncthreads();
  for (int i = tid; i < 4 * 129; i += NTHR) {
    const int r = i / 129, d = i % 129;
    tabs[r * 132 + d] = ((const float*)(p.ws + O_TABS))[(12 + g * 4 + r) * 132 + d];
  }
  for (int i = tid; i < 64 * 65; i += NTHR) cbuf[i] = 0.f;
  const float* tab = tabs + hr * 132;
  const int q0 = qb * 64, qmin = q0 + qs * 32, ql = qs * 32 + lr, qp = q0 + ql;
  bf16_t* cq = (bf16_t*)(p.ws + O_CQ);
  bf16x8 q[4];
  {
    const bf16_t* qptr = cq + (size_t)(b * S_ + qp) * 512 + head * 64 + lh * 8;
#pragma unroll
    for (int ks = 0; ks < 4; ++ks) q[ks] = *(const bf16x8*)(qptr + ks * 16);
  }
  const float* cg = (const float*)(p.ws + O_CGS) + (size_t)(b * S_ + qp) * 24 + head * 3;
  const float g0 = cg[0], g1 = cg[1], g2 = cg[2];
  f32x16 O[2];
  KVRegs R;
  {
    int nct = (((q0 + 32) >> 4) + 1 + 63) >> 6; if (nct > 4) nct = 4;
    const bf16_t* kg = (const bf16_t*)(p.ws + O_KC) + (size_t)(b * 2 + g) * 256 * 64;
    const bf16_t* vg = (const bf16_t*)(p.ws + O_VCT) + (size_t)(b * 2 + g) * 64 * 256;
#pragma unroll
    for (int dt = 0; dt < 2; ++dt)
#pragma unroll
      for (int i = 0; i < 16; ++i) O[dt][i] = 0.f;
    float m = -1e30f, l = 0.f;
    kv_gload(R, kg, 64, vg, 256, 0);
    for (int ct = 0; ct < nct; ++ct, ++itc) {
      bf16_t* Kl = sm + (itc & 1) * 9216; bf16_t* Vl = Kl + 4608;
      kv_lstore(R, Kl, Vl);
      if (ct + 1 < nct) kv_gload(R, kg, 64, vg, 256, (ct + 1) * 64);
      __syncthreads();
      attn_tile<2, 2, true>(Kl, 72, Vl, q, O, m, l, ct * 64, qp, 0, 0.f, tab, true);
    }
    const float lt = l + xor32(l);
    const float inv = lt > 0.f ? 1.f / lt : 0.f;
    {
      const float sc = g0 * inv;
#pragma unroll
      for (int dt = 0; dt < 2; ++dt)
#pragma unroll
        for (int i = 0; i < 16; ++i) outl[(dt * 16 + i) * 64] = sc * O[dt][i];
    }
    float carry = 0.f;
    kv_gload(R, kg, 64, vg, 256, 0);
    for (int ct = 0; ct < nct; ++ct, ++itc) {
      bf16_t* Kl = sm + (itc & 1) * 9216; bf16_t* Vl = Kl + 4608;
      kv_lstore(R, Kl, Vl);
      if (ct + 1 < nct) kv_gload(R, kg, 64, vg, 256, (ct + 1) * 64);
      __syncthreads();
      float val[2][4];
#pragma unroll
      for (int st = 0; st < 2; ++st) {
        f32x16 s;
#pragma unroll
        for (int i = 0; i < 16; ++i) s[i] = 0.f;
#pragma unroll
        for (int ks = 0; ks < 4; ++ks) {
          bf16x8 kf = *(const bf16x8*)(Kl + (st * 32 + lr) * 72 + ks * 16 + lh * 8);
          s = MFMA32(kf, q[ks], s);
        }
        float pq[4], pl[4], other[4];
#pragma unroll
        for (int g4 = 0; g4 < 4; ++g4) {
          float sum = 0.f, last = 0.f;
#pragma unroll
          for (int e = 0; e < 4; ++e) {
            const int cc = ct * 64 + st * 32 + 8 * g4 + 4 * lh + e;
            const float pe = (16 * cc + 31 <= qp) ? ex2(s[4 * g4 + e] - m) * inv : 0.f;
            sum += pe; last = pe;
          }
          pq[g4] = sum; pl[g4] = last;
        }
#pragma unroll
        for (int g4 = 0; g4 < 4; ++g4) other[g4] = xor32(pl[g4]);
        val[st][0] = pq[0] + (lh ? other[0] : carry);
        val[st][1] = pq[1] + (lh ? other[1] : other[0]);
        val[st][2] = pq[2] + (lh ? other[2] : other[1]);
        val[st][3] = pq[3] + (lh ? other[3] : other[2]);
        carry = other[3];
      }
      for (int w = 0; w < 4; ++w) {
        if (hr == w) {
#pragma unroll
          for (int st = 0; st < 2; ++st)
#pragma unroll
            for (int g4 = 0; g4 < 4; ++g4) cbuf[(ct * 16 + st * 8 + 2 * g4 + lh) * 65 + ql] += val[st][g4];
        }
        __syncthreads();
      }
    }
  }
  __syncthreads();
  for (int qi = 0; qi < 8; ++qi) {
    const int qq = wv * 8 + qi, qpos = q0 + qq, j = lane, cur = qpos >> 6;
    const float imp = cbuf[j * 65 + qq];
    const bool valid = j <= cur;
    const bool forced = (j == 0) || (j == cur) || (j == cur - 1);
    const float score = valid ? imp + (forced ? 1e4f : 0.f) : -1e30f;
    int rank = 0;
#pragma unroll 4
    for (int jp = 0; jp < 64; ++jp) {
      const float sj = __int_as_float(__builtin_amdgcn_readlane(__float_as_int(score), jp));
      rank += ((sj > score) || (sj == score && jp < j)) ? 1 : 0;
    }
    const unsigned long long mk = __ballot(rank < 16);
    if (lane == 0) masks[qq] = mk;
  }
  __syncthreads();
  const unsigned long long mymask = masks[ql];
  unsigned long long un = 0ull;
  for (int i = 0; i < 64; ++i) un |= masks[i];
  {
    const int cmax = qb;
    unsigned long long todo = un & (cmax == 63 ? ~0ull : ((1ull << (cmax + 1)) - 1ull));
    const bf16_t* kg = (const bf16_t*)(p.ws + O_KS) + (size_t)b * S_ * 128 + g * 64;
    const bf16_t* vg = (const bf16_t*)(p.ws + O_VST) + (size_t)((b * 2 + g) * 64) * S_;
#pragma unroll
    for (int dt = 0; dt < 2; ++dt)
#pragma unroll
      for (int i = 0; i < 16; ++i) O[dt][i] = 0.f;
    float m = -1e30f, l = 0.f;
    kv_gload(R, kg, 128, vg, S_, (__ffsll((long long)todo) - 1) * 64);
    for (; todo; ++itc) {
      const int j = __ffsll((long long)todo) - 1;
      todo &= todo - 1ull;
      bf16_t* Kl = sm + (itc & 1) * 9216; bf16_t* Vl = Kl + 4608;
      kv_lstore(R, Kl, Vl);
      if (todo) kv_gload(R, kg, 128, vg, S_, (__ffsll((long long)todo) - 1) * 64);
      __syncthreads();
      const bool on = (mymask >> j) & 1ull;
      if (j * 64 <= qmin + 31 && __ballot(on)) {
        if (j * 64 + 63 + 128 <= qmin)
          attn_tile<2, 0, false>(Kl, 72, Vl, q, O, m, l, j * 64, qp, 0, tab[128], tab, on);
        else
          attn_tile<2, 1, false>(Kl, 72, Vl, q, O, m, l, j * 64, qp, 1 << 30, 0.f, tab, on);
      }
    }
    const float lt = l + xor32(l);
    const float inv = lt > 0.f ? 1.f / lt : 0.f;
    {
      const float sc = g1 * inv;
#pragma unroll
      for (int dt = 0; dt < 2; ++dt)
#pragma unroll
        for (int i = 0; i < 16; ++i) outl[(dt * 16 + i) * 64] += sc * O[dt][i];
    }
  }
  {
    const bf16_t* kg = (const bf16_t*)(p.ws + O_KW) + (size_t)b * S_ * 128 + g * 64;
    const bf16_t* vg = (const bf16_t*)(p.ws + O_VWT) + (size_t)((b * 2 + g) * 64) * S_;
#pragma unroll
    for (int dt = 0; dt < 2; ++dt)
#pragma unroll
      for (int i = 0; i < 16; ++i) O[dt][i] = 0.f;
    float m = -1e30f, l = 0.f;
    const int kt_lo = q0 >= 511 ? (q0 - 511) >> 6 : 0, kt_hi = qb;
    kv_gload(R, kg, 128, vg, S_, kt_lo * 64);
    for (int kt = kt_lo; kt <= kt_hi; ++kt, ++itc) {
      bf16_t* Kl = sm + (itc & 1) * 9216; bf16_t* Vl = Kl + 4608;
      kv_lstore(R, Kl, Vl);
      if (kt < kt_hi) kv_gload(R, kg, 128, vg, S_, (kt + 1) * 64);
      __syncthreads();
      if (kt * 64 <= qmin + 31 && kt * 64 + 63 + 511 >= qmin) {
        if (kt * 64 + 63 + 128 <= qmin && qmin + 31 - kt * 64 < 512)
          attn_tile<2, 0, true>(Kl, 72, Vl, q, O, m, l, kt * 64, qp, 0, tab[128], tab, true);
        else
          attn_tile<2, 1, true>(Kl, 72, Vl, q, O, m, l, kt * 64, qp, 512, 0.f, tab, true);
      }
    }
    const float lt = l + xor32(l);
    const float inv = 1.f / lt;
    {
      const float sc = g2 * inv;
#pragma unroll
      for (int dt = 0; dt < 2; ++dt)
#pragma unroll
        for (int i = 0; i < 16; ++i) O[dt][i] = outl[(dt * 16 + i) * 64] + sc * O[dt][i];
    }
  }
  bf16_t* dst = (dm ? (bf16_t*)(p.ws + WS_END) : cq) + (size_t)(b * S_ + qp) * 512 + head * 64;
#pragma unroll
  for (int dt = 0; dt < 2; ++dt)
#pragma unroll
    for (int qd = 0; qd < 4; ++qd) {
      const int d = dt * 32 + 8 * qd + 4 * lh;
      *(uint2*)(dst + d) = make_uint2(pack2(O[dt][4 * qd], O[dt][4 * qd + 1]), pack2(O[dt][4 * qd + 2], O[dt][4 * qd + 3]));
    }
}

DI void phase3(const P& p, int layer, bf16_t* sm, unsigned* qhead, int dm = 0) {
  for (;;) {
    const int task = next_task(qhead, sm);
    if (task >= 512) break;
    task_nsa(p, layer, task, sm, dm);
  }
}

DI void phase23(const P& p, int layer, bf16_t* sm, unsigned* qhead, unsigned* cdone) {
  for (;;) {
    const int task = next_task(qhead, sm);
    if (task >= 16 + 512 + 512 + 512) break;
    if (task < 16) {
      task_compress(p, layer, task, sm);
      asm volatile("s_waitcnt vmcnt(0) lgkmcnt(0)" ::: "memory");
      __syncthreads();
      if (threadIdx.x == 0) {
        __builtin_amdgcn_fence(__ATOMIC_RELEASE, "agent");
        asm volatile("s_waitcnt vmcnt(0)" ::: "memory");
        __hip_atomic_fetch_add(cdone, 1u, __ATOMIC_RELAXED, __HIP_MEMORY_SCOPE_AGENT);
      }
    } else if (task < 16 + 512) task_attnA(p, layer, task - 16, sm, 0);
    else if (task < 1040) task_attnB(p, layer, task - 528, sm, 0);
    else {
      if (threadIdx.x == 0) {
        while (__hip_atomic_load(cdone, __ATOMIC_RELAXED, __HIP_MEMORY_SCOPE_AGENT) < 16u) __builtin_amdgcn_s_sleep(2);
        __builtin_amdgcn_fence(__ATOMIC_ACQUIRE, "agent");
        asm volatile("s_waitcnt vmcnt(0)" ::: "memory");
      }
      __syncthreads();
      task_nsa(p, layer, task - 1040, sm, 0);
    }
  }
}

DI void phase_merge(const P& p, int layer, bf16_t* sm, const Geo& ge) {
  const int tid = tidx(), lane = tid & 63, wv = tid >> 6, wn = wv & 1, wm = wv >> 1;
  const int lr = lane & 31, lh = lane >> 5;
  const bf16_t* W = (const bf16_t*)(p.ws + O_WBR + layer * SZ_WBR);
  const bf16_t* mgs = (const bf16_t*)(p.ws + O_MGS);
  bf16_t* z = (bf16_t*)(p.ws + O_Z);
  TileWalk tw(8, ge);
  int mt_, nt_;
  while (tw.next(mt_, nt_)) {
    unsigned zp[2][2][8];
#pragma unroll
    for (int a_ = 0; a_ < 2; ++a_)
#pragma unroll
      for (int b_ = 0; b_ < 2; ++b_)
#pragma unroll
        for (int i = 0; i < 8; ++i) zp[a_][b_][i] = 0u;
    for (int n3 = 0; n3 < 3; ++n3) {
      const bf16_t* X = (const bf16_t*)(p.ws + (n3 == 0 ? O_AQ : (n3 == 1 ? O_BQ : O_CQ)));
      f32x16 acc[2][2]; zero_acc(acc);
      gemm_mid(W + ((size_t)n3 * 1024 + nt_ * 128) * 512, 512, X, 512, 1 << 30, 64, 8, mt_ * 256, acc, sm);
#pragma unroll
      for (int mt = 0; mt < 2; ++mt) {
        const int m = mt_ * 256 + wm * 64 + mt * 32 + lr;
#pragma unroll
        for (int nt = 0; nt < 2; ++nt)
#pragma unroll
          for (int qd = 0; qd < 4; ++qd) {
            const int n = nt_ * 128 + wn * 64 + nt * 32 + 8 * qd + 4 * lh;
            const uint2 gq = *(const uint2*)(mgs + ((size_t)((n3 * 1024 + n) >> 2) * T_ + m) * 4);
            const unsigned z01 = zp[nt][mt][2 * qd], z23 = zp[nt][mt][2 * qd + 1];
            const float v0 = bf2f((bf16_t)(z01 & 0xffff)) + bf2f((bf16_t)(gq.x & 0xffff)) * acc[nt][mt][4 * qd];
            const float v1 = bf2f((bf16_t)(z01 >> 16)) + bf2f((bf16_t)(gq.x >> 16)) * acc[nt][mt][4 * qd + 1];
            const float v2 = bf2f((bf16_t)(z23 & 0xffff)) + bf2f((bf16_t)(gq.y & 0xffff)) * acc[nt][mt][4 * qd + 2];
            const float v3 = bf2f((bf16_t)(z23 >> 16)) + bf2f((bf16_t)(gq.y >> 16)) * acc[nt][mt][4 * qd + 3];
            zp[nt][mt][2 * qd] = pack2(v0, v1);
            zp[nt][mt][2 * qd + 1] = pack2(v2, v3);
          }
      }
    }
    bf16_t* stg = sm + wv * (64 * 72);
#pragma unroll
    for (int mt = 0; mt < 2; ++mt)
#pragma unroll
      for (int nt = 0; nt < 2; ++nt)
#pragma unroll
        for (int qd = 0; qd < 4; ++qd)
          *(uint2*)(stg + (mt * 32 + lr) * 72 + nt * 32 + 8 * qd + 4 * lh) = make_uint2(zp[nt][mt][2 * qd], zp[nt][mt][2 * qd + 1]);
#pragma unroll
    for (int it = 0; it < 8; ++it) {
      const int row = it * 8 + (lane >> 3), c16 = lane & 7;
      const u32x4 v = *(const u32x4*)(stg + row * 72 + c16 * 8);
      *(u32x4*)(z + (size_t)(mt_ * 256 + wm * 64 + row) * LDK1 + nt_ * 128 + wn * 64 + c16 * 8) = v;
    }
  }
}

DI void phase_resid(const P& p, const bf16_t* W, const bf16_t* X, int K, bf16_t* sm, const Geo& ge, bool last) {
  const int tid = tidx(), lane = tid & 63, wv = tid >> 6, wn = wv & 1, wm = wv >> 1;
  const int lr = lane & 31, lh = lane >> 5;
  bf16_t* xb = (bf16_t*)(p.ws + O_XB);
  float* part = (float*)(p.ws + O_PART);
  TileWalk tw(4, ge);
  int mt_, nt_;
  while (tw.next(mt_, nt_)) {
    f32x16 acc[4][2]; zero_acc8(acc);
    const int ldk = K + 64;
    gemm_wide(W + (size_t)nt_ * 256 * ldk, ldk, X + (size_t)mt_ * 256 * ldk, ldk, K / 64, acc, sm);
    float* stg = (float*)sm + wv * (64 * 68);
    const int m0w = mt_ * 256 + wm * 64, n0w = nt_ * 256 + wn * 128;
#pragma unroll
    for (int cp = 0; cp < 2; ++cp) {
#pragma unroll 4
      for (int it = 0; it < 8; ++it) {
        const int row = it * 8 + (lane >> 3), c8 = (lane & 7) * 8;
        const u32x4 raw = *(const u32x4*)(xb + (size_t)(m0w + row) * LDK1 + n0w + cp * 64 + c8);
        float* d = stg + row * 68 + c8;
        *(float4*)(d) = make_float4(__uint_as_float(raw[0] << 16), __uint_as_float(raw[0] & 0xffff0000u),
                                    __uint_as_float(raw[1] << 16), __uint_as_float(raw[1] & 0xffff0000u));
        *(float4*)(d + 4) = make_float4(__uint_as_float(raw[2] << 16), __uint_as_float(raw[2] & 0xffff0000u),
                                        __uint_as_float(raw[3] << 16), __uint_as_float(raw[3] & 0xffff0000u));
      }
#pragma unroll
      for (int mt = 0; mt < 2; ++mt) {
        float ss = 0.f;
#pragma unroll
        for (int nh = 0; nh < 2; ++nh)
#pragma unroll
          for (int qd = 0; qd < 4; ++qd) {
            const int nt = cp * 2 + nh;
            float4* sp = (float4*)(stg + (mt * 32 + lr) * 68 + nh * 32 + 8 * qd + 4 * lh);
            float4 v = *sp;
            v.x += acc[nt][mt][4 * qd]; v.y += acc[nt][mt][4 * qd + 1]; v.z += acc[nt][mt][4 * qd + 2]; v.w += acc[nt][mt][4 * qd + 3];
            *sp = v;
            ss += v.x * v.x + v.y * v.y + v.z * v.z + v.w * v.w;
          }
        ss += xor32(ss);
        if (lh == 0) part[(size_t)(m0w + mt * 32 + lr) * 16 + nt_ * 4 + wn * 2 + cp] = ss;
      }
#pragma unroll 4
      for (int it = 0; it < 16; ++it) {
        const int row = it * 4 + (lane >> 4), c4 = (lane & 15) * 4;
        const float4 v = *(const float4*)(stg + row * 68 + c4);
        if (last) *(float4*)(p.out + (size_t)(m0w + row) * 1024 + n0w + cp * 64 + c4) = v;
        *(uint2*)(xb + (size_t)(m0w + row) * LDK1 + n0w + cp * 64 + c4) = make_uint2(pack2(v.x, v.y), pack2(v.z, v.w));
      }
    }
  }
}

DI void phase_up(const P& p, int layer, bf16_t* sm, const Geo& ge) {
  const int tid = tidx(), lane = tid & 63, wv = tid >> 6, wn = wv & 1, wm = wv >> 1;
  const int lr = lane & 31, lh = lane >> 5;
  const bf16_t* W = (const bf16_t*)(p.ws + O_WUP + layer * SZ_WUP);
  const bf16_t* X = (const bf16_t*)(p.ws + O_XB);
  const float* part = (const float*)(p.ws + O_PART);
  bf16_t* u = (bf16_t*)(p.ws + O_U);
  TileWalk tw(16, ge);
  int mt_, nt_, mt_have = -1;
  float rs0 = 0.f, rs1 = 0.f;
  while (tw.next(mt_, nt_)) {
    if (mt_ != mt_have) {
      rs0 = row_rstd(part, mt_ * 256 + wm * 64 + lr);
      rs1 = row_rstd(part, mt_ * 256 + wm * 64 + 32 + lr);
      mt_have = mt_;
    }
    f32x16 acc[4][2]; zero_acc8(acc);
    gemm_wide(W + (size_t)nt_ * 256 * LDK1, LDK1, X + (size_t)mt_ * 256 * LDK1, LDK1, 16, acc, sm);
    bf16_t* stg = sm + wv * (64 * 136);
#pragma unroll
    for (int mt = 0; mt < 2; ++mt) {
      const float rs = mt ? rs1 : rs0;
#pragma unroll
      for (int nt = 0; nt < 4; ++nt)
#pragma unroll
        for (int qd = 0; qd < 4; ++qd) {
          const int n = nt_ * 256 + wn * 128 + nt * 32 + 8 * qd + 4 * lh;
          float a = fmaxf(acc[nt][mt][4 * qd] * rs, 0.f), b = fmaxf(acc[nt][mt][4 * qd + 1] * rs, 0.f);
          float c = fmaxf(acc[nt][mt][4 * qd + 2] * rs, 0.f), d = fmaxf(acc[nt][mt][4 * qd + 3] * rs, 0.f);
          *(uint2*)(stg + (mt * 32 + lr) * 136 + nt * 32 + 8 * qd + 4 * lh) = make_uint2(pack2(a * a, b * b), pack2(c * c, d * d));
        }
    }
    stage_rows_store(stg, u + nt_ * 256 + wn * 128, LDK4, mt_ * 256 + wm * 64);
  }
}

DI unsigned xcc_id() { return (unsigned)__builtin_amdgcn_s_getreg((3 << 11) | 20) & 0xFu; }
struct BarCtx { unsigned* base; unsigned xcc, xcnt, nxcc, gen; };
DI void gbar(BarCtx& c) {
  ++c.gen;
  asm volatile("s_waitcnt vmcnt(0) lgkmcnt(0)" ::: "memory");
  __syncthreads();
  if (threadIdx.x == 0) {
    const unsigned old = __hip_atomic_fetch_add(c.base + (16 + c.xcc) * 32, 1u, __ATOMIC_RELAXED, __HIP_MEMORY_SCOPE_AGENT);
    if (old % c.xcnt == c.xcnt - 1) {
      __builtin_amdgcn_fence(__ATOMIC_RELEASE, "agent");
      asm volatile("s_waitcnt vmcnt(0)" ::: "memory");
      const unsigned t = __hip_atomic_fetch_add(c.base + 32 * 32, 1u, __ATOMIC_RELAXED, __HIP_MEMORY_SCOPE_AGENT);
      if (t % c.nxcc == c.nxcc - 1) {
        for (unsigned i = 0; i < 16; ++i)
          __hip_atomic_store(c.base + (33 + i) * 32, c.gen, __ATOMIC_RELAXED, __HIP_MEMORY_SCOPE_AGENT);
      }
    }
    while (__hip_atomic_load(c.base + (33 + c.xcc) * 32, __ATOMIC_RELAXED, __HIP_MEMORY_SCOPE_AGENT) < c.gen) __builtin_amdgcn_s_sleep(1);
    __builtin_amdgcn_fence(__ATOMIC_ACQUIRE, "agent");
    asm volatile("s_waitcnt vmcnt(0)" ::: "memory");
  }
  __syncthreads();
}

__global__ void __launch_bounds__(512, 2) mega(P p) {
  extern __shared__ __attribute__((aligned(16))) unsigned char smraw[];
  bf16_t* sm = (bf16_t*)smraw;
  cg::grid_group grid = cg::this_grid();
  if (threadIdx.x == 0)
    ((unsigned*)smraw)[0] = __hip_atomic_fetch_add((unsigned*)(p.ws + O_BAR) + xcc_id() * 32, 1u, __ATOMIC_RELAXED, __HIP_MEMORY_SCOPE_AGENT);
  __syncthreads();
  const unsigned my_rank = (unsigned)__builtin_amdgcn_readfirstlane((int)((volatile unsigned*)smraw)[0]);
  __syncthreads();
#ifndef PHMASK
#define PHMASK 0xff
#endif
  if (PHMASK & 1) phase0(p, sm);
  grid.sync();
  BarCtx bc;
  bc.base = (unsigned*)(p.ws + O_BAR); bc.xcc = xcc_id(); bc.gen = 0;
  bc.xcnt = (unsigned)__builtin_amdgcn_readfirstlane((int)__hip_atomic_load(bc.base + bc.xcc * 32, __ATOMIC_RELAXED, __HIP_MEMORY_SCOPE_AGENT));
  bc.nxcc = 0;
  for (unsigned i = 0; i < 16; ++i) bc.nxcc += __hip_atomic_load(bc.base + i * 32, __ATOMIC_RELAXED, __HIP_MEMORY_SCOPE_AGENT) ? 1u : 0u;
  bc.nxcc = (unsigned)__builtin_amdgcn_readfirstlane((int)bc.nxcc);
  unsigned hi_cnt = 0;
  for (unsigned i = 8; i < 16; ++i) hi_cnt += __hip_atomic_load(bc.base + i * 32, __ATOMIC_RELAXED, __HIP_MEMORY_SCOPE_AGENT);
  hi_cnt = (unsigned)__builtin_amdgcn_readfirstlane((int)hi_cnt);
  Geo ge;
  if (bc.nxcc == 8 && hi_cnt == 0) { ge.xcd = (int)bc.xcc; ge.loc = (int)my_rank; ge.nloc = (int)bc.xcnt; }
  else { ge.xcd = blockIdx.x & 7; ge.loc = blockIdx.x >> 3; ge.nloc = gridDim.x >> 3; }
  unsigned* qheads = bc.base + 64 * 32;
  for (int layer = 0; layer < NL; ++layer) {
    if (PHMASK & 2) phase_inproj(p, layer, sm, ge);
    gbar(bc);
    phase23(p, layer, sm, qheads + (layer * 2) * 32, qheads + (layer * 2 + 1) * 32);
    gbar(bc);
    if (PHMASK & 16) phase_merge(p, layer, sm, ge);
    gbar(bc);
    if (PHMASK & 32) phase_resid(p, (const bf16_t*)(p.ws + O_WO + layer * SZ_WO), (const bf16_t*)(p.ws + O_Z), 1024, sm, ge, false);
    gbar(bc);
    if (PHMASK & 64) phase_up(p, layer, sm, ge);
    gbar(bc);
    if (PHMASK & 128) phase_resid(p, (const bf16_t*)(p.ws + O_WDN + layer * SZ_WDN), (const bf16_t*)(p.ws + O_U), 4096, sm, ge, layer == NL - 1);
    gbar(bc);
  }
}

extern "C" void kernel_launch(void* const* d_in, const int* in_sizes, int n_in, void* d_out, int out_size, void* d_ws,
                              size_t ws_size, hipStream_t stream) {
  static int grid_blocks = 0;
  if (!grid_blocks) {
    int dev = 0, cus = 0, per_cu = 0;
    (void)hipGetDevice(&dev);
    (void)hipDeviceGetAttribute(&cus, hipDeviceAttributeMultiprocessorCount, dev);
    (void)hipFuncSetAttribute((const void*)mega, hipFuncAttributeMaxDynamicSharedMemorySize, LDS_BYTES);
    (void)hipOccupancyMaxActiveBlocksPerMultiprocessor(&per_cu, (const void*)mega, NTHR, LDS_BYTES);
    if (per_cu < 1) per_cu = 1;
    if (per_cu > 1) per_cu = 1;
    grid_blocks = cus * per_cu;
    if (ws_size < WS_END) fprintf(stderr, "workspace too small: %zu < %zu\n", ws_size, (size_t)WS_END);
  }
  P p{};
  p.x = (const float*)d_in[0]; p.w_in = (const float*)d_in[1]; p.qk_gain = (const float*)d_in[2];
  p.diff_lambda = (const float*)d_in[3]; p.diff_subln = (const float*)d_in[4]; p.sinks = (const float*)d_in[5];
  p.cmp_pos = (const float*)d_in[6]; p.cmp_w1 = (const float*)d_in[7]; p.cmp_w2 = (const float*)d_in[8];
  p.w_branch = (const float*)d_in[9]; p.w_out = (const float*)d_in[10]; p.norm_mix = (const float*)d_in[11];
  p.norm_mlp = (const float*)d_in[12]; p.w_up = (const float*)d_in[13]; p.w_down = (const float*)d_in[14];
  p.rel_bias = (const float*)d_in[15];
  p.out = (float*)d_out; p.ws = (unsigned char*)d_ws;
  (void)hipMemsetAsync((unsigned char*)d_ws + O_BAR, 0, 80 * 128, stream);
  void* args[] = {&p};
  hipError_t e = hipLaunchCooperativeKernel((const void*)mega, dim3(grid_blocks), dim3(NTHR), args, LDS_BYTES, stream);
  if (e != hipSuccess) fprintf(stderr, "cooperative launch failed: %s (grid %d)\n", hipGetErrorString(e), grid_blocks);
}
```

```cpp
#include <hip/hip_runtime.h>
#include <hip/hip_cooperative_groups.h>
#include <cstdio>
namespace cg = cooperative_groups;

typedef unsigned short bf16_t;
using bf16x8 = __attribute__((ext_vector_type(8))) short;
using f32x16 = __attribute__((ext_vector_type(16))) float;
using u32x4 = __attribute__((ext_vector_type(4))) unsigned;
#define DI __device__ __forceinline__
#define MFMA32(a, b, c) __builtin_amdgcn_mfma_f32_32x32x16_bf16((a), (b), (c), 0, 0, 0)

constexpr int S_ = 4096, T_ = 16384, NL = 4;
constexpr int NIN = 6680, NINP = 6912;
constexpr int LDS_BYTES = 147456;
constexpr int NTHR = 512;
constexpr int LDT = 72;
constexpr int LDK1 = 1088, LDK4 = 4160;
constexpr int WT_E = 256 * LDT;

constexpr size_t SZ_WIN = (size_t)NINP * LDK1 * 2;
constexpr size_t SZ_WBR = (size_t)3 * 1024 * 512 * 2;
constexpr size_t SZ_WO = (size_t)1024 * LDK1 * 2;
constexpr size_t SZ_WUP = (size_t)4096 * LDK1 * 2;
constexpr size_t SZ_WDN = (size_t)1024 * LDK4 * 2;
constexpr size_t SZ_W1 = (size_t)2 * 256 * 2048 * 2;
constexpr size_t SZ_W2 = (size_t)2 * 128 * 256 * 2;
constexpr size_t O_WIN = 0;
constexpr size_t O_WBR = O_WIN + NL * SZ_WIN;
constexpr size_t O_WO = O_WBR + NL * SZ_WBR;
constexpr size_t O_WUP = O_WO + NL * SZ_WO;
constexpr size_t O_WDN = O_WUP + NL * SZ_WUP;
constexpr size_t O_W1 = O_WDN + NL * SZ_WDN;
constexpr size_t O_W2 = O_W1 + NL * SZ_W1;
constexpr size_t O_POSW1 = O_W2 + NL * SZ_W2;
constexpr size_t O_LAM = O_POSW1 + (size_t)NL * 2 * 256 * 4;
constexpr size_t O_TABS = O_LAM + 256;
constexpr size_t O_PART = O_TABS + 20 * 132 * 4 + 192;
constexpr size_t O_XB = ((O_PART + (size_t)T_ * 16 * 4 + 255) / 256) * 256;
constexpr size_t O_ACT = O_XB + (size_t)T_ * LDK1 * 2;
constexpr size_t O_AQ = O_ACT;
constexpr size_t O_BQ = O_AQ + (size_t)T_ * 512 * 2;
constexpr size_t O_CQ = O_BQ + (size_t)T_ * 512 * 2;
constexpr size_t O_AK = O_CQ + (size_t)T_ * 512 * 2;
constexpr size_t O_AVT = O_AK + (size_t)T_ * 512 * 2;
constexpr size_t O_Z = O_AK;
constexpr size_t O_BK = O_AVT + (size_t)T_ * 512 * 2;
constexpr size_t SZ_S = (size_t)T_ * 128 * 2;
constexpr size_t O_BVT = O_BK + SZ_S;
constexpr size_t O_CK = O_BVT + SZ_S;
constexpr size_t O_CV = O_CK + SZ_S;
constexpr size_t O_KS = O_CV + SZ_S + 65536;
constexpr size_t O_VST = O_KS + SZ_S;
constexpr size_t O_KW = O_VST + SZ_S;
constexpr size_t O_VWT = O_KW + SZ_S;
constexpr size_t O_CGS = O_VWT + SZ_S;
constexpr size_t O_MGS = O_CGS + (size_t)T_ * 24 * 4;
constexpr size_t O_HID = O_MGS + (size_t)T_ * 3072 * 2;
constexpr size_t O_KC = O_HID + (size_t)16 * 256 * 256 * 2;
constexpr size_t O_VCT = O_KC + (size_t)8 * 256 * 64 * 2;
constexpr size_t O_U = O_ACT;
constexpr size_t O_BAR = O_VCT + (size_t)8 * 256 * 64 * 2;
constexpr size_t WS_END = O_BAR + 80 * 128;
static_assert(O_Z + (size_t)T_ * LDK1 * 2 <= O_CGS && O_U + (size_t)T_ * LDK4 * 2 <= O_HID, "u must fit in the aliased region");

struct P {
  const float* x; const float* w_in; const float* qk_gain; const float* diff_lambda; const float* diff_subln;
  const float* sinks; const float* cmp_pos; const float* cmp_w1; const float* cmp_w2; const float* w_branch;
  const float* w_out; const float* norm_mix; const float* norm_mlp; const float* w_up; const float* w_down;
  const float* rel_bias;
  float* out; unsigned char* ws;
};

DI int tidx() { int t = threadIdx.x; asm volatile("" : "+v"(t)); return t; }
DI bf16_t f2bf(float x) { unsigned u = __float_as_uint(x); u += 0x7fffu + ((u >> 16) & 1u); return (bf16_t)(u >> 16); }
DI float bf2f(bf16_t b) { return __uint_as_float(((unsigned)b) << 16); }
typedef float f32x2_t __attribute__((ext_vector_type(2)));
typedef __bf16 bf16x2_t __attribute__((ext_vector_type(2)));
DI unsigned pack2(float a, float b) { f32x2_t v = {a, b}; bf16x2_t r = __builtin_convertvector(v, bf16x2_t); return __builtin_bit_cast(unsigned, r); }
constexpr float LOG2E = 1.4426950408889634f;
constexpr float QSCL = 0.125f * LOG2E;
DI float ex2(float x) { return __builtin_amdgcn_exp2f(x); }
DI float sigmoidf_(float x) { return __builtin_amdgcn_rcpf(1.f + ex2(-LOG2E * x)); }
DI float xor32(float v) { return __shfl_xor(v, 32); }

DI void gemm_wide(const bf16_t* __restrict__ W, int ldw, const bf16_t* __restrict__ X, int ldx, int nkt,
                  f32x16 (&acc)[4][2], bf16_t* lds) {
  const int tid = tidx(), lane = tid & 63, wv = tid >> 6, wn = wv & 1, wm = wv >> 1;
  const int lr = lane & 31, lh = lane >> 5;
  const int lrow = tid >> 3, lkc = (tid & 7) * 8;
  const bf16_t* wp = W + (size_t)lrow * ldw + lkc;
  const bf16_t* xp = X + (size_t)lrow * ldx + lkc;
  const size_t wst = (size_t)64 * ldw, xst = (size_t)64 * ldx;
  u32x4 rw0, rw1, rw2, rw3, rx0, rx1, rx2, rx3;
#define GW_GLOAD(KT) { const size_t ko_ = (size_t)(KT) * 64; \
    rw0 = *(const u32x4*)(wp + ko_); rw1 = *(const u32x4*)(wp + wst + ko_); \
    rw2 = *(const u32x4*)(wp + 2 * wst + ko_); rw3 = *(const u32x4*)(wp + 3 * wst + ko_); \
    rx0 = *(const u32x4*)(xp + ko_); rx1 = *(const u32x4*)(xp + xst + ko_); \
    rx2 = *(const u32x4*)(xp + 2 * xst + ko_); rx3 = *(const u32x4*)(xp + 3 * xst + ko_); }
#define GW_LSTORE(BUF) { bf16_t* wb_ = lds + (BUF) * 2 * WT_E + lrow * LDT + lkc; bf16_t* xb_ = wb_ + WT_E; \
    *(u32x4*)(wb_) = rw0; *(u32x4*)(wb_ + 64 * LDT) = rw1; *(u32x4*)(wb_ + 128 * LDT) = rw2; *(u32x4*)(wb_ + 192 * LDT) = rw3; \
    *(u32x4*)(xb_) = rx0; *(u32x4*)(xb_ + 64 * LDT) = rx1; *(u32x4*)(xb_ + 128 * LDT) = rx2; *(u32x4*)(xb_ + 192 * LDT) = rx3; }
  u32x4 sw0, sw1, sw2, sw3, sx0, sx1, sx2, sx3;
#define GW_GLOAD_B(KT) { const size_t ko_ = (size_t)(KT) * 64; \
    sw0 = *(const u32x4*)(wp + ko_); sw1 = *(const u32x4*)(wp + wst + ko_); \
    sw2 = *(const u32x4*)(wp + 2 * wst + ko_); sw3 = *(const u32x4*)(wp + 3 * wst + ko_); \
    sx0 = *(const u32x4*)(xp + ko_); sx1 = *(const u32x4*)(xp + xst + ko_); \
    sx2 = *(const u32x4*)(xp + 2 * xst + ko_); sx3 = *(const u32x4*)(xp + 3 * xst + ko_); }
#define GW_LSTORE_B(BUF) { bf16_t* wb_ = lds + (BUF) * 2 * WT_E + lrow * LDT + lkc; bf16_t* xb_ = wb_ + WT_E; \
    *(u32x4*)(wb_) = sw0; *(u32x4*)(wb_ + 64 * LDT) = sw1; *(u32x4*)(wb_ + 128 * LDT) = sw2; *(u32x4*)(wb_ + 192 * LDT) = sw3; \
    *(u32x4*)(xb_) = sx0; *(u32x4*)(xb_ + 64 * LDT) = sx1; *(u32x4*)(xb_ + 128 * LDT) = sx2; *(u32x4*)(xb_ + 192 * LDT) = sx3; }
#define GW_KS(KT, ks) { \
      const bf16_t* wb = lds + ((KT) & 1) * 2 * WT_E + (wn * 128 + lr) * LDT + lh * 8; \
      const bf16_t* xb = lds + ((KT) & 1) * 2 * WT_E + WT_E + (wm * 64 + lr) * LDT + lh * 8; \
      const bf16x8 b0 = *(const bf16x8*)(xb + (ks) * 16), b1 = *(const bf16x8*)(xb + 32 * LDT + (ks) * 16); \
      const bf16x8 a0 = *(const bf16x8*)(wb + (ks) * 16), a1 = *(const bf16x8*)(wb + 32 * LDT + (ks) * 16); \
      const bf16x8 a2 = *(const bf16x8*)(wb + 64 * LDT + (ks) * 16), a3 = *(const bf16x8*)(wb + 96 * LDT + (ks) * 16); \
      acc[0][0] = MFMA32(a0, b0, acc[0][0]); acc[0][1] = MFMA32(a0, b1, acc[0][1]); \
      acc[1][0] = MFMA32(a1, b0, acc[1][0]); acc[1][1] = MFMA32(a1, b1, acc[1][1]); \
      acc[2][0] = MFMA32(a2, b0, acc[2][0]); acc[2][1] = MFMA32(a2, b1, acc[2][1]); \
      acc[3][0] = MFMA32(a3, b0, acc[3][0]); acc[3][1] = MFMA32(a3, b1, acc[3][1]); }
#define GW_ST2(BUF, OFF, R0, R1) { bf16_t* d_ = lds + (BUF) * 2 * WT_E + (OFF) + lrow * LDT + lkc; \
      *(u32x4*)(d_) = R0; *(u32x4*)(d_ + 64 * LDT) = R1; }
  __syncthreads();
  GW_GLOAD(0)
  GW_LSTORE(0)
  GW_GLOAD(1)
  GW_GLOAD_B(nkt > 2 ? 2 : nkt - 1)
  __syncthreads();
  for (int kt = 0; kt < nkt; kt += 2) {
    __builtin_amdgcn_sched_barrier(0);
    GW_ST2(1, 0, rw0, rw1)                         GW_KS(kt, 0)
    GW_ST2(1, 128 * LDT, rw2, rw3)                 GW_KS(kt, 1)
    GW_ST2(1, WT_E, rx0, rx1)                      GW_KS(kt, 2)
    GW_ST2(1, WT_E + 128 * LDT, rx2, rx3)          GW_KS(kt, 3)
    __builtin_amdgcn_sched_barrier(0);
    GW_GLOAD(kt + 3 < nkt ? kt + 3 : nkt - 1)
    __syncthreads();
    __builtin_amdgcn_sched_barrier(0);
    GW_ST2(0, 0, sw0, sw1)                         GW_KS(kt + 1, 0)
    GW_ST2(0, 128 * LDT, sw2, sw3)                 GW_KS(kt + 1, 1)
    GW_ST2(0, WT_E, sx0, sx1)                      GW_KS(kt + 1, 2)
    GW_ST2(0, WT_E + 128 * LDT, sx2, sx3)          GW_KS(kt + 1, 3)
    __builtin_amdgcn_sched_barrier(0);
    GW_GLOAD_B(kt + 4 < nkt ? kt + 4 : nkt - 1)
    __syncthreads();
  }
#undef GW_KS
#undef GW_ST2
#undef GW_GLOAD_B
#undef GW_LSTORE_B
#undef GW_GLOAD
#undef GW_LSTORE
}

constexpr int MID_E = (128 + 256) * LDT;
DI void gemm_mid(const bf16_t* __restrict__ W, int ldw, const bf16_t* __restrict__ X, size_t ldx, int mclamp, int kts,
                 int nkt, int m0, f32x16 (&acc)[2][2], bf16_t* lds) {
  const int tid = tidx(), lane = tid & 63, wv = tid >> 6, wn = wv & 1, wm = wv >> 1;
  const int lr = lane & 31, lh = lane >> 5;
  const int lrow = tid >> 3, lkc = (tid & 7) * 8;
  const bf16_t* wp = W + (size_t)lrow * ldw + lkc;
  const size_t wst = (size_t)64 * ldw;
  const bf16_t *xp0, *xp1, *xp2, *xp3;
  { int m;
    m = m0 + lrow;       m = m < mclamp ? m : mclamp; xp0 = X + (size_t)m * ldx + lkc;
    m = m0 + lrow + 64;  m = m < mclamp ? m : mclamp; xp1 = X + (size_t)m * ldx + lkc;
    m = m0 + lrow + 128; m = m < mclamp ? m : mclamp; xp2 = X + (size_t)m * ldx + lkc;
    m = m0 + lrow + 192; m = m < mclamp ? m : mclamp; xp3 = X + (size_t)m * ldx + lkc; }
  u32x4 rw0, rw1, rx0, rx1, rx2, rx3;
#define GM_GLOAD(KT) { \
    rw0 = *(const u32x4*)(wp + (size_t)(KT) * 64); rw1 = *(const u32x4*)(wp + wst + (size_t)(KT) * 64); \
    rx0 = *(const u32x4*)(xp0 + (size_t)(KT) * kts); rx1 = *(const u32x4*)(xp1 + (size_t)(KT) * kts); \
    rx2 = *(const u32x4*)(xp2 + (size_t)(KT) * kts); rx3 = *(const u32x4*)(xp3 + (size_t)(KT) * kts); }
#define GM_LSTORE(BUF) { bf16_t* wb_ = lds + (BUF) * MID_E + lrow * LDT + lkc; bf16_t* xb_ = wb_ + 128 * LDT; \
    *(u32x4*)(wb_) = rw0; *(u32x4*)(wb_ + 64 * LDT) = rw1; \
    *(u32x4*)(xb_) = rx0; *(u32x4*)(xb_ + 64 * LDT) = rx1; *(u32x4*)(xb_ + 128 * LDT) = rx2; *(u32x4*)(xb_ + 192 * LDT) = rx3; }
  __syncthreads();
  GM_GLOAD(0)
  GM_LSTORE(0)
  __syncthreads();
  for (int kt = 0; kt < nkt; ++kt) {
    const bool more = kt + 1 < nkt;
    if (more) GM_GLOAD(kt + 1)
    __builtin_amdgcn_sched_barrier(0);
    {
      const bf16_t* wb = lds + (kt & 1) * MID_E + (wn * 64 + lr) * LDT + lh * 8;
      const bf16_t* xb = lds + (kt & 1) * MID_E + 128 * LDT + (wm * 64 + lr) * LDT + lh * 8;
#pragma unroll
      for (int ks = 0; ks < 4; ++ks) {
        const bf16x8 a0 = *(const bf16x8*)(wb + ks * 16), a1 = *(const bf16x8*)(wb + 32 * LDT + ks * 16);
        const bf16x8 b0 = *(const bf16x8*)(xb + ks * 16), b1 = *(const bf16x8*)(xb + 32 * LDT + ks * 16);
        acc[0][0] = MFMA32(a0, b0, acc[0][0]); acc[0][1] = MFMA32(a0, b1, acc[0][1]);
        acc[1][0] = MFMA32(a1, b0, acc[1][0]); acc[1][1] = MFMA32(a1, b1, acc[1][1]);
      }
    }
    __builtin_amdgcn_sched_barrier(0);
    if (more) GM_LSTORE((kt + 1) & 1)
    __syncthreads();
  }
#undef GM_GLOAD
#undef GM_LSTORE
}

DI void zero_acc(f32x16 (&acc)[2][2]) {
#pragma unroll
  for (int a = 0; a < 2; ++a)
#pragma unroll
    for (int b = 0; b < 2; ++b)
#pragma unroll
      for (int i = 0; i < 16; ++i) acc[a][b][i] = 0.f;
}
DI void zero_acc8(f32x16 (&acc)[4][2]) {
#pragma unroll
  for (int a = 0; a < 4; ++a)
#pragma unroll
    for (int b = 0; b < 2; ++b)
#pragma unroll
      for (int i = 0; i < 16; ++i) acc[a][b][i] = 0.f;
}

DI const float* tile_rstd(const float* __restrict__ part, int m0, bf16_t* sm) {
  float* rs = (float*)((unsigned char*)sm + 139264);
  const int tid = tidx();
  if (tid < 256) {
    const float4* p4 = (const float4*)(part + (size_t)(m0 + tid) * 16);
    float s = 0.f;
#pragma unroll
    for (int i = 0; i < 4; ++i) { float4 v = p4[i]; s += v.x + v.y + v.z + v.w; }
    rs[tid] = rsqrtf(s * (1.f / 1024.f) + 1e-6f);
  }
  __syncthreads();
  return rs;
}
DI float row_rstd(const float* __restrict__ part, int m) {
  const float4* p4 = (const float4*)(part + (size_t)m * 16);
  float s = 0.f;
#pragma unroll
  for (int i = 0; i < 4; ++i) { float4 v = p4[i]; s += v.x + v.y + v.z + v.w; }
  return rsqrtf(s * (1.f / 1024.f) + 1e-6f);
}

struct Geo { int xcd, loc, nloc; };
struct TileWalk {
  int xcd, loc, nloc, ng, NT, g, i;
  DI TileWalk(int NT_, const Geo& ge) : xcd(ge.xcd), loc(ge.loc), nloc(ge.nloc), ng((NT_ + 7) >> 3), NT(NT_), g(0), i(ge.loc) {}
  DI bool next(int& mt, int& nt) {
    for (;;) {
      if (g >= ng) return false;
      if (i >= 64) { i = loc; ++g; continue; }
      mt = xcd * 8 + (i & 7); nt = g * 8 + (i >> 3);
      i += nloc;
      if (nt < NT) return true;
    }
  }
};

DI int next_task(unsigned* ctr, bf16_t* sm) {
  volatile int* slot = (volatile int*)((unsigned char*)sm + LDS_BYTES - 16);
  __syncthreads();
  if (threadIdx.x == 0) *slot = (int)__hip_atomic_fetch_add(ctr, 1u, __ATOMIC_RELAXED, __HIP_MEMORY_SCOPE_AGENT);
  __syncthreads();
  return __builtin_amdgcn_readfirstlane(*slot);
}

DI void tr_tile(const float* __restrict__ src, int ldS, int C, int r0, int c0, bf16_t* __restrict__ dst, int ldd,
                const float* __restrict__ g, int remap, float* tl) {
  const int tid = tidx() & 255;
  __syncthreads();
  {
    const int c4 = (tid & 15) * 4;
#pragma unroll
    for (int i = 0; i < 4; ++i) {
      const int r = (tid >> 4) + 16 * i;
      float4 v = make_float4(0.f, 0.f, 0.f, 0.f);
      if (c0 + c4 < C) {
        v = *(const float4*)(src + (size_t)(r0 + r) * ldS + c0 + c4);
        if (g) { const float gg = g[r0 + r]; v.x *= gg; v.y *= gg; v.z *= gg; v.w *= gg; }
      }
      float* t4 = tl + r * 65 + c4;
      t4[0] = v.x; t4[1] = v.y; t4[2] = v.z; t4[3] = v.w;
    }
  }
  __syncthreads();
  {
    const int c = tid >> 2, rq = (tid & 3) * 16;
    if (c0 + c < C) {
      int dr = c0 + c;
      if (remap) { if (dr >= 3608) dr -= 24; else if (dr >= 3584) dr += 6656 - 3584; }
      unsigned w[8];
#pragma unroll
      for (int k = 0; k < 8; ++k) w[k] = pack2(tl[(rq + 2 * k) * 65 + c], tl[(rq + 2 * k + 1) * 65 + c]);
      uint4* d4 = (uint4*)(dst + (size_t)dr * ldd + r0 + rq);
      d4[0] = make_uint4(w[0], w[1], w[2], w[3]);
      d4[1] = make_uint4(w[4], w[5], w[6], w[7]);
    }
  }
}

DI void tr_tile_wave(const float* __restrict__ src, int ldS, int C, int r0, int c0, bf16_t* __restrict__ dst, int ldd,
                     const float* __restrict__ g, int remap, float* tl) {
  const int lane = tidx() & 63;
  {
    const int c4 = (lane & 15) * 4;
    float4 v[16];
#pragma unroll
    for (int i = 0; i < 16; ++i) {
      const int r = (lane >> 4) + 4 * i;
      v[i] = make_float4(0.f, 0.f, 0.f, 0.f);
      if (c0 + c4 < C) v[i] = *(const float4*)(src + (size_t)(r0 + r) * ldS + c0 + c4);
    }
#pragma unroll
    for (int i = 0; i < 16; ++i) {
      const int r = (lane >> 4) + 4 * i;
      const float gg = g ? g[r0 + r] : 1.f;
      float* t4 = tl + r * 65 + c4;
      t4[0] = v[i].x * gg; t4[1] = v[i].y * gg; t4[2] = v[i].z * gg; t4[3] = v[i].w * gg;
    }
  }
  __builtin_amdgcn_fence(__ATOMIC_RELEASE, "wavefront");
  __builtin_amdgcn_wave_barrier();
#pragma unroll
  for (int j = 0; j < 4; ++j) {
    const int c = (lane >> 2) + 16 * j, rq = (lane & 3) * 16;
    if (c0 + c < C) {
      int dr = c0 + c;
      if (remap) { if (dr >= 3608) dr -= 24; else if (dr >= 3584) dr += 6656 - 3584; }
      unsigned w[8];
#pragma unroll
      for (int k = 0; k < 8; ++k) w[k] = pack2(tl[(rq + 2 * k) * 65 + c], tl[(rq + 2 * k + 1) * 65 + c]);
      uint4* d4 = (uint4*)(dst + (size_t)dr * ldd + r0 + rq);
      d4[0] = make_uint4(w[0], w[1], w[2], w[3]);
      d4[1] = make_uint4(w[4], w[5], w[6], w[7]);
    }
  }
  __builtin_amdgcn_wave_barrier();
}

DI void phase0(const P& p, bf16_t* sm) {
  const int tid5 = tidx(), half = tid5 >> 8, tid = tid5 & 255, lane = tid5 & 63, wv8 = tid5 >> 6;
  float* tl = (float*)sm + half * (64 * 65);
  constexpr int NTR_L = 1680 + 384 + 256 + 1024 + 1024 + 256 + 8;
  {
    float* tlw = (float*)sm + wv8 * (64 * 65);
    for (int t = blockIdx.x * 8 + wv8; t < NTR_L * NL; t += gridDim.x * 8) {
      const int layer = t / NTR_L; int r = t % NTR_L;
      if (r < 1680) {
        tr_tile_wave(p.w_in + (size_t)layer * 1024 * NIN, NIN, NIN, (r / 105) * 64, (r % 105) * 64,
                     (bf16_t*)(p.ws + O_WIN + layer * SZ_WIN), LDK1, p.norm_mix + layer * 1024, 1, tlw);
      } else if ((r -= 1680) < 384) {
        const int n3 = r / 128; r %= 128;
        tr_tile_wave(p.w_branch + ((size_t)layer * 3 + n3) * 512 * 1024, 1024, 1024, (r / 16) * 64, (r % 16) * 64,
                     (bf16_t*)(p.ws + O_WBR + layer * SZ_WBR) + (size_t)n3 * 1024 * 512, 512, nullptr, 0, tlw);
      } else if ((r -= 384) < 256) {
        tr_tile_wave(p.w_out + (size_t)layer * 1024 * 1024, 1024, 1024, (r / 16) * 64, (r % 16) * 64,
                     (bf16_t*)(p.ws + O_WO + layer * SZ_WO), LDK1, nullptr, 0, tlw);
      } else if ((r -= 256) < 1024) {
        tr_tile_wave(p.w_up + (size_t)layer * 1024 * 4096, 4096, 4096, (r / 64) * 64, (r % 64) * 64,
                     (bf16_t*)(p.ws + O_WUP + layer * SZ_WUP), LDK1, p.norm_mlp + layer * 1024, 0, tlw);
      } else if ((r -= 1024) < 1024) {
        tr_tile_wave(p.w_down + (size_t)layer * 4096 * 1024, 1024, 1024, (r / 16) * 64, (r % 16) * 64,
                     (bf16_t*)(p.ws + O_WDN + layer * SZ_WDN), LDK4, nullptr, 0, tlw);
      } else if ((r -= 1024) < 256) {
        const int kv = r / 128; r %= 128;
        tr_tile_wave(p.cmp_w1 + ((size_t)layer * 2 + kv) * 2048 * 256, 256, 256, (r / 4) * 64, (r % 4) * 64,
                     (bf16_t*)(p.ws + O_W1 + layer * SZ_W1) + (size_t)kv * 256 * 2048, 2048, nullptr, 0, tlw);
      } else {
        r -= 256;
        const int kv = r / 4; r %= 4;
        tr_tile_wave(p.cmp_w2 + ((size_t)layer * 2 + kv) * 256 * 64, 64, 64, r * 64, 0,
                     (bf16_t*)(p.ws + O_W2 + layer * SZ_W2) + (size_t)kv * 128 * 256, 256, nullptr, 0, tlw);
      }
    }
    __syncthreads();
  }
  constexpr int J_TR = 0;
  constexpr int J_X = J_TR + T_ / 8;
  constexpr int J_POS = J_X + 32;
  constexpr int J_MISC = J_POS + 1;
  constexpr int ZW_PER = ((NINP - NIN) * LDK1 / 8 + 511) / 512;
  constexpr int J_ZW = J_MISC + NL * ZW_PER;
  constexpr int J_ZW2 = J_ZW + 32;
  for (int job = blockIdx.x; job < J_ZW2; job += gridDim.x) {
    if (job < J_TR) {
      const int t = job * 2 + half;
      const int layer = t / NTR_L; int r = t % NTR_L;
      if (r < 1680) {
        tr_tile(p.w_in + (size_t)layer * 1024 * NIN, NIN, NIN, (r / 105) * 64, (r % 105) * 64,
                (bf16_t*)(p.ws + O_WIN + layer * SZ_WIN), LDK1, p.norm_mix + layer * 1024, 1, tl);
      } else if ((r -= 1680) < 384) {
        const int n3 = r / 128; r %= 128;
        tr_tile(p.w_branch + ((size_t)layer * 3 + n3) * 512 * 1024, 1024, 1024, (r / 16) * 64, (r % 16) * 64,
                (bf16_t*)(p.ws + O_WBR + layer * SZ_WBR) + (size_t)n3 * 1024 * 512, 512, nullptr, 0, tl);
      } else if ((r -= 384) < 256) {
        tr_tile(p.w_out + (size_t)layer * 1024 * 1024, 1024, 1024, (r / 16) * 64, (r % 16) * 64,
                (bf16_t*)(p.ws + O_WO + layer * SZ_WO), LDK1, nullptr, 0, tl);
      } else if ((r -= 256) < 1024) {
        tr_tile(p.w_up + (size_t)layer * 1024 * 4096, 4096, 4096, (r / 64) * 64, (r % 64) * 64,
                (bf16_t*)(p.ws + O_WUP + layer * SZ_WUP), LDK1, p.norm_mlp + layer * 1024, 0, tl);
      } else if ((r -= 1024) < 1024) {
        tr_tile(p.w_down + (size_t)layer * 4096 * 1024, 1024, 1024, (r / 16) * 64, (r % 16) * 64,
                (bf16_t*)(p.ws + O_WDN + layer * SZ_WDN), LDK4, nullptr, 0, tl);
      } else if ((r -= 1024) < 256) {
        const int kv = r / 128; r %= 128;
        tr_tile(p.cmp_w1 + ((size_t)layer * 2 + kv) * 2048 * 256, 256, 256, (r / 4) * 64, (r % 4) * 64,
                (bf16_t*)(p.ws + O_W1 + layer * SZ_W1) + (size_t)kv * 256 * 2048, 2048, nullptr, 0, tl);
      } else {
        r -= 256;
        const int kv = r / 4; r %= 4;
        tr_tile(p.cmp_w2 + ((size_t)layer * 2 + kv) * 256 * 64, 64, 64, r * 64, 0,
                (bf16_t*)(p.ws + O_W2 + layer * SZ_W2) + (size_t)kv * 128 * 256, 256, nullptr, 0, tl);
      }
    } else if (job < J_X) {
      const int row = (job - J_TR) * 8 + wv8;
      const float4* src = (const float4*)(p.x + (size_t)row * 1024);
      bf16_t* xb = (bf16_t*)(p.ws + O_XB) + (size_t)row * LDK1;
      float ss = 0.f;
#pragma unroll
      for (int i = 0; i < 4; ++i) {
        float4 v = src[lane + 64 * i];
        ss += v.x * v.x + v.y * v.y + v.z * v.z + v.w * v.w;
        *(uint2*)(xb + (lane + 64 * i) * 4) = make_uint2(pack2(v.x, v.y), pack2(v.z, v.w));
      }
#pragma unroll
      for (int o = 32; o >= 1; o >>= 1) ss += __shfl_xor(ss, o);
      float* part = (float*)(p.ws + O_PART) + (size_t)row * 16;
      if (lane < 16) part[lane] = lane == 0 ? ss : 0.f;
    } else if (job < J_POS) {
      const int jj = (job - J_X) * 2 + half; const int lk = jj >> 3, ng = jj & 7;
      const int col = ng * 32 + (tid & 31), ksl = tid >> 5;
      const float* pos = p.cmp_pos + (size_t)lk * 2048;
      const float* w1 = p.cmp_w1 + (size_t)lk * 2048 * 256;
      float s = 0.f;
      for (int k = ksl * 256; k < ksl * 256 + 256; ++k) s += pos[k] * w1[(size_t)k * 256 + col];
      __syncthreads();
      tl[tid] = s;
      __syncthreads();
      if (tid < 32) {
        float t = 0.f;
        for (int q = 0; q < 8; ++q) t += tl[q * 32 + tid];
        ((float*)(p.ws + O_POSW1))[lk * 256 + col] = t;
      }
    } else if (job < J_MISC) {
      float* tabs = (float*)(p.ws + O_TABS);
      for (int i = tid5; i < 20 * 129; i += NTHR) {
        const int h = i / 129, d = i % 129;
        int bk;
        if (d < 16) bk = d;
        else { bk = 16 + (int)(logf((float)d / 16.f) / 2.0794415416798357f * 16.f); if (bk > 31) bk = 31; }
        tabs[h * 132 + d] = p.rel_bias[bk * 20 + h] * LOG2E;
      }
      if (wv8 == 0) {
        for (int layer = 0; layer < NL; ++layer) {
          const float* lm = p.diff_lambda + layer * 256;
          float a = lm[lane] * lm[64 + lane], b = lm[128 + lane] * lm[192 + lane];
#pragma unroll
          for (int o = 32; o >= 1; o >>= 1) { a += __shfl_xor(a, o); b += __shfl_xor(b, o); }
          const float li = 0.8f - 0.6f * expf(-0.3f * (float)layer);
          if (lane == 0) ((float*)(p.ws + O_LAM))[layer] = expf(a) - expf(b) + li;
        }
      }
    } else if (job < J_ZW) {
      const int jj = job - J_MISC; const int layer = jj / ZW_PER, q = jj % ZW_PER;
      uint4* d = (uint4*)(p.ws + O_WIN + layer * SZ_WIN + (size_t)NIN * LDK1 * 2) + q * 512 + tid5;
      if (q * 512 + tid5 < (NINP - NIN) * LDK1 / 8) *d = make_uint4(0, 0, 0, 0);
    } else {
      const int jj = job - J_ZW; const int lk = jj >> 2, q = jj & 3;
      uint4* d = (uint4*)(p.ws + O_W2 + (size_t)lk * 128 * 256 * 2 + 64 * 256 * 2) + q * 512 + tid5;
      *d = make_uint4(0, 0, 0, 0);
    }
  }
}

DI bool epi_inproj_chunk(const P& p, int layer, int ch, int m0w, f32x16 (&a0)[2], f32x16 (&a1)[2], bf16_t* stg, int cp,
                         bf16_t*& rdst, int& rldd, int& rcoff, float rs0, float rs1) {
  const int lane = tidx() & 63;
  const int lr = lane & 31, lh = lane >> 5;
  enum { NORM, RAW, TRANS, SIG, CG };
  int type = RAW, ldd = 512, coff = 0, nh = 2, dv = 64, hd = 0, doff = 0;
  bf16_t* dst = nullptr; const float* gain = nullptr; float scl = 1.f;
  const float* gains = p.qk_gain + layer * 512;
  unsigned char* ws = p.ws;
  if (ch < 8) { type = NORM; dst = (bf16_t*)(ws + O_AQ); coff = ch * 64; gain = gains; scl = QSCL; }
  else if (ch < 16) { type = NORM; dst = (bf16_t*)(ws + O_AK); coff = (ch - 8) * 64; gain = gains + 64; }
  else if (ch < 24) { type = TRANS; dst = (bf16_t*)(ws + O_AVT); nh = 4; dv = 128; hd = (ch - 16) >> 1; doff = ((ch - 16) & 1) * 64; }
  else if (ch < 32) { type = NORM; dst = (bf16_t*)(ws + O_BQ); coff = (ch - 24) * 64; gain = gains + 128; scl = QSCL; }
  else if (ch < 34) { type = NORM; dst = (bf16_t*)(ws + O_BK); ldd = 128; coff = (ch - 32) * 64; gain = gains + 192; }
  else if (ch < 36) { type = TRANS; dst = (bf16_t*)(ws + O_BVT); hd = ch - 34; }
  else if (ch < 44) { type = NORM; dst = (bf16_t*)(ws + O_CQ); coff = (ch - 36) * 64; gain = gains + 256; scl = QSCL; }
  else if (ch < 46) { type = RAW; dst = (bf16_t*)(ws + O_CK); ldd = 128; coff = (ch - 44) * 64; }
  else if (ch < 48) { type = RAW; dst = (bf16_t*)(ws + O_CV); ldd = 128; coff = (ch - 46) * 64; }
  else if (ch < 50) { type = NORM; dst = (bf16_t*)(ws + O_KS); ldd = 128; coff = (ch - 48) * 64; gain = gains + 384; }
  else if (ch < 52) { type = TRANS; dst = (bf16_t*)(ws + O_VST); hd = ch - 50; }
  else if (ch < 54) { type = NORM; dst = (bf16_t*)(ws + O_KW); ldd = 128; coff = (ch - 52) * 64; gain = gains + 448; }
  else if (ch < 56) { type = TRANS; dst = (bf16_t*)(ws + O_VWT); hd = ch - 54; }
  else if (ch < 104) { type = SIG; dst = (bf16_t*)(ws + O_MGS); ldd = 3072; coff = (ch - 56) * 64; }
  else if (ch == 104) { type = CG; }
  else return false;
  rdst = dst; rldd = ldd; rcoff = coff;
#pragma unroll
  for (int mt = 0; mt < 2; ++mt) {
    const int m = m0w + mt * 32 + lr;
    const float rs = mt ? rs1 : rs0;
    float v[2][16];
    float ss = 0.f;
#pragma unroll
    for (int i = 0; i < 16; ++i) { float t = a0[mt][i] * rs; v[0][i] = t; ss += t * t; }
#pragma unroll
    for (int i = 0; i < 16; ++i) { float t = a1[mt][i] * rs; v[1][i] = t; ss += t * t; }
    if (type == NORM) {
      ss += xor32(ss);
      const float r = rsqrtf(ss * (1.f / 64.f) + 1e-6f) * scl;
#pragma unroll
      for (int nt = 0; nt < 2; ++nt)
#pragma unroll
        for (int qd = 0; qd < 4; ++qd) {
          const int n = nt * 32 + 8 * qd + 4 * lh;
          const float4 g4 = *(const float4*)(gain + n);
          *(uint2*)(stg + (mt * 32 + lr) * 136 + cp * 64 + n) =
              make_uint2(pack2(v[nt][4 * qd] * r * g4.x, v[nt][4 * qd + 1] * r * g4.y),
                         pack2(v[nt][4 * qd + 2] * r * g4.z, v[nt][4 * qd + 3] * r * g4.w));
        }
    } else if (type == RAW || type == SIG) {
#pragma unroll
      for (int nt = 0; nt < 2; ++nt)
#pragma unroll
        for (int qd = 0; qd < 4; ++qd) {
          const int n = nt * 32 + 8 * qd + 4 * lh;
          float a = v[nt][4 * qd], b = v[nt][4 * qd + 1], c = v[nt][4 * qd + 2], d = v[nt][4 * qd + 3];
          if (type == SIG) { a = sigmoidf_(a); b = sigmoidf_(b); c = sigmoidf_(c); d = sigmoidf_(d); }
          if (type == SIG)
            *(uint2*)(dst + ((size_t)((coff + n) >> 2) * T_ + m) * 4) = make_uint2(pack2(a, b), pack2(c, d));
          else
            *(uint2*)(stg + (mt * 32 + lr) * 136 + cp * 64 + n) = make_uint2(pack2(a, b), pack2(c, d));
        }
    } else if (type == TRANS) {
      const int b = m >> 12, s = m & 4095;
      bf16_t* base = dst + ((size_t)(b * nh + hd) * dv + doff) * S_ + s;
#pragma unroll
      for (int nt = 0; nt < 2; ++nt)
#pragma unroll
        for (int i = 0; i < 16; ++i) {
          const int n = nt * 32 + 8 * (i >> 2) + 4 * lh + (i & 3);
          base[(size_t)n * S_] = f2bf(v[nt][i]);
        }
    } else {
      float* cg = (float*)(ws + O_CGS) + (size_t)m * 24;
#pragma unroll
      for (int i = 0; i < 16; ++i) {
        const int n = 8 * (i >> 2) + 4 * lh + (i & 3);
        if (n < 24) cg[n] = sigmoidf_(v[0][i]);
      }
    }
  }
  return type == NORM || type == RAW;
}

DI void stage_rows_store(const bf16_t* stg, bf16_t* dst, size_t ldd, int m0w) {
  const int lane = tidx() & 63;
#pragma unroll
  for (int it = 0; it < 16; ++it) {
    const int row = it * 4 + (lane >> 4), c16 = lane & 15;
    const u32x4 v = *(const u32x4*)(stg + row * 136 + c16 * 8);
    *(u32x4*)(dst + (size_t)(m0w + row) * ldd + c16 * 8) = v;
  }
}

DI void phase_inproj(const P& p, int layer, bf16_t* sm, const Geo& ge) {
  const bf16_t* W = (const bf16_t*)(p.ws + O_WIN + layer * SZ_WIN);
  const bf16_t* X = (const bf16_t*)(p.ws + O_XB);
  TileWalk tw(27, ge);
  int mt, nt, mt_have = -1;
  float rs0 = 0.f, rs1 = 0.f;
  while (tw.next(mt, nt)) {
    if (mt != mt_have) {
      const int lane_ = tidx() & 63, wm_ = (tidx() >> 6) >> 1;
      rs0 = row_rstd((const float*)(p.ws + O_PART), mt * 256 + wm_ * 64 + (lane_ & 31));
      rs1 = row_rstd((const float*)(p.ws + O_PART), mt * 256 + wm_ * 64 + 32 + (lane_ & 31));
      mt_have = mt;
    }
    f32x16 acc[4][2]; zero_acc8(acc);
    gemm_wide(W + (size_t)nt * 256 * LDK1, LDK1, X + (size_t)mt * 256 * LDK1, LDK1, 16, acc, sm);
    const int wv = tidx() >> 6, wn = wv & 1, wm = wv >> 1;
    bf16_t* stg = sm + wv * (64 * 136);
    bf16_t *d0 = nullptr, *d1 = nullptr; int ld0 = 0, ld1 = 0, co0 = 0, co1 = 0;
    const bool s0 = epi_inproj_chunk(p, layer, nt * 4 + wn * 2, mt * 256 + wm * 64, acc[0], acc[1], stg, 0, d0, ld0, co0, rs0, rs1);
    const bool s1 = epi_inproj_chunk(p, layer, nt * 4 + wn * 2 + 1, mt * 256 + wm * 64, acc[2], acc[3], stg, 1, d1, ld1, co1, rs0, rs1);
    if (s0 && s1) stage_rows_store(stg, d0 + co0, ld0, mt * 256 + wm * 64);
  }
}

template <int NDT, int MODE, bool ALLON>
DI void attn_tile(const bf16_t* Kl, int kst, const bf16_t* Vl, const bf16x8 (&q)[4], f32x16 (&O)[NDT], float& m, float& l,
                  int kbase, int qp, int win, float cbias, const float* tab, bool lane_on) {
  const int lane = tidx() & 63, lr = lane & 31, lh = lane >> 5;
  f32x16 s[2];
#pragma unroll
  for (int st = 0; st < 2; ++st) {
#pragma unroll
    for (int i = 0; i < 16; ++i) s[st][i] = 0.f;
  }
#pragma unroll
  for (int ks = 0; ks < 4; ++ks) {
    const bf16x8 k0 = *(const bf16x8*)(Kl + lr * kst + ks * 16 + lh * 8);
    const bf16x8 k1 = *(const bf16x8*)(Kl + (32 + lr) * kst + ks * 16 + lh * 8);
    s[0] = MFMA32(k0, q[ks], s[0]);
    s[1] = MFMA32(k1, q[ks], s[1]);
  }
  float alpha, psum = 0.f;
  if (MODE == 0) {
    float tmax = fmaxf(s[0][0], s[1][0]);
#pragma unroll
    for (int i = 1; i < 16; ++i) tmax = fmaxf(tmax, fmaxf(s[0][i], s[1][i]));
    tmax = fmaxf(tmax, xor32(tmax)) + cbias;
    if (!ALLON) tmax = lane_on ? tmax : -1e30f;
    const float mn = fmaxf(m, tmax);
    alpha = ex2(m - mn);
    m = mn;
    const float mc = (ALLON || lane_on) ? mn - cbias : 1e30f;
#pragma unroll
    for (int st = 0; st < 2; ++st)
#pragma unroll
      for (int i = 0; i < 16; ++i) { const float pe = ex2(s[st][i] - mc); psum += pe; s[st][i] = pe; }
  } else {
    float tmax = -1e30f;
#pragma unroll
    for (int st = 0; st < 2; ++st)
#pragma unroll
      for (int i = 0; i < 16; ++i) {
        const int key = kbase + st * 32 + 8 * (i >> 2) + 4 * lh + (i & 3);
        float v;
        if (MODE == 1) {
          const int dist = qp - key;
          const bool ok = (ALLON || lane_on) && dist >= 0 && dist < win;
          const int di = dist < 0 ? 0 : (dist > 128 ? 128 : dist);
          v = ok ? s[st][i] + tab[di] : -1e30f;
        } else {
          v = (16 * key + 31 <= qp) ? s[st][i] : -1e30f;
        }
        s[st][i] = v;
        tmax = fmaxf(tmax, v);
      }
    tmax = fmaxf(tmax, xor32(tmax));
    const float mn = fmaxf(m, tmax);
    alpha = ex2(m - mn);
    m = mn;
#pragma unroll
    for (int st = 0; st < 2; ++st)
#pragma unroll
      for (int i = 0; i < 16; ++i) {
        const float pe = s[st][i] > -5e29f ? ex2(s[st][i] - mn) : 0.f;
        psum += pe;
        s[st][i] = pe;
      }
  }
  l = l * alpha + psum;
  if (__ballot(alpha != 1.f)) {
#pragma unroll
    for (int dt = 0; dt < NDT; ++dt)
#pragma unroll
      for (int i = 0; i < 16; ++i) O[dt][i] *= alpha;
  }
#pragma unroll
  for (int st = 0; st < 2; ++st)
#pragma unroll
    for (int sk = 0; sk < 2; ++sk) {
      u32x4 pu;
      pu[0] = pack2(s[st][8 * sk + 0], s[st][8 * sk + 1]);
      pu[1] = pack2(s[st][8 * sk + 2], s[st][8 * sk + 3]);
      pu[2] = pack2(s[st][8 * sk + 4], s[st][8 * sk + 5]);
      pu[3] = pack2(s[st][8 * sk + 6], s[st][8 * sk + 7]);
      const bf16x8 pf = __builtin_bit_cast(bf16x8, pu);
#pragma unroll
      for (int dt = 0; dt < NDT; ++dt) {
        const bf16_t* vp = Vl + (dt * 32 + lr) * 72 + st * 32 + sk * 16 + 4 * lh;
        const uint2 v0 = *(const uint2*)(vp);
        const uint2 v1 = *(const uint2*)(vp + 8);
        u32x4 vu; vu[0] = v0.x; vu[1] = v0.y; vu[2] = v1.x; vu[3] = v1.y;
        O[dt] = MFMA32(__builtin_bit_cast(bf16x8, vu), pf, O[dt]);
      }
    }
}

DI float gelu_tanh(float x) {
  const float u = 0.7978845608028654f * (x + 0.044715f * x * x * x);
  const float e = __expf(2.f * u);
  const float th = 1.f - 2.f * __builtin_amdgcn_rcpf(e + 1.f);
  return 0.5f * x * (1.f + th);
}

DI void task_compress(const P& p, int layer, int task, bf16_t* sm) {
  const int tid = tidx(), lane = tid & 63, wv = tid >> 6, wn = wv & 1, wm = wv >> 1;
  const int lr = lane & 31, lh = lane >> 5;
  const int b = task & 3, g = (task >> 2) & 1, kv = task >> 3;
  const bf16_t* src = (const bf16_t*)(p.ws + (kv ? O_CV : O_CK)) + (size_t)b * S_ * 128 + g * 64;
  const bf16_t* W1 = (const bf16_t*)(p.ws + O_W1 + layer * SZ_W1) + (size_t)kv * 256 * 2048;
  const bf16_t* W2 = (const bf16_t*)(p.ws + O_W2 + layer * SZ_W2) + (size_t)kv * 128 * 256;
  bf16_t* hid = (bf16_t*)(p.ws + O_HID) + (size_t)((kv * 2 + g) * 4 + b) * 65536;
  const float* pw = (const float*)(p.ws + O_POSW1) + (layer * 2 + kv) * 256;
  for (int nt2 = 0; nt2 < 2; ++nt2) {
    f32x16 acc[2][2]; zero_acc(acc);
    gemm_mid(W1 + (size_t)nt2 * 128 * 2048, 2048, src, 16 * 128, 254, 128, 32, 0, acc, sm);
#pragma unroll
    for (int mt = 0; mt < 2; ++mt) {
      const int m = wm * 64 + mt * 32 + lr;
#pragma unroll
      for (int nt = 0; nt < 2; ++nt)
#pragma unroll
        for (int qd = 0; qd < 4; ++qd) {
          const int n = nt2 * 128 + wn * 64 + nt * 32 + 8 * qd + 4 * lh;
          const float4 pw4 = *(const float4*)(pw + n);
          *(uint2*)(hid + (size_t)m * 256 + n) =
              make_uint2(pack2(gelu_tanh(acc[nt][mt][4 * qd] + pw4.x), gelu_tanh(acc[nt][mt][4 * qd + 1] + pw4.y)),
                         pack2(gelu_tanh(acc[nt][mt][4 * qd + 2] + pw4.z), gelu_tanh(acc[nt][mt][4 * qd + 3] + pw4.w)));
        }
    }
  }
  __threadfence();
  __syncthreads();
  {
    f32x16 acc[2][2]; zero_acc(acc);
    gemm_mid(W2, 256, hid, 256, 1 << 30, 64, 4, 0, acc, sm);
    if (wn == 0) {
      const float* gain = p.qk_gain + layer * 512 + 320;
#pragma unroll
      for (int mt = 0; mt < 2; ++mt) {
        const int m = wm * 64 + mt * 32 + lr;
        if (kv == 0) {
          float ss = 0.f;
#pragma unroll
          for (int nt = 0; nt < 2; ++nt)
#pragma unroll
            for (int i = 0; i < 16; ++i) ss += acc[nt][mt][i] * acc[nt][mt][i];
          ss += xor32(ss);
          const float r = rsqrtf(ss * (1.f / 64.f) + 1e-6f);
          bf16_t* kc = (bf16_t*)(p.ws + O_KC) + ((size_t)(b * 2 + g) * 256 + m) * 64;
#pragma unroll
          for (int nt = 0; nt < 2; ++nt)
#pragma unroll
            for (int qd = 0; qd < 4; ++qd) {
              const int n = nt * 32 + 8 * qd + 4 * lh;
              const float4 g4 = *(const float4*)(gain + n);
              *(uint2*)(kc + n) = make_uint2(pack2(acc[nt][mt][4 * qd] * r * g4.x, acc[nt][mt][4 * qd + 1] * r * g4.y),
                                             pack2(acc[nt][mt][4 * qd + 2] * r * g4.z, acc[nt][mt][4 * qd + 3] * r * g4.w));
            }
        } else {
          bf16_t* vc = (bf16_t*)(p.ws + O_VCT) + (size_t)(b * 2 + g) * 64 * 256 + m;
#pragma unroll
          for (int nt = 0; nt < 2; ++nt)
#pragma unroll
            for (int i = 0; i < 16; ++i) {
              const int n = nt * 32 + 8 * (i >> 2) + 4 * lh + (i & 3);
              vc[(size_t)n * 256] = f2bf(acc[nt][mt][i]);
            }
        }
      }
    }
  }
}

DI void task_attnA(const P& p, int layer, int task, bf16_t* sm, int dm) {
  const int tid = tidx(), lane = tid & 63, wv = tid >> 6, c = wv & 1, qs = wv >> 1;
  const int lr = lane & 31, lh = lane >> 5;
  const int qb = 31 - (task >> 4), bh = task & 15, b = bh >> 2, h = bh & 3;
  float* tab = (float*)((unsigned char*)sm + 71680);
  bf16x8* qlds = (bf16x8*)((unsigned char*)sm + 72704) + wv * 256 + lane;
  float* xbuf = (float*)((unsigned char*)sm);
  __syncthreads();
  if (tid < 129) tab[tid] = ((const float*)(p.ws + O_TABS))[h * 132 + tid];
  const int q0 = qb * 128, qmin = q0 + qs * 32, qp = qmin + lr;
  bf16_t* aq = (bf16_t*)(p.ws + O_AQ);
  {
    const bf16_t* qptr = aq + (size_t)(b * S_ + qp) * 512 + h * 128 + c * 64 + lh * 8;
#pragma unroll
    for (int ks = 0; ks < 4; ++ks) qlds[ks * 64] = *(const bf16x8*)(qptr + ks * 16);
  }
  f32x16 O[4];
#pragma unroll
  for (int dt = 0; dt < 4; ++dt)
#pragma unroll
    for (int i = 0; i < 16; ++i) O[dt][i] = 0.f;
  float m = -1e30f, l = 0.f;
  const bf16_t* kg = (const bf16_t*)(p.ws + O_AK) + (size_t)b * S_ * 512 + h * 128;
  const bf16_t* vg = (const bf16_t*)(p.ws + O_AVT) + (size_t)((b * 4 + h) * 128) * S_;
  u32x4 rk0, rk1, rv0, rv1;
#define A_GLOAD(i, KT) { const int chk = tid + 512 * i; \
    rk##i = *(const u32x4*)(kg + (size_t)((KT) * 64 + (chk >> 4)) * 512 + (chk & 15) * 8); \
    rv##i = *(const u32x4*)(vg + (size_t)(chk >> 3) * S_ + (KT) * 64 + (chk & 7) * 8); }
#define A_LSTORE(i) { const int chk = tid + 512 * i; \
    *(u32x4*)(Kl + (chk >> 4) * 136 + (chk & 15) * 8) = rk##i; \
    *(u32x4*)(Kl + 64 * 136 + (chk >> 3) * 72 + (chk & 7) * 8) = rv##i; }
  const int kt_hi = 2 * qb + 1;
  A_GLOAD(0, 0) A_GLOAD(1, 0)
  for (int kt = 0; kt <= kt_hi; ++kt) {
    bf16_t* Kl = sm + (kt & 1) * 17920; const bf16_t* Vl = Kl + 64 * 136;
    A_LSTORE(0) A_LSTORE(1)
    if (kt < kt_hi) { A_GLOAD(0, kt + 1) A_GLOAD(1, kt + 1) }
    __syncthreads();
    if (kt * 64 <= qmin + 31) {
      bf16x8 q[4];
#pragma unroll
      for (int ks = 0; ks < 4; ++ks) q[ks] = qlds[ks * 64];
      if (kt * 64 + 63 + 128 <= qmin)
        attn_tile<4, 0, true>(Kl + c * 64, 136, Vl, q, O, m, l, kt * 64, qp, 0, tab[128], tab, true);
      else
        attn_tile<4, 1, true>(Kl + c * 64, 136, Vl, q, O, m, l, kt * 64, qp, 1 << 30, 0.f, tab, true);
    }
  }
#undef A_GLOAD
#undef A_LSTORE
  const float lt = l + xor32(l);
  const float inv = 1.f / lt;
  __syncthreads();
  if (c == 1) {
#pragma unroll
    for (int dt = 0; dt < 4; ++dt)
#pragma unroll
      for (int i = 0; i < 16; ++i) {
        const int d = dt * 32 + 8 * (i >> 2) + 4 * lh + (i & 3);
        xbuf[(qs * 128 + d) * 32 + lr] = O[dt][i] * inv;
      }
  }
  __syncthreads();
  if (c == 0) {
    const float lam = ((const float*)(p.ws + O_LAM))[layer];
    const float li = 0.8f - 0.6f * expf(-0.3f * (float)layer);
    float ss = 0.f;
#pragma unroll
    for (int dt = 0; dt < 4; ++dt)
#pragma unroll
      for (int i = 0; i < 16; ++i) {
        const int d = dt * 32 + 8 * (i >> 2) + 4 * lh + (i & 3);
        const float o = O[dt][i] * inv - lam * xbuf[(qs * 128 + d) * 32 + lr];
        O[dt][i] = o;
        ss += o * o;
      }
    ss += xor32(ss);
    const float r = rsqrtf(ss * (1.f / 128.f) + 1e-6f) * (1.f - li);
    const float* sub = p.diff_subln + layer * 128;
    bf16_t* dst = (dm ? (bf16_t*)(p.ws + WS_END) : aq) + (size_t)(b * S_ + qp) * 512 + h * 128;
#pragma unroll
    for (int dt = 0; dt < 4; ++dt)
#pragma unroll
      for (int qd = 0; qd < 4; ++qd) {
        const int d = dt * 32 + 8 * qd + 4 * lh;
        const float4 g4 = *(const float4*)(sub + d);
        *(uint2*)(dst + d) = make_uint2(pack2(O[dt][4 * qd] * r * g4.x, O[dt][4 * qd + 1] * r * g4.y),
                                        pack2(O[dt][4 * qd + 2] * r * g4.z, O[dt][4 * qd + 3] * r * g4.w));
      }
  }
}

struct KVRegs { u32x4 k0, v0; };
DI void kv_gload(KVRegs& r, const bf16_t* kg, size_t kld, const bf16_t* vg, size_t vld, int key0) {
  const int c0 = tidx();
  r.k0 = *(const u32x4*)(kg + (size_t)(key0 + (c0 >> 3)) * kld + (c0 & 7) * 8);
  r.v0 = *(const u32x4*)(vg + (size_t)(c0 >> 3) * vld + key0 + (c0 & 7) * 8);
}
DI void kv_lstore(const KVRegs& r, bf16_t* Kl, bf16_t* Vl) {
  const int c0 = tidx();
  *(u32x4*)(Kl + (c0 >> 3) * 72 + (c0 & 7) * 8) = r.k0;
  *(u32x4*)(Vl + (c0 >> 3) * 72 + (c0 & 7) * 8) = r.v0;
}

DI void task_attnB(const P& p, int layer, int task, bf16_t* sm, int dm) {
  const int tid = tidx(), lane = tid & 63, wv = tid >> 6, hr = wv & 3, qs = wv >> 2;
  const int lr = lane & 31, lh = lane >> 5;
  const int qb = 63 - (task >> 3), bg = task & 7, b = bg >> 1, g = bg & 1, head = g * 4 + hr;
  float* tabs = (float*)((unsigned char*)sm + 36864);
  __syncthreads();
  for (int i = tid; i < 4 * 129; i += NTHR) {
    const int r = i / 129, d = i % 129;
    tabs[r * 132 + d] = ((const float*)(p.ws + O_TABS))[(4 + g * 4 + r) * 132 + d];
  }
  const int q0 = qb * 64, qmin = q0 + qs * 32, qp = qmin + lr;
  bf16_t* bq = (bf16_t*)(p.ws + O_BQ);
  bf16x8 q[4];
  {
    const bf16_t* qptr = bq + (size_t)(b * S_ + qp) * 512 + head * 64 + lh * 8;
#pragma unroll
    for (int ks = 0; ks < 4; ++ks) q[ks] = *(const bf16x8*)(qptr + ks * 16);
  }
  f32x16 O[2];
#pragma unroll
  for (int dt = 0; dt < 2; ++dt)
#pragma unroll
    for (int i = 0; i < 16; ++i) O[dt][i] = 0.f;
  float m = p.sinks[layer * 8 + head] * LOG2E, l = lh == 0 ? 1.f : 0.f;
  const bf16_t* kg = (const bf16_t*)(p.ws + O_BK) + (size_t)b * S_ * 128 + g * 64;
  const bf16_t* vg = (const bf16_t*)(p.ws + O_BVT) + (size_t)((b * 2 + g) * 64) * S_;
  const int kt_lo = q0 >= 127 ? (q0 - 127) >> 6 : 0, kt_hi = qb;
  KVRegs R;
  kv_gload(R, kg, 128, vg, S_, kt_lo * 64);
  for (int kt = kt_lo; kt <= kt_hi; ++kt) {
    bf16_t* Kl = sm + (kt & 1) * 9216; bf16_t* Vl = Kl + 4608;
    kv_lstore(R, Kl, Vl);
    if (kt < kt_hi) kv_gload(R, kg, 128, vg, S_, (kt + 1) * 64);
    __syncthreads();
    if (kt * 64 <= qmin + 31 && kt * 64 + 63 + 127 >= qmin)
      attn_tile<2, 1, true>(Kl, 72, Vl, q, O, m, l, kt * 64, qp, 128, 0.f, tabs + hr * 132, true);
  }
  const float lt = l + xor32(l);
  const float inv = 1.f / lt;
  bf16_t* dst = (dm ? (bf16_t*)(p.ws + WS_END) : bq) + (size_t)(b * S_ + qp) * 512 + head * 64;
#pragma unroll
  for (int dt = 0; dt < 2; ++dt)
#pragma unroll
    for (int qd = 0; qd < 4; ++qd) {
      const int d = dt * 32 + 8 * qd + 4 * lh;
      *(uint2*)(dst + d) = make_uint2(pack2(O[dt][4 * qd] * inv, O[dt][4 * qd + 1] * inv),
                                      pack2(O[dt][4 * qd + 2] * inv, O[dt][4 * qd + 3] * inv));
    }
}

DI void phase2(const P& p, int layer, bf16_t* sm, unsigned* qhead, int dm = 0) {
  for (;;) {
    const int task = next_task(qhead, sm);
    if (task >= 16 + 512 + 512) break;
    if (task < 16) task_compress(p, layer, task, sm);
    else if (task < 16 + 512) task_attnA(p, layer, task - 16, sm, dm);
    else task_attnB(p, layer, task - 528, sm, dm);
  }
}

DI void task_nsa(const P& p, int layer, int task, bf16_t* sm, int dm) {
  const int tid = tidx(), lane = tid & 63, wv = tid >> 6, hr = wv & 3, qs = wv >> 2;
  const int lr = lane & 31, lh = lane >> 5;
  const int qb = 63 - (task >> 3), bg = task & 7, b = bg >> 1, g = bg & 1, head = g * 4 + hr;
  float* tabs = (float*)((unsigned char*)sm + 36864);
  float* cbuf = (float*)((unsigned char*)sm + 39168);
  unsigned long long* masks = (unsigned long long*)((unsigned char*)sm + 55808);
  float* outl = (float*)((unsigned char*)sm + 56320) + wv * 2048 + lane;
  int itc = 0;
  __syncthreads();
  for (int i = tid; i < 4 * 129; i += NTHR) {
    const int r = i / 129, d = i % 129;
    tabs[r * 132 + d] = ((const float*)(p.ws + O_TABS))[(12 + g * 4 + r) * 132 + d];
  }
  for (int i = tid; i < 64 * 65; i += NTHR) cbuf[i] = 0.f;
  const float* tab = tabs + hr * 132;
  const int q0 = qb * 64, qmin = q0 + qs * 32, ql = qs * 32 + lr, qp = q0 + ql;
  bf16_t* cq = (bf16_t*)(p.ws + O_CQ);
  bf16x8 q[4];
  {
    const bf16_t* qptr = cq + (size_t)(b * S_ + qp) * 512 + head * 64 + lh * 8;
#pragma unroll
    for (int ks = 0; ks < 4; ++ks) q[ks] = *(const bf16x8*)(qptr + ks * 16);
  }
  const float* cg = (const float*)(p.ws + O_CGS) + (size_t)(b * S_ + qp) * 24 + head * 3;
  const float g0 = cg[0], g1 = cg[1], g2 = cg[2];
  f32x16 O[2];
  KVRegs R;
  {
    int nct = (((q0 + 32) >> 4) + 1 + 63) >> 6; if (nct > 4) nct = 4;
    const bf16_t* kg = (const bf16_t*)(p.ws + O_KC) + (size_t)(b * 2 + g) * 256 * 64;
    const bf16_t* vg = (const bf16_t*)(p.ws + O_VCT) + (size_t)(b * 2 + g) * 64 * 256;
#pragma unroll
    for (int dt = 0; dt < 2; ++dt)
#pragma unroll
      for (int i = 0; i < 16; ++i) O[dt][i] = 0.f;
    float m = -1e30f, l = 0.f;
    kv_gload(R, kg, 64, vg, 256, 0);
    for (int ct = 0; ct < nct; ++ct, ++itc) {
      bf16_t* Kl = sm + (itc & 1) * 9216; bf16_t* Vl = Kl + 4608;
      kv_lstore(R, Kl, Vl);
      if (ct + 1 < nct) kv_gload(R, kg, 64, vg, 256, (ct + 1) * 64);
      __syncthreads();
      attn_tile<2, 2, true>(Kl, 72, Vl, q, O, m, l, ct * 64, qp, 0, 0.f, tab, true);
    }
    const float lt = l + xor32(l);
    const float inv = lt > 0.f ? 1.f / lt : 0.f;
    {
      const float sc = g0 * inv;
#pragma unroll
      for (int dt = 0; dt < 2; ++dt)
#pragma unroll
        for (int i = 0; i < 16; ++i) outl[(dt * 16 + i) * 64] = sc * O[dt][i];
    }
    float carry = 0.f;
    kv_gload(R, kg, 64, vg, 256, 0);
    for (int ct = 0; ct < nct; ++ct, ++itc) {
      bf16_t* Kl = sm + (itc & 1) * 9216; bf16_t* Vl = Kl + 4608;
      kv_lstore(R, Kl, Vl);
      if (ct + 1 < nct) kv_gload(R, kg, 64, vg, 256, (ct + 1) * 64);
      __syncthreads();
      float val[2][4];
#pragma unroll
      for (int st = 0; st < 2; ++st) {
        f32x16 s;
#pragma unroll
        for (int i = 0; i < 16; ++i) s[i] = 0.f;
#pragma unroll
        for (int ks = 0; ks < 4; ++ks) {
          bf16x8 kf = *(const bf16x8*)(Kl + (st * 32 + lr) * 72 + ks * 16 + lh * 8);
          s = MFMA32(kf, q[ks], s);
        }
        float pq[4], pl[4], other[4];
#pragma unroll
        for (int g4 = 0; g4 < 4; ++g4) {
          float sum = 0.f, last = 0.f;
#pragma unroll
          for (int e = 0; e < 4; ++e) {
            const int cc = ct * 64 + st * 32 + 8 * g4 + 4 * lh + e;
            const float pe = (16 * cc + 31 <= qp) ? ex2(s[4 * g4 + e] - m) * inv : 0.f;
            sum += pe; last = pe;
          }
          pq[g4] = sum; pl[g4] = last;
        }
#pragma unroll
        for (int g4 = 0; g4 < 4; ++g4) other[g4] = xor32(pl[g4]);
        val[st][0] = pq[0] + (lh ? other[0] : carry);
        val[st][1] = pq[1] + (lh ? other[1] : other[0]);
        val[st][2] = pq[2] + (lh ? other[2] : other[1]);
        val[st][3] = pq[3] + (lh ? other[3] : other[2]);
        carry = other[3];
      }
      for (int w = 0; w < 4; ++w) {
        if (hr == w) {
#pragma unroll
          for (int st = 0; st < 2; ++st)
#pragma unroll
            for (int g4 = 0; g4 < 4; ++g4) cbuf[(ct * 16 + st * 8 + 2 * g4 + lh) * 65 + ql] += val[st][g4];
        }
        __syncthreads();
      }
    }
  }
  __syncthreads();
  for (int qi = 0; qi < 8; ++qi) {
    const int qq = wv * 8 + qi, qpos = q0 + qq, j = lane, cur = qpos >> 6;
    const float imp = cbuf[j * 65 + qq];
    const bool valid = j <= cur;
    const bool forced = (j == 0) || (j == cur) || (j == cur - 1);
    const float score = valid ? imp + (forced ? 1e4f : 0.f) : -1e30f;
    int rank = 0;
#pragma unroll 4
    for (int jp = 0; jp < 64; ++jp) {
      const float sj = __int_as_float(__builtin_amdgcn_readlane(__float_as_int(score), jp));
      rank += ((sj > score) || (sj == score && jp < j)) ? 1 : 0;
    }
    const unsigned long long mk = __ballot(rank < 16);
    if (lane == 0) masks[qq] = mk;
  }
  __syncthreads();
  const unsigned long long mymask = masks[ql];
  unsigned long long un = 0ull;
  for (int i = 0; i < 64; ++i) un |= masks[i];
  {
    const int cmax = qb;
    unsigned long long todo = un & (cmax == 63 ? ~0ull : ((1ull << (cmax + 1)) - 1ull));
    const bf16_t* kg = (const bf16_t*)(p.ws + O_KS) + (size_t)b * S_ * 128 + g * 64;
    const bf16_t* vg = (const bf16_t*)(p.ws + O_VST) + (size_t)((b * 2 + g) * 64) * S_;
#pragma unroll
    for (int dt = 0; dt < 2; ++dt)
#pragma unroll
      for (int i = 0; i < 16; ++i) O[dt][i] = 0.f;
    float m = -1e30f, l = 0.f;
    kv_gload(R, kg, 128, vg, S_, (__ffsll((long long)todo) - 1) * 64);
    for (; todo; ++itc) {
      const int j = __ffsll((long long)todo) - 1;
      todo &= todo - 1ull;
      bf16_t* Kl = sm + (itc & 1) * 9216; bf16_t* Vl = Kl + 4608;
      kv_lstore(R, Kl, Vl);
      if (todo) kv_gload(R, kg, 128, vg, S_, (__ffsll((long long)todo) - 1) * 64);
      __syncthreads();
      const bool on = (mymask >> j) & 1ull;
      if (j * 64 <= qmin + 31 && __ballot(on)) {
        if (j * 64 + 63 + 128 <= qmin)
          attn_tile<2, 0, false>(Kl, 72, Vl, q, O, m, l, j * 64, qp, 0, tab[128], tab, on);
        else
          attn_tile<2, 1, false>(Kl, 72, Vl, q, O, m, l, j * 64, qp, 1 << 30, 0.f, tab, on);
      }
    }
    const float lt = l + xor32(l);
    const float inv = lt > 0.f ? 1.f / lt : 0.f;
    {
      const float sc = g1 * inv;
#pragma unroll
      for (int dt = 0; dt < 2; ++dt)
#pragma unroll
        for (int i = 0; i < 16; ++i) outl[(dt * 16 + i) * 64] += sc * O[dt][i];
    }
  }
  {
    const bf16_t* kg = (const bf16_t*)(p.ws + O_KW) + (size_t)b * S_ * 128 + g * 64;
    const bf16_t* vg = (const bf16_t*)(p.ws + O_VWT) + (size_t)((b * 2 + g) * 64) * S_;
#pragma unroll
    for (int dt = 0; dt < 2; ++dt)
#pragma unroll
      for (int i = 0; i < 16; ++i) O[dt][i] = 0.f;
    float m = -1e30f, l = 0.f;
    const int kt_lo = q0 >= 511 ? (q0 - 511) >> 6 : 0, kt_hi = qb;
    kv_gload(R, kg, 128, vg, S_, kt_lo * 64);
    for (int kt = kt_lo; kt <= kt_hi; ++kt, ++itc) {
      bf16_t* Kl = sm + (itc & 1) * 9216; bf16_t* Vl = Kl + 4608;
      kv_lstore(R, Kl, Vl);
      if (kt < kt_hi) kv_gload(R, kg, 128, vg, S_, (kt + 1) * 64);
      __syncthreads();
      if (kt * 64 <= qmin + 31 && kt * 64 + 63 + 511 >= qmin) {
        if (kt * 64 + 63 + 128 <= qmin && qmin + 31 - kt * 64 < 512)
          attn_tile<2, 0, true>(Kl, 72, Vl, q, O, m, l, kt * 64, qp, 0, tab[128], tab, true);
        else
          attn_tile<2, 1, true>(Kl, 72, Vl, q, O, m, l, kt * 64, qp, 512, 0.f, tab, true);
      }
    }
    const float lt = l + xor32(l);
    const float inv = 1.f / lt;
    {
      const float sc = g2 * inv;
#pragma unroll
      for (int dt = 0; dt < 2; ++dt)
#pragma unroll
        for (int i = 0; i < 16; ++i) O[dt][i] = outl[(dt * 16 + i) * 64] + sc * O[dt][i];
    }
  }
  bf16_t* dst = (dm ? (bf16_t*)(p.ws + WS_END) : cq) + (size_t)(b * S_ + qp) * 512 + head * 64;
#pragma unroll
  for (int dt = 0; dt < 2; ++dt)
#pragma unroll
    for (int qd = 0; qd < 4; ++qd) {
      const int d = dt * 32 + 8 * qd + 4 * lh;
      *(uint2*)(dst + d) = make_uint2(pack2(O[dt][4 * qd], O[dt][4 * qd + 1]), pack2(O[dt][4 * qd + 2], O[dt][4 * qd + 3]));
    }
}

DI void phase3(const P& p, int layer, bf16_t* sm, unsigned* qhead, int dm = 0) {
  for (;;) {
    const int task = next_task(qhead, sm);
    if (task >= 512) break;
    task_nsa(p, layer, task, sm, dm);
  }
}

DI void phase23(const P& p, int layer, bf16_t* sm, unsigned* qhead, unsigned* cdone) {
  for (;;) {
    const int task = next_task(qhead, sm);
    if (task >= 16 + 512 + 512 + 512) break;
    if (task < 16) {
      task_compress(p, layer, task, sm);
      asm volatile("s_waitcnt vmcnt(0) lgkmcnt(0)" ::: "memory");
      __syncthreads();
      if (threadIdx.x == 0) {
        __builtin_amdgcn_fence(__ATOMIC_RELEASE, "agent");
        asm volatile("s_waitcnt vmcnt(0)" ::: "memory");
        __hip_atomic_fetch_add(cdone, 1u, __ATOMIC_RELAXED, __HIP_MEMORY_SCOPE_AGENT);
      }
    } else if (task < 16 + 512) task_attnA(p, layer, task - 16, sm, 0);
    else if (task >= 1040) task_attnB(p, layer, task - 1040, sm, 0);
    else {
      if (threadIdx.x == 0) {
        while (__hip_atomic_load(cdone, __ATOMIC_RELAXED, __HIP_MEMORY_SCOPE_AGENT) < 16u) __builtin_amdgcn_s_sleep(2);
        __builtin_amdgcn_fence(__ATOMIC_ACQUIRE, "agent");
        asm volatile("s_waitcnt vmcnt(0)" ::: "memory");
      }
      __syncthreads();
      task_nsa(p, layer, task - 528, sm, 0);
    }
  }
}

DI void phase_merge(const P& p, int layer, bf16_t* sm, const Geo& ge) {
  const int tid = tidx(), lane = tid & 63, wv = tid >> 6, wn = wv & 1, wm = wv >> 1;
  const int lr = lane & 31, lh = lane >> 5;
  const bf16_t* W = (const bf16_t*)(p.ws + O_WBR + layer * SZ_WBR);
  const bf16_t* mgs = (const bf16_t*)(p.ws + O_MGS);
  bf16_t* z = (bf16_t*)(p.ws + O_Z);
  TileWalk tw(8, ge);
  int mt_, nt_;
  while (tw.next(mt_, nt_)) {
    unsigned zp[2][2][8];
#pragma unroll
    for (int a_ = 0; a_ < 2; ++a_)
#pragma unroll
      for (int b_ = 0; b_ < 2; ++b_)
#pragma unroll
        for (int i = 0; i < 8; ++i) zp[a_][b_][i] = 0u;
    for (int n3 = 0; n3 < 3; ++n3) {
      const bf16_t* X = (const bf16_t*)(p.ws + (n3 == 0 ? O_AQ : (n3 == 1 ? O_BQ : O_CQ)));
      f32x16 acc[2][2]; zero_acc(acc);
      gemm_mid(W + ((size_t)n3 * 1024 + nt_ * 128) * 512, 512, X, 512, 1 << 30, 64, 8, mt_ * 256, acc, sm);
#pragma unroll
      for (int mt = 0; mt < 2; ++mt) {
        const int m = mt_ * 256 + wm * 64 + mt * 32 + lr;
#pragma unroll
        for (int nt = 0; nt < 2; ++nt)
#pragma unroll
          for (int qd = 0; qd < 4; ++qd) {
            const int n = nt_ * 128 + wn * 64 + nt * 32 + 8 * qd + 4 * lh;
            const uint2 gq = *(const uint2*)(mgs + ((size_t)((n3 * 1024 + n) >> 2) * T_ + m) * 4);
            const unsigned z01 = zp[nt][mt][2 * qd], z23 = zp[nt][mt][2 * qd + 1];
            const float v0 = bf2f((bf16_t)(z01 & 0xffff)) + bf2f((bf16_t)(gq.x & 0xffff)) * acc[nt][mt][4 * qd];
            const float v1 = bf2f((bf16_t)(z01 >> 16)) + bf2f((bf16_t)(gq.x >> 16)) * acc[nt][mt][4 * qd + 1];
            const float v2 = bf2f((bf16_t)(z23 & 0xffff)) + bf2f((bf16_t)(gq.y & 0xffff)) * acc[nt][mt][4 * qd + 2];
            const float v3 = bf2f((bf16_t)(z23 >> 16)) + bf2f((bf16_t)(gq.y >> 16)) * acc[nt][mt][4 * qd + 3];
            zp[nt][mt][2 * qd] = pack2(v0, v1);
            zp[nt][mt][2 * qd + 1] = pack2(v2, v3);
          }
      }
    }
    bf16_t* stg = sm + wv * (64 * 72);
#pragma unroll
    for (int mt = 0; mt < 2; ++mt)
#pragma unroll
      for (int nt = 0; nt < 2; ++nt)
#pragma unroll
        for (int qd = 0; qd < 4; ++qd)
          *(uint2*)(stg + (mt * 32 + lr) * 72 + nt * 32 + 8 * qd + 4 * lh) = make_uint2(zp[nt][mt][2 * qd], zp[nt][mt][2 * qd + 1]);
#pragma unroll
    for (int it = 0; it < 8; ++it) {
      const int row = it * 8 + (lane >> 3), c16 = lane & 7;
      const u32x4 v = *(const u32x4*)(stg + row * 72 + c16 * 8);
      *(u32x4*)(z + (size_t)(mt_ * 256 + wm * 64 + row) * LDK1 + nt_ * 128 + wn * 64 + c16 * 8) = v;
    }
  }
}

DI void phase_resid(const P& p, const bf16_t* W, const bf16_t* X, int K, bf16_t* sm, const Geo& ge, bool last) {
  const int tid = tidx(), lane = tid & 63, wv = tid >> 6, wn = wv & 1, wm = wv >> 1;
  const int lr = lane & 31, lh = lane >> 5;
  bf16_t* xb = (bf16_t*)(p.ws + O_XB);
  float* part = (float*)(p.ws + O_PART);
  TileWalk tw(4, ge);
  int mt_, nt_;
  while (tw.next(mt_, nt_)) {
    f32x16 acc[4][2]; zero_acc8(acc);
    const int ldk = K + 64;
    gemm_wide(W + (size_t)nt_ * 256 * ldk, ldk, X + (size_t)mt_ * 256 * ldk, ldk, K / 64, acc, sm);
    float* stg = (float*)sm + wv * (64 * 68);
    const int m0w = mt_ * 256 + wm * 64, n0w = nt_ * 256 + wn * 128;
#pragma unroll
    for (int cp = 0; cp < 2; ++cp) {
#pragma unroll 4
      for (int it = 0; it < 8; ++it) {
        const int row = it * 8 + (lane >> 3), c8 = (lane & 7) * 8;
        const u32x4 raw = *(const u32x4*)(xb + (size_t)(m0w + row) * LDK1 + n0w + cp * 64 + c8);
        float* d = stg + row * 68 + c8;
        *(float4*)(d) = make_float4(__uint_as_float(raw[0] << 16), __uint_as_float(raw[0] & 0xffff0000u),
                                    __uint_as_float(raw[1] << 16), __uint_as_float(raw[1] & 0xffff0000u));
        *(float4*)(d + 4) = make_float4(__uint_as_float(raw[2] << 16), __uint_as_float(raw[2] & 0xffff0000u),
                                        __uint_as_float(raw[3] << 16), __uint_as_float(raw[3] & 0xffff0000u));
      }
#pragma unroll
      for (int mt = 0; mt < 2; ++mt) {
        float ss = 0.f;
#pragma unroll
        for (int nh = 0; nh < 2; ++nh)
#pragma unroll
          for (int qd = 0; qd < 4; ++qd) {
            const int nt = cp * 2 + nh;
            float4* sp = (float4*)(stg + (mt * 32 + lr) * 68 + nh * 32 + 8 * qd + 4 * lh);
            float4 v = *sp;
            v.x += acc[nt][mt][4 * qd]; v.y += acc[nt][mt][4 * qd + 1]; v.z += acc[nt][mt][4 * qd + 2]; v.w += acc[nt][mt][4 * qd + 3];
            *sp = v;
            ss += v.x * v.x + v.y * v.y + v.z * v.z + v.w * v.w;
          }
        ss += xor32(ss);
        if (lh == 0) part[(size_t)(m0w + mt * 32 + lr) * 16 + nt_ * 4 + wn * 2 + cp] = ss;
      }
#pragma unroll 4
      for (int it = 0; it < 16; ++it) {
        const int row = it * 4 + (lane >> 4), c4 = (lane & 15) * 4;
        const float4 v = *(const float4*)(stg + row * 68 + c4);
        if (last) *(float4*)(p.out + (size_t)(m0w + row) * 1024 + n0w + cp * 64 + c4) = v;
        *(uint2*)(xb + (size_t)(m0w + row) * LDK1 + n0w + cp * 64 + c4) = make_uint2(pack2(v.x, v.y), pack2(v.z, v.w));
      }
    }
  }
}

DI void phase_up(const P& p, int layer, bf16_t* sm, const Geo& ge) {
  const int tid = tidx(), lane = tid & 63, wv = tid >> 6, wn = wv & 1, wm = wv >> 1;
  const int lr = lane & 31, lh = lane >> 5;
  const bf16_t* W = (const bf16_t*)(p.ws + O_WUP + layer * SZ_WUP);
  const bf16_t* X = (const bf16_t*)(p.ws + O_XB);
  const float* part = (const float*)(p.ws + O_PART);
  bf16_t* u = (bf16_t*)(p.ws + O_U);
  TileWalk tw(16, ge);
  int mt_, nt_, mt_have = -1;
  float rs0 = 0.f, rs1 = 0.f;
  while (tw.next(mt_, nt_)) {
    if (mt_ != mt_have) {
      rs0 = row_rstd(part, mt_ * 256 + wm * 64 + lr);
      rs1 = row_rstd(part, mt_ * 256 + wm * 64 + 32 + lr);
      mt_have = mt_;
    }
    f32x16 acc[4][2]; zero_acc8(acc);
    gemm_wide(W + (size_t)nt_ * 256 * LDK1, LDK1, X + (size_t)mt_ * 256 * LDK1, LDK1, 16, acc, sm);
    bf16_t* stg = sm + wv * (64 * 136);
#pragma unroll
    for (int mt = 0; mt < 2; ++mt) {
      const float rs = mt ? rs1 : rs0;
#pragma unroll
      for (int nt = 0; nt < 4; ++nt)
#pragma unroll
        for (int qd = 0; qd < 4; ++qd) {
          const int n = nt_ * 256 + wn * 128 + nt * 32 + 8 * qd + 4 * lh;
          float a = fmaxf(acc[nt][mt][4 * qd] * rs, 0.f), b = fmaxf(acc[nt][mt][4 * qd + 1] * rs, 0.f);
          float c = fmaxf(acc[nt][mt][4 * qd + 2] * rs, 0.f), d = fmaxf(acc[nt][mt][4 * qd + 3] * rs, 0.f);
          *(uint2*)(stg + (mt * 32 + lr) * 136 + nt * 32 + 8 * qd + 4 * lh) = make_uint2(pack2(a * a, b * b), pack2(c * c, d * d));
        }
    }
    stage_rows_store(stg, u + nt_ * 256 + wn * 128, LDK4, mt_ * 256 + wm * 64);
  }
}

DI unsigned xcc_id() { return (unsigned)__builtin_amdgcn_s_getreg((3 << 11) | 20) & 0xFu; }
struct BarCtx { unsigned* base; unsigned xcc, xcnt, nxcc, gen; };
DI void gbar(BarCtx& c) {
  ++c.gen;
  asm volatile("s_waitcnt vmcnt(0) lgkmcnt(0)" ::: "memory");
  __syncthreads();
  if (threadIdx.x == 0) {
    const unsigned old = __hip_atomic_fetch_add(c.base + (16 + c.xcc) * 32, 1u, __ATOMIC_RELAXED, __HIP_MEMORY_SCOPE_AGENT);
    if (old % c.xcnt == c.xcnt - 1) {
      __builtin_amdgcn_fence(__ATOMIC_RELEASE, "agent");
      asm volatile("s_waitcnt vmcnt(0)" ::: "memory");
      const unsigned t = __hip_atomic_fetch_add(c.base + 32 * 32, 1u, __ATOMIC_RELAXED, __HIP_MEMORY_SCOPE_AGENT);
      if (t % c.nxcc == c.nxcc - 1) {
        for (unsigned i = 0; i < 16; ++i)
          __hip_atomic_store(c.base + (33 + i) * 32, c.gen, __ATOMIC_RELAXED, __HIP_MEMORY_SCOPE_AGENT);
      }
    }
    while (__hip_atomic_load(c.base + (33 + c.xcc) * 32, __ATOMIC_RELAXED, __HIP_MEMORY_SCOPE_AGENT) < c.gen) __builtin_amdgcn_s_sleep(1);
    __builtin_amdgcn_fence(__ATOMIC_ACQUIRE, "agent");
    asm volatile("s_waitcnt vmcnt(0)" ::: "memory");
  }
  __syncthreads();
}

__global__ void __launch_bounds__(512, 2) mega(P p) {
  extern __shared__ __attribute__((aligned(16))) unsigned char smraw[];
  bf16_t* sm = (bf16_t*)smraw;
  cg::grid_group grid = cg::this_grid();
  if (threadIdx.x == 0)
    ((unsigned*)smraw)[0] = __hip_atomic_fetch_add((unsigned*)(p.ws + O_BAR) + xcc_id() * 32, 1u, __ATOMIC_RELAXED, __HIP_MEMORY_SCOPE_AGENT);
  __syncthreads();
  const unsigned my_rank = (unsigned)__builtin_amdgcn_readfirstlane((int)((volatile unsigned*)smraw)[0]);
  __syncthreads();
#ifndef PHMASK
#define PHMASK 0xff
#endif
  if (PHMASK & 1) phase0(p, sm);
  grid.sync();
  BarCtx bc;
  bc.base = (unsigned*)(p.ws + O_BAR); bc.xcc = xcc_id(); bc.gen = 0;
  bc.xcnt = (unsigned)__builtin_amdgcn_readfirstlane((int)__hip_atomic_load(bc.base + bc.xcc * 32, __ATOMIC_RELAXED, __HIP_MEMORY_SCOPE_AGENT));
  bc.nxcc = 0;
  for (unsigned i = 0; i < 16; ++i) bc.nxcc += __hip_atomic_load(bc.base + i * 32, __ATOMIC_RELAXED, __HIP_MEMORY_SCOPE_AGENT) ? 1u : 0u;
  bc.nxcc = (unsigned)__builtin_amdgcn_readfirstlane((int)bc.nxcc);
  unsigned hi_cnt = 0;
  for (unsigned i = 8; i < 16; ++i) hi_cnt += __hip_atomic_load(bc.base + i * 32, __ATOMIC_RELAXED, __HIP_MEMORY_SCOPE_AGENT);
  hi_cnt = (unsigned)__builtin_amdgcn_readfirstlane((int)hi_cnt);
  Geo ge;
  if (bc.nxcc == 8 && hi_cnt == 0) { ge.xcd = (int)bc.xcc; ge.loc = (int)my_rank; ge.nloc = (int)bc.xcnt; }
  else { ge.xcd = blockIdx.x & 7; ge.loc = blockIdx.x >> 3; ge.nloc = gridDim.x >> 3; }
  unsigned* qheads = bc.base + 64 * 32;
  for (int layer = 0; layer < NL; ++layer) {
    if (PHMASK & 2) phase_inproj(p, layer, sm, ge);
    gbar(bc);
    phase23(p, layer, sm, qheads + (layer * 2) * 32, qheads + (layer * 2 + 1) * 32);
    gbar(bc);
    if (PHMASK & 16) phase_merge(p, layer, sm, ge);
    gbar(bc);
    if (PHMASK & 32) phase_resid(p, (const bf16_t*)(p.ws + O_WO + layer * SZ_WO), (const bf16_t*)(p.ws + O_Z), 1024, sm, ge, false);
    gbar(bc);
    if (PHMASK & 64) phase_up(p, layer, sm, ge);
    gbar(bc);
    if (PHMASK & 128) phase_resid(p, (const bf16_t*)(p.ws + O_WDN + layer * SZ_WDN), (const bf16_t*)(p.ws + O_U), 4096, sm, ge, layer == NL - 1);
    gbar(bc);
  }
}

extern "C" void kernel_launch(void* const* d_in, const int* in_sizes, int n_in, void* d_out, int out_size, void* d_ws,
                              size_t ws_size, hipStream_t stream) {
  static int grid_blocks = 0;
  if (!grid_blocks) {
    int dev = 0, cus = 0, per_cu = 0;
    (void)hipGetDevice(&dev);
    (void)hipDeviceGetAttribute(&cus, hipDeviceAttributeMultiprocessorCount, dev);
    (void)hipFuncSetAttribute((const void*)mega, hipFuncAttributeMaxDynamicSharedMemorySize, LDS_BYTES);
    (void)hipOccupancyMaxActiveBlocksPerMultiprocessor(&per_cu, (const void*)mega, NTHR, LDS_BYTES);
    if (per_cu < 1) per_cu = 1;
    if (per_cu > 1) per_cu = 1;
    grid_blocks = cus * per_cu;
    if (ws_size < WS_END) fprintf(stderr, "workspace too small: %zu < %zu\n", ws_size, (size_t)WS_END);
  }
  P p{};
  p.x = (const float*)d_in[0]; p.w_in = (const float*)d_in[1]; p.qk_gain = (const float*)d_in[2];
  p.diff_lambda = (const float*)d_in[3]; p.diff_subln = (const float*)d_in[4]; p.sinks = (const float*)d_in[5];
  p.cmp_pos = (const float*)d_in[6]; p.cmp_w1 = (const float*)d_in[7]; p.cmp_w2 = (const float*)d_in[8];
  p.w_branch = (const float*)d_in[9]; p.w_out = (const float*)d_in[10]; p.norm_mix = (const float*)d_in[11];
  p.norm_mlp = (const float*)d_in[12]; p.w_up = (const float*)d_in[13]; p.w_down = (const float*)d_in[14];
  p.rel_bias = (const float*)d_in[15];
  p.out = (float*)d_out; p.ws = (unsigned char*)d_ws;
  (void)hipMemsetAsync((unsigned char*)d_ws + O_BAR, 0, 80 * 128, stream);
  void* args[] = {&p};
  hipError_t e = hipLaunchCooperativeKernel((const void*)mega, dim3(grid_blocks), dim3(NTHR), args, LDS_BYTES, stream);
  if (e != hipSuccess) fprintf(stderr, "cooperative launch failed: %s (grid %d)\n", hipGetErrorString(e), grid_blocks);
}
```

```cpp
#include <hip/hip_runtime.h>
#include <hip/hip_cooperative_groups.h>
#include <cstdio>
namespace cg = cooperative_groups;

typedef unsigned short bf16_t;
using bf16x8 = __attribute__((ext_vector_type(8))) short;
using f32x16 = __attribute__((ext_vector_type(16))) float;
using u32x4 = __attribute__((ext_vector_type(4))) unsigned;
#define DI __device__ __forceinline__
#define MFMA32(a, b, c) __builtin_amdgcn_mfma_f32_32x32x16_bf16((a), (b), (c), 0, 0, 0)

constexpr int S_ = 4096, T_ = 16384, NL = 4;
constexpr int NIN = 6680, NINP = 6912;
constexpr int LDS_BYTES = 147456;
constexpr int NTHR = 512;
constexpr int LDT = 72;
constexpr int LDK1 = 1088, LDK4 = 4160;
constexpr int WT_E = 256 * LDT;

constexpr size_t SZ_WIN = (size_t)NINP * LDK1 * 2;
constexpr size_t SZ_WBR = (size_t)3 * 1024 * 512 * 2;
constexpr size_t SZ_WO = (size_t)1024 * LDK1 * 2;
constexpr size_t SZ_WUP = (size_t)4096 * LDK1 * 2;
constexpr size_t SZ_WDN = (size_t)1024 * LDK4 * 2;
constexpr size_t SZ_W1 = (size_t)2 * 256 * 2048 * 2;
constexpr size_t SZ_W2 = (size_t)2 * 128 * 256 * 2;
constexpr size_t O_WIN = 0;
constexpr size_t O_WBR = O_WIN + NL * SZ_WIN;
constexpr size_t O_WO = O_WBR + NL * SZ_WBR;
constexpr size_t O_WUP = O_WO + NL * SZ_WO;
constexpr size_t O_WDN = O_WUP + NL * SZ_WUP;
constexpr size_t O_W1 = O_WDN + NL * SZ_WDN;
constexpr size_t O_W2 = O_W1 + NL * SZ_W1;
constexpr size_t O_POSW1 = O_W2 + NL * SZ_W2;
constexpr size_t O_LAM = O_POSW1 + (size_t)NL * 2 * 4 * 256 * 4;
constexpr size_t O_TABS = O_LAM + 256;
constexpr size_t O_PART = O_TABS + 20 * 132 * 4 + 192;
constexpr size_t O_XB = ((O_PART + (size_t)T_ * 16 * 4 + 255) / 256) * 256;
constexpr size_t O_ACT = O_XB + (size_t)T_ * LDK1 * 2;
constexpr size_t O_AQ = O_ACT;
constexpr size_t O_BQ = O_AQ + (size_t)T_ * 512 * 2;
constexpr size_t O_CQ = O_BQ + (size_t)T_ * 512 * 2;
constexpr size_t O_AK = O_CQ + (size_t)T_ * 512 * 2;
constexpr size_t O_AVT = O_AK + (size_t)T_ * 512 * 2;
constexpr size_t O_Z = O_AK;
constexpr size_t O_BK = O_AVT + (size_t)T_ * 512 * 2;
constexpr size_t SZ_S = (size_t)T_ * 128 * 2;
constexpr size_t O_BVT = O_BK + SZ_S;
constexpr size_t O_CK = O_BVT + SZ_S;
constexpr size_t O_CV = O_CK + SZ_S;
constexpr size_t O_KS = O_CV + SZ_S + 65536;
constexpr size_t O_VST = O_KS + SZ_S;
constexpr size_t O_KW = O_VST + SZ_S;
constexpr size_t O_VWT = O_KW + SZ_S;
constexpr size_t O_CGS = O_VWT + SZ_S;
constexpr size_t O_MGS = O_CGS + (size_t)T_ * 24 * 4;
constexpr size_t O_HID = O_MGS + (size_t)T_ * 3072 * 2;
constexpr size_t O_KC = O_HID + (size_t)16 * 256 * 256 * 2;
constexpr size_t O_VCT = O_KC + (size_t)8 * 256 * 64 * 2;
constexpr size_t O_U = O_ACT;
constexpr size_t O_BAR = O_VCT + (size_t)8 * 256 * 64 * 2;
constexpr size_t WS_END = O_BAR + 80 * 128;
static_assert(O_Z + (size_t)T_ * LDK1 * 2 <= O_CGS && O_U + (size_t)T_ * LDK4 * 2 <= O_HID, "u must fit in the aliased region");

struct P {
  const float* x; const float* w_in; const float* qk_gain; const float* diff_lambda; const float* diff_subln;
  const float* sinks; const float* cmp_pos; const float* cmp_w1; const float* cmp_w2; const float* w_branch;
  const float* w_out; const float* norm_mix; const float* norm_mlp; const float* w_up; const float* w_down;
  const float* rel_bias;
  float* out; unsigned char* ws;
};

DI int tidx() { int t = threadIdx.x; asm volatile("" : "+v"(t)); return t; }
DI bf16_t f2bf(float x) { unsigned u = __float_as_uint(x); u += 0x7fffu + ((u >> 16) & 1u); return (bf16_t)(u >> 16); }
DI float bf2f(bf16_t b) { return __uint_as_float(((unsigned)b) << 16); }
typedef float f32x2_t __attribute__((ext_vector_type(2)));
typedef __bf16 bf16x2_t __attribute__((ext_vector_type(2)));
DI unsigned pack2(float a, float b) { f32x2_t v = {a, b}; bf16x2_t r = __builtin_convertvector(v, bf16x2_t); return __builtin_bit_cast(unsigned, r); }
constexpr float LOG2E = 1.4426950408889634f;
constexpr float QSCL = 0.125f * LOG2E;
DI float ex2(float x) { return __builtin_amdgcn_exp2f(x); }
DI float sigmoidf_(float x) { return __builtin_amdgcn_rcpf(1.f + ex2(-LOG2E * x)); }
DI float xor32(float v) { return __shfl_xor(v, 32); }

DI void gemm_wide(const bf16_t* __restrict__ W, int ldw, const bf16_t* __restrict__ X, int ldx, int nkt,
                  f32x16 (&acc)[4][2], bf16_t* lds) {
  const int tid = tidx(), lane = tid & 63, wv = tid >> 6, wn = wv & 1, wm = wv >> 1;
  const int lr = lane & 31, lh = lane >> 5;
  const int lrow = tid >> 3, lkc = (tid & 7) * 8;
  const bf16_t* wp = W + (size_t)lrow * ldw + lkc;
  const bf16_t* xp = X + (size_t)lrow * ldx + lkc;
  const size_t wst = (size_t)64 * ldw, xst = (size_t)64 * ldx;
  u32x4 rw0, rw1, rw2, rw3, rx0, rx1, rx2, rx3;
#define GW_GLOAD(KT) { const size_t ko_ = (size_t)(KT) * 64; \
    rw0 = *(const u32x4*)(wp + ko_); rw1 = *(const u32x4*)(wp + wst + ko_); \
    rw2 = *(const u32x4*)(wp + 2 * wst + ko_); rw3 = *(const u32x4*)(wp + 3 * wst + ko_); \
    rx0 = *(const u32x4*)(xp + ko_); rx1 = *(const u32x4*)(xp + xst + ko_); \
    rx2 = *(const u32x4*)(xp + 2 * xst + ko_); rx3 = *(const u32x4*)(xp + 3 * xst + ko_); }
#define GW_LSTORE(BUF) { bf16_t* wb_ = lds + (BUF) * 2 * WT_E + lrow * LDT + lkc; bf16_t* xb_ = wb_ + WT_E; \
    *(u32x4*)(wb_) = rw0; *(u32x4*)(wb_ + 64 * LDT) = rw1; *(u32x4*)(wb_ + 128 * LDT) = rw2; *(u32x4*)(wb_ + 192 * LDT) = rw3; \
    *(u32x4*)(xb_) = rx0; *(u32x4*)(xb_ + 64 * LDT) = rx1; *(u32x4*)(xb_ + 128 * LDT) = rx2; *(u32x4*)(xb_ + 192 * LDT) = rx3; }
  u32x4 sw0, sw1, sw2, sw3, sx0, sx1, sx2, sx3;
#define GW_GLOAD_B(KT) { const size_t ko_ = (size_t)(KT) * 64; \
    sw0 = *(const u32x4*)(wp + ko_); sw1 = *(const u32x4*)(wp + wst + ko_); \
    sw2 = *(const u32x4*)(wp + 2 * wst + ko_); sw3 = *(const u32x4*)(wp + 3 * wst + ko_); \
    sx0 = *(const u32x4*)(xp + ko_); sx1 = *(const u32x4*)(xp + xst + ko_); \
    sx2 = *(const u32x4*)(xp + 2 * xst + ko_); sx3 = *(const u32x4*)(xp + 3 * xst + ko_); }
#define GW_LSTORE_B(BUF) { bf16_t* wb_ = lds + (BUF) * 2 * WT_E + lrow * LDT + lkc; bf16_t* xb_ = wb_ + WT_E; \
    *(u32x4*)(wb_) = sw0; *(u32x4*)(wb_ + 64 * LDT) = sw1; *(u32x4*)(wb_ + 128 * LDT) = sw2; *(u32x4*)(wb_ + 192 * LDT) = sw3; \
    *(u32x4*)(xb_) = sx0; *(u32x4*)(xb_ + 64 * LDT) = sx1; *(u32x4*)(xb_ + 128 * LDT) = sx2; *(u32x4*)(xb_ + 192 * LDT) = sx3; }
#define GW_KS(KT, ks) { \
      const bf16_t* wb = lds + ((KT) & 1) * 2 * WT_E + (wn * 128 + lr) * LDT + lh * 8; \
      const bf16_t* xb = lds + ((KT) & 1) * 2 * WT_E + WT_E + (wm * 64 + lr) * LDT + lh * 8; \
      const bf16x8 b0 = *(const bf16x8*)(xb + (ks) * 16), b1 = *(const bf16x8*)(xb + 32 * LDT + (ks) * 16); \
      const bf16x8 a0 = *(const bf16x8*)(wb + (ks) * 16), a1 = *(const bf16x8*)(wb + 32 * LDT + (ks) * 16); \
      const bf16x8 a2 = *(const bf16x8*)(wb + 64 * LDT + (ks) * 16), a3 = *(const bf16x8*)(wb + 96 * LDT + (ks) * 16); \
      acc[0][0] = MFMA32(a0, b0, acc[0][0]); acc[0][1] = MFMA32(a0, b1, acc[0][1]); \
      acc[1][0] = MFMA32(a1, b0, acc[1][0]); acc[1][1] = MFMA32(a1, b1, acc[1][1]); \
      acc[2][0] = MFMA32(a2, b0, acc[2][0]); acc[2][1] = MFMA32(a2, b1, acc[2][1]); \
      acc[3][0] = MFMA32(a3, b0, acc[3][0]); acc[3][1] = MFMA32(a3, b1, acc[3][1]); }
#define GW_ST2(BUF, OFF, R0, R1) { bf16_t* d_ = lds + (BUF) * 2 * WT_E + (OFF) + lrow * LDT + lkc; \
      *(u32x4*)(d_) = R0; *(u32x4*)(d_ + 64 * LDT) = R1; }
  __syncthreads();
  GW_GLOAD(0)
  GW_LSTORE(0)
  GW_GLOAD(1)
  GW_GLOAD_B(nkt > 2 ? 2 : nkt - 1)
  __syncthreads();
  for (int kt = 0; kt < nkt; kt += 2) {
    __builtin_amdgcn_sched_barrier(0);
    GW_ST2(1, 0, rw0, rw1)                         GW_KS(kt, 0)
    GW_ST2(1, 128 * LDT, rw2, rw3)                 GW_KS(kt, 1)
    GW_ST2(1, WT_E, rx0, rx1)                      GW_KS(kt, 2)
    GW_ST2(1, WT_E + 128 * LDT, rx2, rx3)          GW_KS(kt, 3)
    __builtin_amdgcn_sched_barrier(0);
    GW_GLOAD(kt + 3 < nkt ? kt + 3 : nkt - 1)
    __syncthreads();
    __builtin_amdgcn_sched_barrier(0);
    GW_ST2(0, 0, sw0, sw1)                         GW_KS(kt + 1, 0)
    GW_ST2(0, 128 * LDT, sw2, sw3)                 GW_KS(kt + 1, 1)
    GW_ST2(0, WT_E, sx0, sx1)                      GW_KS(kt + 1, 2)
    GW_ST2(0, WT_E + 128 * LDT, sx2, sx3)          GW_KS(kt + 1, 3)
    __builtin_amdgcn_sched_barrier(0);
    GW_GLOAD_B(kt + 4 < nkt ? kt + 4 : nkt - 1)
    __syncthreads();
  }
#undef GW_KS
#undef GW_ST2
#undef GW_GLOAD_B
#undef GW_LSTORE_B
#undef GW_GLOAD
#undef GW_LSTORE
}

constexpr int MID_E = (128 + 256) * LDT;
DI void gemm_mid(const bf16_t* __restrict__ W, int ldw, const bf16_t* __restrict__ X, size_t ldx, int mclamp, int kts,
                 int nkt, int m0, f32x16 (&acc)[2][2], bf16_t* lds) {
  const int tid = tidx(), lane = tid & 63, wv = tid >> 6, wn = wv & 1, wm = wv >> 1;
  const int lr = lane & 31, lh = lane >> 5;
  const int lrow = tid >> 3, lkc = (tid & 7) * 8;
  const bf16_t* wp = W + (size_t)lrow * ldw + lkc;
  const size_t wst = (size_t)64 * ldw;
  const bf16_t *xp0, *xp1, *xp2, *xp3;
  { int m;
    m = m0 + lrow;       m = m < mclamp ? m : mclamp; xp0 = X + (size_t)m * ldx + lkc;
    m = m0 + lrow + 64;  m = m < mclamp ? m : mclamp; xp1 = X + (size_t)m * ldx + lkc;
    m = m0 + lrow + 128; m = m < mclamp ? m : mclamp; xp2 = X + (size_t)m * ldx + lkc;
    m = m0 + lrow + 192; m = m < mclamp ? m : mclamp; xp3 = X + (size_t)m * ldx + lkc; }
  u32x4 rw0, rw1, rx0, rx1, rx2, rx3;
#define GM_GLOAD(KT) { \
    rw0 = *(const u32x4*)(wp + (size_t)(KT) * 64); rw1 = *(const u32x4*)(wp + wst + (size_t)(KT) * 64); \
    rx0 = *(const u32x4*)(xp0 + (size_t)(KT) * kts); rx1 = *(const u32x4*)(xp1 + (size_t)(KT) * kts); \
    rx2 = *(const u32x4*)(xp2 + (size_t)(KT) * kts); rx3 = *(const u32x4*)(xp3 + (size_t)(KT) * kts); }
#define GM_LSTORE(BUF) { bf16_t* wb_ = lds + (BUF) * MID_E + lrow * LDT + lkc; bf16_t* xb_ = wb_ + 128 * LDT; \
    *(u32x4*)(wb_) = rw0; *(u32x4*)(wb_ + 64 * LDT) = rw1; \
    *(u32x4*)(xb_) = rx0; *(u32x4*)(xb_ + 64 * LDT) = rx1; *(u32x4*)(xb_ + 128 * LDT) = rx2; *(u32x4*)(xb_ + 192 * LDT) = rx3; }
  __syncthreads();
  GM_GLOAD(0)
  GM_LSTORE(0)
  __syncthreads();
  for (int kt = 0; kt < nkt; ++kt) {
    const bool more = kt + 1 < nkt;
    if (more) GM_GLOAD(kt + 1)
    __builtin_amdgcn_sched_barrier(0);
    {
      const bf16_t* wb = lds + (kt & 1) * MID_E + (wn * 64 + lr) * LDT + lh * 8;
      const bf16_t* xb = lds + (kt & 1) * MID_E + 128 * LDT + (wm * 64 + lr) * LDT + lh * 8;
#pragma unroll
      for (int ks = 0; ks < 4; ++ks) {
        const bf16x8 a0 = *(const bf16x8*)(wb + ks * 16), a1 = *(const bf16x8*)(wb + 32 * LDT + ks * 16);
        const bf16x8 b0 = *(const bf16x8*)(xb + ks * 16), b1 = *(const bf16x8*)(xb + 32 * LDT + ks * 16);
        acc[0][0] = MFMA32(a0, b0, acc[0][0]); acc[0][1] = MFMA32(a0, b1, acc[0][1]);
        acc[1][0] = MFMA32(a1, b0, acc[1][0]); acc[1][1] = MFMA32(a1, b1, acc[1][1]);
      }
    }
    __builtin_amdgcn_sched_barrier(0);
    if (more) GM_LSTORE((kt + 1) & 1)
    __syncthreads();
  }
#undef GM_GLOAD
#undef GM_LSTORE
}

DI void zero_acc(f32x16 (&acc)[2][2]) {
#pragma unroll
  for (int a = 0; a < 2; ++a)
#pragma unroll
    for (int b = 0; b < 2; ++b)
#pragma unroll
      for (int i = 0; i < 16; ++i) acc[a][b][i] = 0.f;
}
DI void zero_acc8(f32x16 (&acc)[4][2]) {
#pragma unroll
  for (int a = 0; a < 4; ++a)
#pragma unroll
    for (int b = 0; b < 2; ++b)
#pragma unroll
      for (int i = 0; i < 16; ++i) acc[a][b][i] = 0.f;
}

DI const float* tile_rstd(const float* __restrict__ part, int m0, bf16_t* sm) {
  float* rs = (float*)((unsigned char*)sm + 139264);
  const int tid = tidx();
  if (tid < 256) {
    const float4* p4 = (const float4*)(part + (size_t)(m0 + tid) * 16);
    float s = 0.f;
#pragma unroll
    for (int i = 0; i < 4; ++i) { float4 v = p4[i]; s += v.x + v.y + v.z + v.w; }
    rs[tid] = rsqrtf(s * (1.f / 1024.f) + 1e-6f);
  }
  __syncthreads();
  return rs;
}
DI float row_rstd(const float* __restrict__ part, int m) {
  const float4* p4 = (const float4*)(part + (size_t)m * 16);
  float s = 0.f;
#pragma unroll
  for (int i = 0; i < 4; ++i) { float4 v = p4[i]; s += v.x + v.y + v.z + v.w; }
  return rsqrtf(s * (1.f / 1024.f) + 1e-6f);
}

struct Geo { int xcd, loc, nloc; };
struct TileWalk {
  int xcd, loc, nloc, ng, NT, g, i;
  DI TileWalk(int NT_, const Geo& ge) : xcd(ge.xcd), loc(ge.loc), nloc(ge.nloc), ng((NT_ + 7) >> 3), NT(NT_), g(0), i(ge.loc) {}
  DI bool next(int& mt, int& nt) {
    for (;;) {
      if (g >= ng) return false;
      if (i >= 64) { i = loc; ++g; continue; }
      mt = xcd * 8 + (i & 7); nt = g * 8 + (i >> 3);
      i += nloc;
      if (nt < NT) return true;
    }
  }
};

DI int next_task(unsigned* ctr, bf16_t* sm) {
  volatile int* slot = (volatile int*)((unsigned char*)sm + LDS_BYTES - 16);
  __syncthreads();
  if (threadIdx.x == 0) *slot = (int)__hip_atomic_fetch_add(ctr, 1u, __ATOMIC_RELAXED, __HIP_MEMORY_SCOPE_AGENT);
  __syncthreads();
  return __builtin_amdgcn_readfirstlane(*slot);
}

DI void tr_tile(const float* __restrict__ src, int ldS, int C, int r0, int c0, bf16_t* __restrict__ dst, int ldd,
                const float* __restrict__ g, int remap, float* tl) {
  const int tid = tidx() & 255;
  __syncthreads();
  {
    const int c4 = (tid & 15) * 4;
#pragma unroll
    for (int i = 0; i < 4; ++i) {
      const int r = (tid >> 4) + 16 * i;
      float4 v = make_float4(0.f, 0.f, 0.f, 0.f);
      if (c0 + c4 < C) {
        v = *(const float4*)(src + (size_t)(r0 + r) * ldS + c0 + c4);
        if (g) { const float gg = g[r0 + r]; v.x *= gg; v.y *= gg; v.z *= gg; v.w *= gg; }
      }
      float* t4 = tl + r * 65 + c4;
      t4[0] = v.x; t4[1] = v.y; t4[2] = v.z; t4[3] = v.w;
    }
  }
  __syncthreads();
  {
    const int c = tid >> 2, rq = (tid & 3) * 16;
    if (c0 + c < C) {
      int dr = c0 + c;
      if (remap) { if (dr >= 3608) dr -= 24; else if (dr >= 3584) dr += 6656 - 3584; }
      unsigned w[8];
#pragma unroll
      for (int k = 0; k < 8; ++k) w[k] = pack2(tl[(rq + 2 * k) * 65 + c], tl[(rq + 2 * k + 1) * 65 + c]);
      uint4* d4 = (uint4*)(dst + (size_t)dr * ldd + r0 + rq);
      d4[0] = make_uint4(w[0], w[1], w[2], w[3]);
      d4[1] = make_uint4(w[4], w[5], w[6], w[7]);
    }
  }
}

DI void tr_tile_wave(const float* __restrict__ src, int ldS, int C, int r0, int c0, bf16_t* __restrict__ dst, int ldd,
                     const float* __restrict__ g, int remap, float* tl) {
  const int lane = tidx() & 63;
  {
    const int c4 = (lane & 15) * 4;
    float4 v[16];
#pragma unroll
    for (int i = 0; i < 16; ++i) {
      const int r = (lane >> 4) + 4 * i;
      v[i] = make_float4(0.f, 0.f, 0.f, 0.f);
      if (c0 + c4 < C) v[i] = *(const float4*)(src + (size_t)(r0 + r) * ldS + c0 + c4);
    }
#pragma unroll
    for (int i = 0; i < 16; ++i) {
      const int r = (lane >> 4) + 4 * i;
      const float gg = g ? g[r0 + r] : 1.f;
      float* t4 = tl + r * 65 + c4;
      t4[0] = v[i].x * gg; t4[1] = v[i].y * gg; t4[2] = v[i].z * gg; t4[3] = v[i].w * gg;
    }
  }
  __builtin_amdgcn_fence(__ATOMIC_RELEASE, "wavefront");
  __builtin_amdgcn_wave_barrier();
#pragma unroll
  for (int j = 0; j < 4; ++j) {
    const int c = (lane >> 2) + 16 * j, rq = (lane & 3) * 16;
    if (c0 + c < C) {
      int dr = c0 + c;
      if (remap) { if (dr >= 3608) dr -= 24; else if (dr >= 3584) dr += 6656 - 3584; }
      unsigned w[8];
#pragma unroll
      for (int k = 0; k < 8; ++k) w[k] = pack2(tl[(rq + 2 * k) * 65 + c], tl[(rq + 2 * k + 1) * 65 + c]);
      uint4* d4 = (uint4*)(dst + (size_t)dr * ldd + r0 + rq);
      d4[0] = make_uint4(w[0], w[1], w[2], w[3]);
      d4[1] = make_uint4(w[4], w[5], w[6], w[7]);
    }
  }
  __builtin_amdgcn_wave_barrier();
}

DI void phase0(const P& p, bf16_t* sm) {
  const int tid5 = tidx(), half = tid5 >> 8, tid = tid5 & 255, lane = tid5 & 63, wv8 = tid5 >> 6;
  float* tl = (float*)sm + half * (64 * 65);
  constexpr int NTR_L = 1680 + 384 + 256 + 1024 + 1024 + 256 + 8;
  {
    float* tlw = (float*)sm + wv8 * (64 * 65);
    for (int t = blockIdx.x * 8 + wv8; t < NTR_L * NL; t += gridDim.x * 8) {
      const int layer = t / NTR_L; int r = t % NTR_L;
      if (r < 1680) {
        tr_tile_wave(p.w_in + (size_t)layer * 1024 * NIN, NIN, NIN, (r / 105) * 64, (r % 105) * 64,
                     (bf16_t*)(p.ws + O_WIN + layer * SZ_WIN), LDK1, p.norm_mix + layer * 1024, 1, tlw);
      } else if ((r -= 1680) < 384) {
        const int n3 = r / 128; r %= 128;
        tr_tile_wave(p.w_branch + ((size_t)layer * 3 + n3) * 512 * 1024, 1024, 1024, (r / 16) * 64, (r % 16) * 64,
                     (bf16_t*)(p.ws + O_WBR + layer * SZ_WBR) + (size_t)n3 * 1024 * 512, 512, nullptr, 0, tlw);
      } else if ((r -= 384) < 256) {
        tr_tile_wave(p.w_out + (size_t)layer * 1024 * 1024, 1024, 1024, (r / 16) * 64, (r % 16) * 64,
                     (bf16_t*)(p.ws + O_WO + layer * SZ_WO), LDK1, nullptr, 0, tlw);
      } else if ((r -= 256) < 1024) {
        tr_tile_wave(p.w_up + (size_t)layer * 1024 * 4096, 4096, 4096, (r / 64) * 64, (r % 64) * 64,
                     (bf16_t*)(p.ws + O_WUP + layer * SZ_WUP), LDK1, p.norm_mlp + layer * 1024, 0, tlw);
      } else if ((r -= 1024) < 1024) {
        tr_tile_wave(p.w_down + (size_t)layer * 4096 * 1024, 1024, 1024, (r / 16) * 64, (r % 16) * 64,
                     (bf16_t*)(p.ws + O_WDN + layer * SZ_WDN), LDK4, nullptr, 0, tlw);
      } else if ((r -= 1024) < 256) {
        const int kv = r / 128; r %= 128;
        tr_tile_wave(p.cmp_w1 + ((size_t)layer * 2 + kv) * 2048 * 256, 256, 256, (r / 4) * 64, (r % 4) * 64,
                     (bf16_t*)(p.ws + O_W1 + layer * SZ_W1) + (size_t)kv * 256 * 2048, 2048, nullptr, 0, tlw);
      } else {
        r -= 256;
        const int kv = r / 4; r %= 4;
        tr_tile_wave(p.cmp_w2 + ((size_t)layer * 2 + kv) * 256 * 64, 64, 64, r * 64, 0,
                     (bf16_t*)(p.ws + O_W2 + layer * SZ_W2) + (size_t)kv * 128 * 256, 256, nullptr, 0, tlw);
      }
    }
    __syncthreads();
  }
  constexpr int J_TR = 0;
  constexpr int J_X = J_TR + T_ / 8;
  constexpr int J_POS = J_X + 256;
  constexpr int J_MISC = J_POS + 1;
  constexpr int ZW_PER = ((NINP - NIN) * LDK1 / 8 + 511) / 512;
  constexpr int J_ZW = J_MISC + NL * ZW_PER;
  constexpr int J_ZW2 = J_ZW + 32;
  for (int job = blockIdx.x; job < J_ZW2; job += gridDim.x) {
    if (job < J_TR) {
      const int t = job * 2 + half;
      const int layer = t / NTR_L; int r = t % NTR_L;
      if (r < 1680) {
        tr_tile(p.w_in + (size_t)layer * 1024 * NIN, NIN, NIN, (r / 105) * 64, (r % 105) * 64,
                (bf16_t*)(p.ws + O_WIN + layer * SZ_WIN), LDK1, p.norm_mix + layer * 1024, 1, tl);
      } else if ((r -= 1680) < 384) {
        const int n3 = r / 128; r %= 128;
        tr_tile(p.w_branch + ((size_t)layer * 3 + n3) * 512 * 1024, 1024, 1024, (r / 16) * 64, (r % 16) * 64,
                (bf16_t*)(p.ws + O_WBR + layer * SZ_WBR) + (size_t)n3 * 1024 * 512, 512, nullptr, 0, tl);
      } else if ((r -= 384) < 256) {
        tr_tile(p.w_out + (size_t)layer * 1024 * 1024, 1024, 1024, (r / 16) * 64, (r % 16) * 64,
                (bf16_t*)(p.ws + O_WO + layer * SZ_WO), LDK1, nullptr, 0, tl);
      } else if ((r -= 256) < 1024) {
        tr_tile(p.w_up + (size_t)layer * 1024 * 4096, 4096, 4096, (r / 64) * 64, (r % 64) * 64,
                (bf16_t*)(p.ws + O_WUP + layer * SZ_WUP), LDK1, p.norm_mlp + layer * 1024, 0, tl);
      } else if ((r -= 1024) < 1024) {
        tr_tile(p.w_down + (size_t)layer * 4096 * 1024, 1024, 1024, (r / 16) * 64, (r % 16) * 64,
                (bf16_t*)(p.ws + O_WDN + layer * SZ_WDN), LDK4, nullptr, 0, tl);
      } else if ((r -= 1024) < 256) {
        const int kv = r / 128; r %= 128;
        tr_tile(p.cmp_w1 + ((size_t)layer * 2 + kv) * 2048 * 256, 256, 256, (r / 4) * 64, (r % 4) * 64,
                (bf16_t*)(p.ws + O_W1 + layer * SZ_W1) + (size_t)kv * 256 * 2048, 2048, nullptr, 0, tl);
      } else {
        r -= 256;
        const int kv = r / 4; r %= 4;
        tr_tile(p.cmp_w2 + ((size_t)layer * 2 + kv) * 256 * 64, 64, 64, r * 64, 0,
                (bf16_t*)(p.ws + O_W2 + layer * SZ_W2) + (size_t)kv * 128 * 256, 256, nullptr, 0, tl);
      }
    } else if (job < J_X) {
      const int row = (job - J_TR) * 8 + wv8;
      const float4* src = (const float4*)(p.x + (size_t)row * 1024);
      bf16_t* xb = (bf16_t*)(p.ws + O_XB) + (size_t)row * LDK1;
      float ss = 0.f;
#pragma unroll
      for (int i = 0; i < 4; ++i) {
        float4 v = src[lane + 64 * i];
        ss += v.x * v.x + v.y * v.y + v.z * v.z + v.w * v.w;
        *(uint2*)(xb + (lane + 64 * i) * 4) = make_uint2(pack2(v.x, v.y), pack2(v.z, v.w));
      }
#pragma unroll
      for (int o = 32; o >= 1; o >>= 1) ss += __shfl_xor(ss, o);
      float* part = (float*)(p.ws + O_PART) + (size_t)row * 16;
      if (lane < 16) part[lane] = lane == 0 ? ss : 0.f;
    } else if (job < J_POS) {
      const int jj = job - J_X; const int unit = jj >> 2, kq = jj & 3, lk = unit >> 3, ng = unit & 7;
      const int col = ng * 32 + (tid5 & 31), ksl = tid5 >> 5;
      const float* pos = p.cmp_pos + (size_t)lk * 2048;
      const float* w1 = p.cmp_w1 + (size_t)lk * 2048 * 256;
      float s = 0.f;
      const int k0 = kq * 512 + ksl * 32;
#pragma unroll 8
      for (int k = k0; k < k0 + 32; ++k) s += pos[k] * w1[(size_t)k * 256 + col];
      float* red = (float*)sm;
      __syncthreads();
      red[tid5] = s;
      __syncthreads();
      if (tid5 < 32) {
        float t = 0.f;
        for (int q = 0; q < 16; ++q) t += red[q * 32 + tid5];
        ((float*)(p.ws + O_POSW1))[(lk * 4 + kq) * 256 + col] = t;
      }
    } else if (job < J_MISC) {
      float* tabs = (float*)(p.ws + O_TABS);
      for (int i = tid5; i < 20 * 129; i += NTHR) {
        const int h = i / 129, d = i % 129;
        int bk;
        if (d < 16) bk = d;
        else { bk = 16 + (int)(logf((float)d / 16.f) / 2.0794415416798357f * 16.f); if (bk > 31) bk = 31; }
        tabs[h * 132 + d] = p.rel_bias[bk * 20 + h] * LOG2E;
      }
      if (wv8 == 0) {
        for (int layer = 0; layer < NL; ++layer) {
          const float* lm = p.diff_lambda + layer * 256;
          float a = lm[lane] * lm[64 + lane], b = lm[128 + lane] * lm[192 + lane];
#pragma unroll
          for (int o = 32; o >= 1; o >>= 1) { a += __shfl_xor(a, o); b += __shfl_xor(b, o); }
          const float li = 0.8f - 0.6f * expf(-0.3f * (float)layer);
          if (lane == 0) ((float*)(p.ws + O_LAM))[layer] = expf(a) - expf(b) + li;
        }
      }
    } else if (job < J_ZW) {
      const int jj = job - J_MISC; const int layer = jj / ZW_PER, q = jj % ZW_PER;
      uint4* d = (uint4*)(p.ws + O_WIN + layer * SZ_WIN + (size_t)NIN * LDK1 * 2) + q * 512 + tid5;
      if (q * 512 + tid5 < (NINP - NIN) * LDK1 / 8) *d = make_uint4(0, 0, 0, 0);
    } else {
      const int jj = job - J_ZW; const int lk = jj >> 2, q = jj & 3;
      uint4* d = (uint4*)(p.ws + O_W2 + (size_t)lk * 128 * 256 * 2 + 64 * 256 * 2) + q * 512 + tid5;
      *d = make_uint4(0, 0, 0, 0);
    }
  }
}

DI bool epi_inproj_chunk(const P& p, int layer, int ch, int m0w, f32x16 (&a0)[2], f32x16 (&a1)[2], bf16_t* stg, int cp,
                         bf16_t*& rdst, int& rldd, int& rcoff, float rs0, float rs1) {
  const int lane = tidx() & 63;
  const int lr = lane & 31, lh = lane >> 5;
  enum { NORM, RAW, TRANS, SIG, CG };
  int type = RAW, ldd = 512, coff = 0, nh = 2, dv = 64, hd = 0, doff = 0;
  bf16_t* dst = nullptr; const float* gain = nullptr; float scl = 1.f;
  const float* gains = p.qk_gain + layer * 512;
  unsigned char* ws = p.ws;
  if (ch < 8) { type = NORM; dst = (bf16_t*)(ws + O_AQ); coff = ch * 64; gain = gains; scl = QSCL; }
  else if (ch < 16) { type = NORM; dst = (bf16_t*)(ws + O_AK); coff = (ch - 8) * 64; gain = gains + 64; }
  else if (ch < 24) { type = TRANS; dst = (bf16_t*)(ws + O_AVT); nh = 4; dv = 128; hd = (ch - 16) >> 1; doff = ((ch - 16) & 1) * 64; }
  else if (ch < 32) { type = NORM; dst = (bf16_t*)(ws + O_BQ); coff = (ch - 24) * 64; gain = gains + 128; scl = QSCL; }
  else if (ch < 34) { type = NORM; dst = (bf16_t*)(ws + O_BK); ldd = 128; coff = (ch - 32) * 64; gain = gains + 192; }
  else if (ch < 36) { type = TRANS; dst = (bf16_t*)(ws + O_BVT); hd = ch - 34; }
  else if (ch < 44) { type = NORM; dst = (bf16_t*)(ws + O_CQ); coff = (ch - 36) * 64; gain = gains + 256; scl = QSCL; }
  else if (ch < 46) { type = RAW; dst = (bf16_t*)(ws + O_CK); ldd = 128; coff = (ch - 44) * 64; }
  else if (ch < 48) { type = RAW; dst = (bf16_t*)(ws + O_CV); ldd = 128; coff = (ch - 46) * 64; }
  else if (ch < 50) { type = NORM; dst = (bf16_t*)(ws + O_KS); ldd = 128; coff = (ch - 48) * 64; gain = gains + 384; }
  else if (ch < 52) { type = TRANS; dst = (bf16_t*)(ws + O_VST); hd = ch - 50; }
  else if (ch < 54) { type = NORM; dst = (bf16_t*)(ws + O_KW); ldd = 128; coff = (ch - 52) * 64; gain = gains + 448; }
  else if (ch < 56) { type = TRANS; dst = (bf16_t*)(ws + O_VWT); hd = ch - 54; }
  else if (ch < 104) { type = SIG; dst = (bf16_t*)(ws + O_MGS); ldd = 3072; coff = (ch - 56) * 64; }
  else if (ch == 104) { type = CG; }
  else return false;
  rdst = dst; rldd = ldd; rcoff = coff;
#pragma unroll
  for (int mt = 0; mt < 2; ++mt) {
    const int m = m0w + mt * 32 + lr;
    const float rs = mt ? rs1 : rs0;
    float v[2][16];
    float ss = 0.f;
#pragma unroll
    for (int i = 0; i < 16; ++i) { float t = a0[mt][i] * rs; v[0][i] = t; ss += t * t; }
#pragma unroll
    for (int i = 0; i < 16; ++i) { float t = a1[mt][i] * rs; v[1][i] = t; ss += t * t; }
    if (type == NORM) {
      ss += xor32(ss);
      const float r = rsqrtf(ss * (1.f / 64.f) + 1e-6f) * scl;
#pragma unroll
      for (int nt = 0; nt < 2; ++nt)
#pragma unroll
        for (int qd = 0; qd < 4; ++qd) {
          const int n = nt * 32 + 8 * qd + 4 * lh;
          const float4 g4 = *(const float4*)(gain + n);
          *(uint2*)(stg + (mt * 32 + lr) * 136 + cp * 64 + n) =
              make_uint2(pack2(v[nt][4 * qd] * r * g4.x, v[nt][4 * qd + 1] * r * g4.y),
                         pack2(v[nt][4 * qd + 2] * r * g4.z, v[nt][4 * qd + 3] * r * g4.w));
        }
    } else if (type == RAW || type == SIG) {
#pragma unroll
      for (int nt = 0; nt < 2; ++nt)
#pragma unroll
        for (int qd = 0; qd < 4; ++qd) {
          const int n = nt * 32 + 8 * qd + 4 * lh;
          float a = v[nt][4 * qd], b = v[nt][4 * qd + 1], c = v[nt][4 * qd + 2], d = v[nt][4 * qd + 3];
          if (type == SIG) { a = sigmoidf_(a); b = sigmoidf_(b); c = sigmoidf_(c); d = sigmoidf_(d); }
          if (type == SIG)
            *(uint2*)(dst + ((size_t)((coff + n) >> 2) * T_ + m) * 4) = make_uint2(pack2(a, b), pack2(c, d));
          else
            *(uint2*)(stg + (mt * 32 + lr) * 136 + cp * 64 + n) = make_uint2(pack2(a, b), pack2(c, d));
        }
    } else if (type == TRANS) {
      const int b = m >> 12, s = m & 4095;
      bf16_t* base = dst + ((size_t)(b * nh + hd) * dv + doff) * S_ + s;
#pragma unroll
      for (int nt = 0; nt < 2; ++nt)
#pragma unroll
        for (int i = 0; i < 16; ++i) {
          const int n = nt * 32 + 8 * (i >> 2) + 4 * lh + (i & 3);
          base[(size_t)n * S_] = f2bf(v[nt][i]);
        }
    } else {
      float* cg = (float*)(ws + O_CGS) + (size_t)m * 24;
#pragma unroll
      for (int i = 0; i < 16; ++i) {
        const int n = 8 * (i >> 2) + 4 * lh + (i & 3);
        if (n < 24) cg[n] = sigmoidf_(v[0][i]);
      }
    }
  }
  return type == NORM || type == RAW;
}

DI void stage_rows_store(const bf16_t* stg, bf16_t* dst, size_t ldd, int m0w) {
  const int lane = tidx() & 63;
#pragma unroll
  for (int it = 0; it < 16; ++it) {
    const int row = it * 4 + (lane >> 4), c16 = lane & 15;
    const u32x4 v = *(const u32x4*)(stg + row * 136 + c16 * 8);
    *(u32x4*)(dst + (size_t)(m0w + row) * ldd + c16 * 8) = v;
  }
}

DI void phase_inproj(const P& p, int layer, bf16_t* sm, const Geo& ge) {
  const bf16_t* W = (const bf16_t*)(p.ws + O_WIN + layer * SZ_WIN);
  const bf16_t* X = (const bf16_t*)(p.ws + O_XB);
  TileWalk tw(27, ge);
  int mt, nt, mt_have = -1;
  float rs0 = 0.f, rs1 = 0.f;
  while (tw.next(mt, nt)) {
    if (mt != mt_have) {
      const int lane_ = tidx() & 63, wm_ = (tidx() >> 6) >> 1;
      rs0 = row_rstd((const float*)(p.ws + O_PART), mt * 256 + wm_ * 64 + (lane_ & 31));
      rs1 = row_rstd((const float*)(p.ws + O_PART), mt * 256 + wm_ * 64 + 32 + (lane_ & 31));
      mt_have = mt;
    }
    f32x16 acc[4][2]; zero_acc8(acc);
    gemm_wide(W + (size_t)nt * 256 * LDK1, LDK1, X + (size_t)mt * 256 * LDK1, LDK1, 16, acc, sm);
    const int wv = tidx() >> 6, wn = wv & 1, wm = wv >> 1;
    bf16_t* stg = sm + wv * (64 * 136);
    bf16_t *d0 = nullptr, *d1 = nullptr; int ld0 = 0, ld1 = 0, co0 = 0, co1 = 0;
    const bool s0 = epi_inproj_chunk(p, layer, nt * 4 + wn * 2, mt * 256 + wm * 64, acc[0], acc[1], stg, 0, d0, ld0, co0, rs0, rs1);
    const bool s1 = epi_inproj_chunk(p, layer, nt * 4 + wn * 2 + 1, mt * 256 + wm * 64, acc[2], acc[3], stg, 1, d1, ld1, co1, rs0, rs1);
    if (s0 && s1) stage_rows_store(stg, d0 + co0, ld0, mt * 256 + wm * 64);
  }
}

template <int NDT, int MODE, bool ALLON>
DI void attn_tile(const bf16_t* Kl, int kst, const bf16_t* Vl, const bf16x8 (&q)[4], f32x16 (&O)[NDT], float& m, float& l,
                  int kbase, int qp, int win, float cbias, const float* tab, bool lane_on) {
  const int lane = tidx() & 63, lr = lane & 31, lh = lane >> 5;
  f32x16 s[2];
#pragma unroll
  for (int st = 0; st < 2; ++st) {
#pragma unroll
    for (int i = 0; i < 16; ++i) s[st][i] = 0.f;
  }
#pragma unroll
  for (int ks = 0; ks < 4; ++ks) {
    const bf16x8 k0 = *(const bf16x8*)(Kl + lr * kst + ks * 16 + lh * 8);
    const bf16x8 k1 = *(const bf16x8*)(Kl + (32 + lr) * kst + ks * 16 + lh * 8);
    s[0] = MFMA32(k0, q[ks], s[0]);
    s[1] = MFMA32(k1, q[ks], s[1]);
  }
  float alpha, psum = 0.f;
  if (MODE == 0) {
    float tmax = fmaxf(s[0][0], s[1][0]);
#pragma unroll
    for (int i = 1; i < 16; ++i) tmax = fmaxf(tmax, fmaxf(s[0][i], s[1][i]));
    tmax = fmaxf(tmax, xor32(tmax)) + cbias;
    if (!ALLON) tmax = lane_on ? tmax : -1e30f;
    const float mn = fmaxf(m, tmax);
    alpha = ex2(m - mn);
    m = mn;
    const float mc = (ALLON || lane_on) ? mn - cbias : 1e30f;
#pragma unroll
    for (int st = 0; st < 2; ++st)
#pragma unroll
      for (int i = 0; i < 16; ++i) { const float pe = ex2(s[st][i] - mc); psum += pe; s[st][i] = pe; }
  } else {
    float tmax = -1e30f;
#pragma unroll
    for (int st = 0; st < 2; ++st)
#pragma unroll
      for (int i = 0; i < 16; ++i) {
        const int key = kbase + st * 32 + 8 * (i >> 2) + 4 * lh + (i & 3);
        float v;
        if (MODE == 1) {
          const int dist = qp - key;
          const bool ok = (ALLON || lane_on) && dist >= 0 && dist < win;
          const int di = dist < 0 ? 0 : (dist > 128 ? 128 : dist);
          v = ok ? s[st][i] + tab[di] : -1e30f;
        } else {
          v = (16 * key + 31 <= qp) ? s[st][i] : -1e30f;
        }
        s[st][i] = v;
        tmax = fmaxf(tmax, v);
      }
    tmax = fmaxf(tmax, xor32(tmax));
    const float mn = fmaxf(m, tmax);
    alpha = ex2(m - mn);
    m = mn;
#pragma unroll
    for (int st = 0; st < 2; ++st)
#pragma unroll
      for (int i = 0; i < 16; ++i) {
        const float pe = s[st][i] > -5e29f ? ex2(s[st][i] - mn) : 0.f;
        psum += pe;
        s[st][i] = pe;
      }
  }
  l = l * alpha + psum;
  if (__ballot(alpha != 1.f)) {
#pragma unroll
    for (int dt = 0; dt < NDT; ++dt)
#pragma unroll
      for (int i = 0; i < 16; ++i) O[dt][i] *= alpha;
  }
#pragma unroll
  for (int st = 0; st < 2; ++st)
#pragma unroll
    for (int sk = 0; sk < 2; ++sk) {
      u32x4 pu;
      pu[0] = pack2(s[st][8 * sk + 0], s[st][8 * sk + 1]);
      pu[1] = pack2(s[st][8 * sk + 2], s[st][8 * sk + 3]);
      pu[2] = pack2(s[st][8 * sk + 4], s[st][8 * sk + 5]);
      pu[3] = pack2(s[st][8 * sk + 6], s[st][8 * sk + 7]);
      const bf16x8 pf = __builtin_bit_cast(bf16x8, pu);
#pragma unroll
      for (int dt = 0; dt < NDT; ++dt) {
        const bf16_t* vp = Vl + (dt * 32 + lr) * 72 + st * 32 + sk * 16 + 4 * lh;
        const uint2 v0 = *(const uint2*)(vp);
        const uint2 v1 = *(const uint2*)(vp + 8);
        u32x4 vu; vu[0] = v0.x; vu[1] = v0.y; vu[2] = v1.x; vu[3] = v1.y;
        O[dt] = MFMA32(__builtin_bit_cast(bf16x8, vu), pf, O[dt]);
      }
    }
}

DI float gelu_tanh(float x) {
  const float u = 0.7978845608028654f * (x + 0.044715f * x * x * x);
  const float e = __expf(2.f * u);
  const float th = 1.f - 2.f * __builtin_amdgcn_rcpf(e + 1.f);
  return 0.5f * x * (1.f + th);
}

DI void task_compress(const P& p, int layer, int task, bf16_t* sm) {
  const int tid = tidx(), lane = tid & 63, wv = tid >> 6, wn = wv & 1, wm = wv >> 1;
  const int lr = lane & 31, lh = lane >> 5;
  const int b = task & 3, g = (task >> 2) & 1, kv = task >> 3;
  const bf16_t* src = (const bf16_t*)(p.ws + (kv ? O_CV : O_CK)) + (size_t)b * S_ * 128 + g * 64;
  const bf16_t* W1 = (const bf16_t*)(p.ws + O_W1 + layer * SZ_W1) + (size_t)kv * 256 * 2048;
  const bf16_t* W2 = (const bf16_t*)(p.ws + O_W2 + layer * SZ_W2) + (size_t)kv * 128 * 256;
  bf16_t* hid = (bf16_t*)(p.ws + O_HID) + (size_t)((kv * 2 + g) * 4 + b) * 65536;
  const float* pw = (const float*)(p.ws + O_POSW1) + (layer * 2 + kv) * 1024;
  for (int nt2 = 0; nt2 < 2; ++nt2) {
    f32x16 acc[2][2]; zero_acc(acc);
    gemm_mid(W1 + (size_t)nt2 * 128 * 2048, 2048, src, 16 * 128, 254, 128, 32, 0, acc, sm);
#pragma unroll
    for (int mt = 0; mt < 2; ++mt) {
      const int m = wm * 64 + mt * 32 + lr;
#pragma unroll
      for (int nt = 0; nt < 2; ++nt)
#pragma unroll
        for (int qd = 0; qd < 4; ++qd) {
          const int n = nt2 * 128 + wn * 64 + nt * 32 + 8 * qd + 4 * lh;
          float4 pw4 = *(const float4*)(pw + n);
          { const float4 a1 = *(const float4*)(pw + 256 + n), a2 = *(const float4*)(pw + 512 + n), a3 = *(const float4*)(pw + 768 + n);
            pw4.x = ((pw4.x + a1.x) + a2.x) + a3.x; pw4.y = ((pw4.y + a1.y) + a2.y) + a3.y;
            pw4.z = ((pw4.z + a1.z) + a2.z) + a3.z; pw4.w = ((pw4.w + a1.w) + a2.w) + a3.w; }
          *(uint2*)(hid + (size_t)m * 256 + n) =
              make_uint2(pack2(gelu_tanh(acc[nt][mt][4 * qd] + pw4.x), gelu_tanh(acc[nt][mt][4 * qd + 1] + pw4.y)),
                         pack2(gelu_tanh(acc[nt][mt][4 * qd + 2] + pw4.z), gelu_tanh(acc[nt][mt][4 * qd + 3] + pw4.w)));
        }
    }
  }
  __threadfence();
  __syncthreads();
  {
    f32x16 acc[2][2]; zero_acc(acc);
    gemm_mid(W2, 256, hid, 256, 1 << 30, 64, 4, 0, acc, sm);
    if (wn == 0) {
      const float* gain = p.qk_gain + layer * 512 + 320;
#pragma unroll
      for (int mt = 0; mt < 2; ++mt) {
        const int m = wm * 64 + mt * 32 + lr;
        if (kv == 0) {
          float ss = 0.f;
#pragma unroll
          for (int nt = 0; nt < 2; ++nt)
#pragma unroll
            for (int i = 0; i < 16; ++i) ss += acc[nt][mt][i] * acc[nt][mt][i];
          ss += xor32(ss);
          const float r = rsqrtf(ss * (1.f / 64.f) + 1e-6f);
          bf16_t* kc = (bf16_t*)(p.ws + O_KC) + ((size_t)(b * 2 + g) * 256 + m) * 64;
#pragma unroll
          for (int nt = 0; nt < 2; ++nt)
#pragma unroll
            for (int qd = 0; qd < 4; ++qd) {
              const int n = nt * 32 + 8 * qd + 4 * lh;
              const float4 g4 = *(const float4*)(gain + n);
              *(uint2*)(kc + n) = make_uint2(pack2(acc[nt][mt][4 * qd] * r * g4.x, acc[nt][mt][4 * qd + 1] * r * g4.y),
                                             pack2(acc[nt][mt][4 * qd + 2] * r * g4.z, acc[nt][mt][4 * qd + 3] * r * g4.w));
            }
        } else {
          bf16_t* vc = (bf16_t*)(p.ws + O_VCT) + (size_t)(b * 2 + g) * 64 * 256 + m;
#pragma unroll
          for (int nt = 0; nt < 2; ++nt)
#pragma unroll
            for (int i = 0; i < 16; ++i) {
              const int n = nt * 32 + 8 * (i >> 2) + 4 * lh + (i & 3);
              vc[(size_t)n * 256] = f2bf(acc[nt][mt][i]);
            }
        }
      }
    }
  }
}

DI void task_attnA(const P& p, int layer, int task, bf16_t* sm, int dm) {
  const int tid = tidx(), lane = tid & 63, wv = tid >> 6, c = wv & 1, qs = wv >> 1;
  const int lr = lane & 31, lh = lane >> 5;
  const int qb = 31 - (task >> 4), bh = task & 15, b = bh >> 2, h = bh & 3;
  float* tab = (float*)((unsigned char*)sm + 71680);
  bf16x8* qlds = (bf16x8*)((unsigned char*)sm + 72704) + wv * 256 + lane;
  float* xbuf = (float*)((unsigned char*)sm);
  __syncthreads();
  if (tid < 129) tab[tid] = ((const float*)(p.ws + O_TABS))[h * 132 + tid];
  const int q0 = qb * 128, qmin = q0 + qs * 32, qp = qmin + lr;
  bf16_t* aq = (bf16_t*)(p.ws + O_AQ);
  {
    const bf16_t* qptr = aq + (size_t)(b * S_ + qp) * 512 + h * 128 + c * 64 + lh * 8;
#pragma unroll
    for (int ks = 0; ks < 4; ++ks) qlds[ks * 64] = *(const bf16x8*)(qptr + ks * 16);
  }
  f32x16 O[4];
#pragma unroll
  for (int dt = 0; dt < 4; ++dt)
#pragma unroll
    for (int i = 0; i < 16; ++i) O[dt][i] = 0.f;
  float m = -1e30f, l = 0.f;
  const bf16_t* kg = (const bf16_t*)(p.ws + O_AK) + (size_t)b * S_ * 512 + h * 128;
  const bf16_t* vg = (const bf16_t*)(p.ws + O_AVT) + (size_t)((b * 4 + h) * 128) * S_;
  u32x4 rk0, rk1, rv0, rv1;
#define A_GLOAD(i, KT) { const int chk = tid + 512 * i; \
    rk##i = *(const u32x4*)(kg + (size_t)((KT) * 64 + (chk >> 4)) * 512 + (chk & 15) * 8); \
    rv##i = *(const u32x4*)(vg + (size_t)(chk >> 3) * S_ + (KT) * 64 + (chk & 7) * 8); }
#define A_LSTORE(i) { const int chk = tid + 512 * i; \
    *(u32x4*)(Kl + (chk >> 4) * 136 + (chk & 15) * 8) = rk##i; \
    *(u32x4*)(Kl + 64 * 136 + (chk >> 3) * 72 + (chk & 7) * 8) = rv##i; }
  const int kt_hi = 2 * qb + 1;
  A_GLOAD(0, 0) A_GLOAD(1, 0)
  for (int kt = 0; kt <= kt_hi; ++kt) {
    bf16_t* Kl = sm + (kt & 1) * 17920; const bf16_t* Vl = Kl + 64 * 136;
    A_LSTORE(0) A_LSTORE(1)
    if (kt < kt_hi) { A_GLOAD(0, kt + 1) A_GLOAD(1, kt + 1) }
    __syncthreads();
    if (kt * 64 <= qmin + 31) {
      bf16x8 q[4];
#pragma unroll
      for (int ks = 0; ks < 4; ++ks) q[ks] = qlds[ks * 64];
      if (kt * 64 + 63 + 128 <= qmin)
        attn_tile<4, 0, true>(Kl + c * 64, 136, Vl, q, O, m, l, kt * 64, qp, 0, tab[128], tab, true);
      else
        attn_tile<4, 1, true>(Kl + c * 64, 136, Vl, q, O, m, l, kt * 64, qp, 1 << 30, 0.f, tab, true);
    }
  }
#undef A_GLOAD
#undef A_LSTORE
  const float lt = l + xor32(l);
  const float inv = 1.f / lt;
  __syncthreads();
  if (c == 1) {
#pragma unroll
    for (int dt = 0; dt < 4; ++dt)
#pragma unroll
      for (int i = 0; i < 16; ++i) {
        const int d = dt * 32 + 8 * (i >> 2) + 4 * lh + (i & 3);
        xbuf[(qs * 128 + d) * 32 + lr] = O[dt][i] * inv;
      }
  }
  __syncthreads();
  if (c == 0) {
    const float lam = ((const float*)(p.ws + O_LAM))[layer];
    const float li = 0.8f - 0.6f * expf(-0.3f * (float)layer);
    float ss = 0.f;
#pragma unroll
    for (int dt = 0; dt < 4; ++dt)
#pragma unroll
      for (int i = 0; i < 16; ++i) {
        const int d = dt * 32 + 8 * (i >> 2) + 4 * lh + (i & 3);
        const float o = O[dt][i] * inv - lam * xbuf[(qs * 128 + d) * 32 + lr];
        O[dt][i] = o;
        ss += o * o;
      }
    ss += xor32(ss);
    const float r = rsqrtf(ss * (1.f / 128.f) + 1e-6f) * (1.f - li);
    const float* sub = p.diff_subln + layer * 128;
    bf16_t* dst = (dm ? (bf16_t*)(p.ws + WS_END) : aq) + (size_t)(b * S_ + qp) * 512 + h * 128;
#pragma unroll
    for (int dt = 0; dt < 4; ++dt)
#pragma unroll
      for (int qd = 0; qd < 4; ++qd) {
        const int d = dt * 32 + 8 * qd + 4 * lh;
        const float4 g4 = *(const float4*)(sub + d);
        *(uint2*)(dst + d) = make_uint2(pack2(O[dt][4 * qd] * r * g4.x, O[dt][4 * qd + 1] * r * g4.y),
                                        pack2(O[dt][4 * qd + 2] * r * g4.z, O[dt][4 * qd + 3] * r * g4.w));
      }
  }
}

struct KVRegs { u32x4 k0, v0; };
DI void kv_gload(KVRegs& r, const bf16_t* kg, size_t kld, const bf16_t* vg, size_t vld, int key0) {
  const int c0 = tidx();
  r.k0 = *(const u32x4*)(kg + (size_t)(key0 + (c0 >> 3)) * kld + (c0 & 7) * 8);
  r.v0 = *(const u32x4*)(vg + (size_t)(c0 >> 3) * vld + key0 + (c0 & 7) * 8);
}
DI void kv_lstore(const KVRegs& r, bf16_t* Kl, bf16_t* Vl) {
  const int c0 = tidx();
  *(u32x4*)(Kl + (c0 >> 3) * 72 + (c0 & 7) * 8) = r.k0;
  *(u32x4*)(Vl + (c0 >> 3) * 72 + (c0 & 7) * 8) = r.v0;
}

DI void task_attnB(const P& p, int layer, int task, bf16_t* sm, int dm) {
  const int tid = tidx(), lane = tid & 63, wv = tid >> 6, hr = wv & 3, qs = wv >> 2;
  const int lr = lane & 31, lh = lane >> 5;
  const int qb = 63 - (task >> 3), bg = task & 7, b = bg >> 1, g = bg & 1, head = g * 4 + hr;
  float* tabs = (float*)((unsigned char*)sm + 36864);
  __syncthreads();
  for (int i = tid; i < 4 * 129; i += NTHR) {
    const int r = i / 129, d = i % 129;
    tabs[r * 132 + d] = ((const float*)(p.ws + O_TABS))[(4 + g * 4 + r) * 132 + d];
  }
  const int q0 = qb * 64, qmin = q0 + qs * 32, qp = qmin + lr;
  bf16_t* bq = (bf16_t*)(p.ws + O_BQ);
  bf16x8 q[4];
  {
    const bf16_t* qptr = bq + (size_t)(b * S_ + qp) * 512 + head * 64 + lh * 8;
#pragma unroll
    for (int ks = 0; ks < 4; ++ks) q[ks] = *(const bf16x8*)(qptr + ks * 16);
  }
  f32x16 O[2];
#pragma unroll
  for (int dt = 0; dt < 2; ++dt)
#pragma unroll
    for (int i = 0; i < 16; ++i) O[dt][i] = 0.f;
  float m = p.sinks[layer * 8 + head] * LOG2E, l = lh == 0 ? 1.f : 0.f;
  const bf16_t* kg = (const bf16_t*)(p.ws + O_BK) + (size_t)b * S_ * 128 + g * 64;
  const bf16_t* vg = (const bf16_t*)(p.ws + O_BVT) + (size_t)((b * 2 + g) * 64) * S_;
  const int kt_lo = q0 >= 127 ? (q0 - 127) >> 6 : 0, kt_hi = qb;
  KVRegs R;
  kv_gload(R, kg, 128, vg, S_, kt_lo * 64);
  for (int kt = kt_lo; kt <= kt_hi; ++kt) {
    bf16_t* Kl = sm + (kt & 1) * 9216; bf16_t* Vl = Kl + 4608;
    kv_lstore(R, Kl, Vl);
    if (kt < kt_hi) kv_gload(R, kg, 128, vg, S_, (kt + 1) * 64);
    __syncthreads();
    if (kt * 64 <= qmin + 31 && kt * 64 + 63 + 127 >= qmin)
      attn_tile<2, 1, true>(Kl, 72, Vl, q, O, m, l, kt * 64, qp, 128, 0.f, tabs + hr * 132, true);
  }
  const float lt = l + xor32(l);
  const float inv = 1.f / lt;
  bf16_t* dst = (dm ? (bf16_t*)(p.ws + WS_END) : bq) + (size_t)(b * S_ + qp) * 512 + head * 64;
#pragma unroll
  for (int dt = 0; dt < 2; ++dt)
#pragma unroll
    for (int qd = 0; qd < 4; ++qd) {
      const int d = dt * 32 + 8 * qd + 4 * lh;
      *(uint2*)(dst + d) = make_uint2(pack2(O[dt][4 * qd] * inv, O[dt][4 * qd + 1] * inv),
                                      pack2(O[dt][4 * qd + 2] * inv, O[dt][4 * qd + 3] * inv));
    }
}

DI void phase2(const P& p, int layer, bf16_t* sm, unsigned* qhead, int dm = 0) {
  for (;;) {
    const int task = next_task(qhead, sm);
    if (task >= 16 + 512 + 512) break;
    if (task < 16) task_compress(p, layer, task, sm);
    else if (task < 16 + 512) task_attnA(p, layer, task - 16, sm, dm);
    else task_attnB(p, layer, task - 528, sm, dm);
  }
}

DI void task_nsa(const P& p, int layer, int task, bf16_t* sm, int dm) {
  const int tid = tidx(), lane = tid & 63, wv = tid >> 6, hr = wv & 3, qs = wv >> 2;
  const int lr = lane & 31, lh = lane >> 5;
  const int qb = 63 - (task >> 3), bg = task & 7, b = bg >> 1, g = bg & 1, head = g * 4 + hr;
  float* tabs = (float*)((unsigned char*)sm + 36864);
  float* cbuf = (float*)((unsigned char*)sm + 39168);
  unsigned long long* masks = (unsigned long long*)((unsigned char*)sm + 55808);
  float* outl = (float*)((unsigned char*)sm + 56320) + wv * 2048 + lane;
  int itc = 0;
  __syncthreads();
  for (int i = tid; i < 4 * 129; i += NTHR) {
    const int r = i / 129, d = i % 129;
    tabs[r * 132 + d] = ((const float*)(p.ws + O_TABS))[(12 + g * 4 + r) * 132 + d];
  }
  for (int i = tid; i < 64 * 65; i += NTHR) cbuf[i] = 0.f;
  const float* tab = tabs + hr * 132;
  const int q0 = qb * 64, qmin = q0 + qs * 32, ql = qs * 32 + lr, qp = q0 + ql;
  bf16_t* cq = (bf16_t*)(p.ws + O_CQ);
  bf16x8 q[4];
  {
    const bf16_t* qptr = cq + (size_t)(b * S_ + qp) * 512 + head * 64 + lh * 8;
#pragma unroll
    for (int ks = 0; ks < 4; ++ks) q[ks] = *(const bf16x8*)(qptr + ks * 16);
  }
  const float* cg = (const float*)(p.ws + O_CGS) + (size_t)(b * S_ + qp) * 24 + head * 3;
  const float g0 = cg[0], g1 = cg[1], g2 = cg[2];
  f32x16 O[2];
  KVRegs R;
  {
    int nct = (((q0 + 32) >> 4) + 1 + 63) >> 6; if (nct > 4) nct = 4;
    const bf16_t* kg = (const bf16_t*)(p.ws + O_KC) + (size_t)(b * 2 + g) * 256 * 64;
    const bf16_t* vg = (const bf16_t*)(p.ws + O_VCT) + (size_t)(b * 2 + g) * 64 * 256;
#pragma unroll
    for (int dt = 0; dt < 2; ++dt)
#pragma unroll
      for (int i = 0; i < 16; ++i) O[dt][i] = 0.f;
    float m = -1e30f, l = 0.f;
    kv_gload(R, kg, 64, vg, 256, 0);
    for (int ct = 0; ct < nct; ++ct, ++itc) {
      bf16_t* Kl = sm + (itc & 1) * 9216; bf16_t* Vl = Kl + 4608;
      kv_lstore(R, Kl, Vl);
      if (ct + 1 < nct) kv_gload(R, kg, 64, vg, 256, (ct + 1) * 64);
      __syncthreads();
      attn_tile<2, 2, true>(Kl, 72, Vl, q, O, m, l, ct * 64, qp, 0, 0.f, tab, true);
    }
    const float lt = l + xor32(l);
    const float inv = lt > 0.f ? 1.f / lt : 0.f;
    {
      const float sc = g0 * inv;
#pragma unroll
      for (int dt = 0; dt < 2; ++dt)
#pragma unroll
        for (int i = 0; i < 16; ++i) outl[(dt * 16 + i) * 64] = sc * O[dt][i];
    }
    float carry = 0.f;
    kv_gload(R, kg, 64, vg, 256, 0);
    for (int ct = 0; ct < nct; ++ct, ++itc) {
      bf16_t* Kl = sm + (itc & 1) * 9216; bf16_t* Vl = Kl + 4608;
      kv_lstore(R, Kl, Vl);
      if (ct + 1 < nct) kv_gload(R, kg, 64, vg, 256, (ct + 1) * 64);
      __syncthreads();
      float val[2][4];
#pragma unroll
      for (int st = 0; st < 2; ++st) {
        f32x16 s;
#pragma unroll
        for (int i = 0; i < 16; ++i) s[i] = 0.f;
#pragma unroll
        for (int ks = 0; ks < 4; ++ks) {
          bf16x8 kf = *(const bf16x8*)(Kl + (st * 32 + lr) * 72 + ks * 16 + lh * 8);
          s = MFMA32(kf, q[ks], s);
        }
        float pq[4], pl[4], other[4];
#pragma unroll
        for (int g4 = 0; g4 < 4; ++g4) {
          float sum = 0.f, last = 0.f;
#pragma unroll
          for (int e = 0; e < 4; ++e) {
            const int cc = ct * 64 + st * 32 + 8 * g4 + 4 * lh + e;
            const float pe = (16 * cc + 31 <= qp) ? ex2(s[4 * g4 + e] - m) * inv : 0.f;
            sum += pe; last = pe;
          }
          pq[g4] = sum; pl[g4] = last;
        }
#pragma unroll
        for (int g4 = 0; g4 < 4; ++g4) other[g4] = xor32(pl[g4]);
        val[st][0] = pq[0] + (lh ? other[0] : carry);
        val[st][1] = pq[1] + (lh ? other[1] : other[0]);
        val[st][2] = pq[2] + (lh ? other[2] : other[1]);
        val[st][3] = pq[3] + (lh ? other[3] : other[2]);
        carry = other[3];
      }
      for (int w = 0; w < 4; ++w) {
        if (hr == w) {
#pragma unroll
          for (int st = 0; st < 2; ++st)
#pragma unroll
            for (int g4 = 0; g4 < 4; ++g4) cbuf[(ct * 16 + st * 8 + 2 * g4 + lh) * 65 + ql] += val[st][g4];
        }
        __syncthreads();
      }
    }
  }
  __syncthreads();
  for (int qi = 0; qi < 8; ++qi) {
    const int qq = wv * 8 + qi, qpos = q0 + qq, j = lane, cur = qpos >> 6;
    const float imp = cbuf[j * 65 + qq];
    const bool valid = j <= cur;
    const bool forced = (j == 0) || (j == cur) || (j == cur - 1);
    const float score = valid ? imp + (forced ? 1e4f : 0.f) : -1e30f;
    int rank = 0;
#pragma unroll 4
    for (int jp = 0; jp < 64; ++jp) {
      const float sj = __int_as_float(__builtin_amdgcn_readlane(__float_as_int(score), jp));
      rank += ((sj > score) || (sj == score && jp < j)) ? 1 : 0;
    }
    const unsigned long long mk = __ballot(rank < 16);
    if (lane == 0) masks[qq] = mk;
  }
  __syncthreads();
  const unsigned long long mymask = masks[ql];
  unsigned long long un = 0ull;
  for (int i = 0; i < 64; ++i) un |= masks[i];
  {
    const int cmax = qb;
    unsigned long long todo = un & (cmax == 63 ? ~0ull : ((1ull << (cmax + 1)) - 1ull));
    const bf16_t* kg = (const bf16_t*)(p.ws + O_KS) + (size_t)b * S_ * 128 + g * 64;
    const bf16_t* vg = (const bf16_t*)(p.ws + O_VST) + (size_t)((b * 2 + g) * 64) * S_;
#pragma unroll
    for (int dt = 0; dt < 2; ++dt)
#pragma unroll
      for (int i = 0; i < 16; ++i) O[dt][i] = 0.f;
    float m = -1e30f, l = 0.f;
    kv_gload(R, kg, 128, vg, S_, (__ffsll((long long)todo) - 1) * 64);
    for (; todo; ++itc) {
      const int j = __ffsll((long long)todo) - 1;
      todo &= todo - 1ull;
      bf16_t* Kl = sm + (itc & 1) * 9216; bf16_t* Vl = Kl + 4608;
      kv_lstore(R, Kl, Vl);
      if (todo) kv_gload(R, kg, 128, vg, S_, (__ffsll((long long)todo) - 1) * 64);
      __syncthreads();
      const bool on = (mymask >> j) & 1ull;
      if (j * 64 <= qmin + 31 && __ballot(on)) {
        if (j * 64 + 63 + 128 <= qmin)
          attn_tile<2, 0, false>(Kl, 72, Vl, q, O, m, l, j * 64, qp, 0, tab[128], tab, on);
        else
          attn_tile<2, 1, false>(Kl, 72, Vl, q, O, m, l, j * 64, qp, 1 << 30, 0.f, tab, on);
      }
    }
    const float lt = l + xor32(l);
    const float inv = lt > 0.f ? 1.f / lt : 0.f;
    {
      const float sc = g1 * inv;
#pragma unroll
      for (int dt = 0; dt < 2; ++dt)
#pragma unroll
        for (int i = 0; i < 16; ++i) outl[(dt * 16 + i) * 64] += sc * O[dt][i];
    }
  }
  {
    const bf16_t* kg = (const bf16_t*)(p.ws + O_KW) + (size_t)b * S_ * 128 + g * 64;
    const bf16_t* vg = (const bf16_t*)(p.ws + O_VWT) + (size_t)((b * 2 + g) * 64) * S_;
#pragma unroll
    for (int dt = 0; dt < 2; ++dt)
#pragma unroll
      for (int i = 0; i < 16; ++i) O[dt][i] = 0.f;
    float m = -1e30f, l = 0.f;
    const int kt_lo = q0 >= 511 ? (q0 - 511) >> 6 : 0, kt_hi = qb;
    kv_gload(R, kg, 128, vg, S_, kt_lo * 64);
    for (int kt = kt_lo; kt <= kt_hi; ++kt, ++itc) {
      bf16_t* Kl = sm + (itc & 1) * 9216; bf16_t* Vl = Kl + 4608;
      kv_lstore(R, Kl, Vl);
      if (kt < kt_hi) kv_gload(R, kg, 128, vg, S_, (kt + 1) * 64);
      __syncthreads();
      if (kt * 64 <= qmin + 31 && kt * 64 + 63 + 511 >= qmin) {
        if (kt * 64 + 63 + 128 <= qmin && qmin + 31 - kt * 64 < 512)
          attn_tile<2, 0, true>(Kl, 72, Vl, q, O, m, l, kt * 64, qp, 0, tab[128], tab, true);
        else
          attn_tile<2, 1, true>(Kl, 72, Vl, q, O, m, l, kt * 64, qp, 512, 0.f, tab, true);
      }
    }
    const float lt = l + xor32(l);
    const float inv = 1.f / lt;
    {
      const float sc = g2 * inv;
#pragma unroll
      for (int dt = 0; dt < 2; ++dt)
#pragma unroll
        for (int i = 0; i < 16; ++i) O[dt][i] = outl[(dt * 16 + i) * 64] + sc * O[dt][i];
    }
  }
  bf16_t* dst = (dm ? (bf16_t*)(p.ws + WS_END) : cq) + (size_t)(b * S_ + qp) * 512 + head * 64;
#pragma unroll
  for (int dt = 0; dt < 2; ++dt)
#pragma unroll
    for (int qd = 0; qd < 4; ++qd) {
      const int d = dt * 32 + 8 * qd + 4 * lh;
      *(uint2*)(dst + d) = make_uint2(pack2(O[dt][4 * qd], O[dt][4 * qd + 1]), pack2(O[dt][4 * qd + 2], O[dt][4 * qd + 3]));
    }
}

DI void phase3(const P& p, int layer, bf16_t* sm, unsigned* qhead, int dm = 0) {
  for (;;) {
    const int task = next_task(qhead, sm);
    if (task >= 512) break;
    task_nsa(p, layer, task, sm, dm);
  }
}

DI void phase23(const P& p, int layer, bf16_t* sm, unsigned* qhead, unsigned* cdone) {
  for (;;) {
    const int task = next_task(qhead, sm);
    if (task >= 16 + 512 + 512 + 512) break;
    if (task < 16) {
      task_compress(p, layer, task, sm);
      asm volatile("s_waitcnt vmcnt(0) lgkmcnt(0)" ::: "memory");
      __syncthreads();
      if (threadIdx.x == 0) {
        __builtin_amdgcn_fence(__ATOMIC_RELEASE, "agent");
        asm volatile("s_waitcnt vmcnt(0)" ::: "memory");
        __hip_atomic_fetch_add(cdone, 1u, __ATOMIC_RELAXED, __HIP_MEMORY_SCOPE_AGENT);
      }
    } else if (task < 16 + 512) task_attnA(p, layer, task - 16, sm, 0);
    else if (task >= 1040) task_attnB(p, layer, task - 1040, sm, 0);
    else {
      if (threadIdx.x == 0) {
        while (__hip_atomic_load(cdone, __ATOMIC_RELAXED, __HIP_MEMORY_SCOPE_AGENT) < 16u) __builtin_amdgcn_s_sleep(2);
        __builtin_amdgcn_fence(__ATOMIC_ACQUIRE, "agent");
        asm volatile("s_waitcnt vmcnt(0)" ::: "memory");
      }
      __syncthreads();
      task_nsa(p, layer, task - 528, sm, 0);
    }
  }
}

DI void phase_merge(const P& p, int layer, bf16_t* sm, const Geo& ge) {
  const int tid = tidx(), lane = tid & 63, wv = tid >> 6, wn = wv & 1, wm = wv >> 1;
  const int lr = lane & 31, lh = lane >> 5;
  const bf16_t* W = (const bf16_t*)(p.ws + O_WBR + layer * SZ_WBR);
  const bf16_t* mgs = (const bf16_t*)(p.ws + O_MGS);
  bf16_t* z = (bf16_t*)(p.ws + O_Z);
  TileWalk tw(8, ge);
  int mt_, nt_;
  while (tw.next(mt_, nt_)) {
    unsigned zp[2][2][8];
#pragma unroll
    for (int a_ = 0; a_ < 2; ++a_)
#pragma unroll
      for (int b_ = 0; b_ < 2; ++b_)
#pragma unroll
        for (int i = 0; i < 8; ++i) zp[a_][b_][i] = 0u;
    for (int n3 = 0; n3 < 3; ++n3) {
      const bf16_t* X = (const bf16_t*)(p.ws + (n3 == 0 ? O_AQ : (n3 == 1 ? O_BQ : O_CQ)));
      f32x16 acc[2][2]; zero_acc(acc);
      gemm_mid(W + ((size_t)n3 * 1024 + nt_ * 128) * 512, 512, X, 512, 1 << 30, 64, 8, mt_ * 256, acc, sm);
#pragma unroll
      for (int mt = 0; mt < 2; ++mt) {
        const int m = mt_ * 256 + wm * 64 + mt * 32 + lr;
#pragma unroll
        for (int nt = 0; nt < 2; ++nt)
#pragma unroll
          for (int qd = 0; qd < 4; ++qd) {
            const int n = nt_ * 128 + wn * 64 + nt * 32 + 8 * qd + 4 * lh;
            const uint2 gq = *(const uint2*)(mgs + ((size_t)((n3 * 1024 + n) >> 2) * T_ + m) * 4);
            const unsigned z01 = zp[nt][mt][2 * qd], z23 = zp[nt][mt][2 * qd + 1];
            const float v0 = bf2f((bf16_t)(z01 & 0xffff)) + bf2f((bf16_t)(gq.x & 0xffff)) * acc[nt][mt][4 * qd];
            const float v1 = bf2f((bf16_t)(z01 >> 16)) + bf2f((bf16_t)(gq.x >> 16)) * acc[nt][mt][4 * qd + 1];
            const float v2 = bf2f((bf16_t)(z23 & 0xffff)) + bf2f((bf16_t)(gq.y & 0xffff)) * acc[nt][mt][4 * qd + 2];
            const float v3 = bf2f((bf16_t)(z23 >> 16)) + bf2f((bf16_t)(gq.y >> 16)) * acc[nt][mt][4 * qd + 3];
            zp[nt][mt][2 * qd] = pack2(v0, v1);
            zp[nt][mt][2 * qd + 1] = pack2(v2, v3);
          }
      }
    }
    bf16_t* stg = sm + wv * (64 * 72);
#pragma unroll
    for (int mt = 0; mt < 2; ++mt)
#pragma unroll
      for (int nt = 0; nt < 2; ++nt)
#pragma unroll
        for (int qd = 0; qd < 4; ++qd)
          *(uint2*)(stg + (mt * 32 + lr) * 72 + nt * 32 + 8 * qd + 4 * lh) = make_uint2(zp[nt][mt][2 * qd], zp[nt][mt][2 * qd + 1]);
#pragma unroll
    for (int it = 0; it < 8; ++it) {
      const int row = it * 8 + (lane >> 3), c16 = lane & 7;
      const u32x4 v = *(const u32x4*)(stg + row * 72 + c16 * 8);
      *(u32x4*)(z + (size_t)(mt_ * 256 + wm * 64 + row) * LDK1 + nt_ * 128 + wn * 64 + c16 * 8) = v;
    }
  }
}

DI void phase_resid(const P& p, const bf16_t* W, const bf16_t* X, int K, bf16_t* sm, const Geo& ge, bool last) {
  const int tid = tidx(), lane = tid & 63, wv = tid >> 6, wn = wv & 1, wm = wv >> 1;
  const int lr = lane & 31, lh = lane >> 5;
  bf16_t* xb = (bf16_t*)(p.ws + O_XB);
  float* part = (float*)(p.ws + O_PART);
  TileWalk tw(4, ge);
  int mt_, nt_;
  while (tw.next(mt_, nt_)) {
    f32x16 acc[4][2]; zero_acc8(acc);
    const int ldk = K + 64;
    gemm_wide(W + (size_t)nt_ * 256 * ldk, ldk, X + (size_t)mt_ * 256 * ldk, ldk, K / 64, acc, sm);
    float* stg = (float*)sm + wv * (64 * 68);
    const int m0w = mt_ * 256 + wm * 64, n0w = nt_ * 256 + wn * 128;
#pragma unroll
    for (int cp = 0; cp < 2; ++cp) {
#pragma unroll 4
      for (int it = 0; it < 8; ++it) {
        const int row = it * 8 + (lane >> 3), c8 = (lane & 7) * 8;
        const u32x4 raw = *(const u32x4*)(xb + (size_t)(m0w + row) * LDK1 + n0w + cp * 64 + c8);
        float* d = stg + row * 68 + c8;
        *(float4*)(d) = make_float4(__uint_as_float(raw[0] << 16), __uint_as_float(raw[0] & 0xffff0000u),
                                    __uint_as_float(raw[1] << 16), __uint_as_float(raw[1] & 0xffff0000u));
        *(float4*)(d + 4) = make_float4(__uint_as_float(raw[2] << 16), __uint_as_float(raw[2] & 0xffff0000u),
                                        __uint_as_float(raw[3] << 16), __uint_as_float(raw[3] & 0xffff0000u));
      }
#pragma unroll
      for (int mt = 0; mt < 2; ++mt) {
        float ss = 0.f;
#pragma unroll
        for (int nh = 0; nh < 2; ++nh)
#pragma unroll
          for (int qd = 0; qd < 4; ++qd) {
            const int nt = cp * 2 + nh;
            float4* sp = (float4*)(stg + (mt * 32 + lr) * 68 + nh * 32 + 8 * qd + 4 * lh);
            float4 v = *sp;
            v.x += acc[nt][mt][4 * qd]; v.y += acc[nt][mt][4 * qd + 1]; v.z += acc[nt][mt][4 * qd + 2]; v.w += acc[nt][mt][4 * qd + 3];
            *sp = v;
            ss += v.x * v.x + v.y * v.y + v.z * v.z + v.w * v.w;
          }
        ss += xor32(ss);
        if (lh == 0) part[(size_t)(m0w + mt * 32 + lr) * 16 + nt_ * 4 + wn * 2 + cp] = ss;
      }
#pragma unroll 4
      for (int it = 0; it < 16; ++it) {
        const int row = it * 4 + (lane >> 4), c4 = (lane & 15) * 4;
        const float4 v = *(const float4*)(stg + row * 68 + c4);
        if (last) *(float4*)(p.out + (size_t)(m0w + row) * 1024 + n0w + cp * 64 + c4) = v;
        *(uint2*)(xb + (size_t)(m0w + row) * LDK1 + n0w + cp * 64 + c4) = make_uint2(pack2(v.x, v.y), pack2(v.z, v.w));
      }
    }
  }
}

DI void phase_up(const P& p, int layer, bf16_t* sm, const Geo& ge) {
  const int tid = tidx(), lane = tid & 63, wv = tid >> 6, wn = wv & 1, wm = wv >> 1;
  const int lr = lane & 31, lh = lane >> 5;
  const bf16_t* W = (const bf16_t*)(p.ws + O_WUP + layer * SZ_WUP);
  const bf16_t* X = (const bf16_t*)(p.ws + O_XB);
  const float* part = (const float*)(p.ws + O_PART);
  bf16_t* u = (bf16_t*)(p.ws + O_U);
  TileWalk tw(16, ge);
  int mt_, nt_, mt_have = -1;
  float rs0 = 0.f, rs1 = 0.f;
  while (tw.next(mt_, nt_)) {
    if (mt_ != mt_have) {
      rs0 = row_rstd(part, mt_ * 256 + wm * 64 + lr);
      rs1 = row_rstd(part, mt_ * 256 + wm * 64 + 32 + lr);
      mt_have = mt_;
    }
    f32x16 acc[4][2]; zero_acc8(acc);
    gemm_wide(W + (size_t)nt_ * 256 * LDK1, LDK1, X + (size_t)mt_ * 256 * LDK1, LDK1, 16, acc, sm);
    bf16_t* stg = sm + wv * (64 * 136);
#pragma unroll
    for (int mt = 0; mt < 2; ++mt) {
      const float rs = mt ? rs1 : rs0;
#pragma unroll
      for (int nt = 0; nt < 4; ++nt)
#pragma unroll
        for (int qd = 0; qd < 4; ++qd) {
          const int n = nt_ * 256 + wn * 128 + nt * 32 + 8 * qd + 4 * lh;
          float a = fmaxf(acc[nt][mt][4 * qd] * rs, 0.f), b = fmaxf(acc[nt][mt][4 * qd + 1] * rs, 0.f);
          float c = fmaxf(acc[nt][mt][4 * qd + 2] * rs, 0.f), d = fmaxf(acc[nt][mt][4 * qd + 3] * rs, 0.f);
          *(uint2*)(stg + (mt * 32 + lr) * 136 + nt * 32 + 8 * qd + 4 * lh) = make_uint2(pack2(a * a, b * b), pack2(c * c, d * d));
        }
    }
    stage_rows_store(stg, u + nt_ * 256 + wn * 128, LDK4, mt_ * 256 + wm * 64);
  }
}

DI unsigned xcc_id() { return (unsigned)__builtin_amdgcn_s_getreg((3 << 11) | 20) & 0xFu; }
struct BarCtx { unsigned* base; unsigned xcc, xcnt, nxcc, gen; };
DI void gbar(BarCtx& c) {
  ++c.gen;
  asm volatile("s_waitcnt vmcnt(0) lgkmcnt(0)" ::: "memory");
  __syncthreads();
  if (threadIdx.x == 0) {
    const unsigned old = __hip_atomic_fetch_add(c.base + (16 + c.xcc) * 32, 1u, __ATOMIC_RELAXED, __HIP_MEMORY_SCOPE_AGENT);
    if (old % c.xcnt == c.xcnt - 1) {
      __builtin_amdgcn_fence(__ATOMIC_RELEASE, "agent");
      asm volatile("s_waitcnt vmcnt(0)" ::: "memory");
      const unsigned t = __hip_atomic_fetch_add(c.base + 32 * 32, 1u, __ATOMIC_RELAXED, __HIP_MEMORY_SCOPE_AGENT);
      if (t % c.nxcc == c.nxcc - 1) {
        for (unsigned i = 0; i < 16; ++i)
          __hip_atomic_store(c.base + (33 + i) * 32, c.gen, __ATOMIC_RELAXED, __HIP_MEMORY_SCOPE_AGENT);
      }
    }
    while (__hip_atomic_load(c.base + (33 + c.xcc) * 32, __ATOMIC_RELAXED, __HIP_MEMORY_SCOPE_AGENT) < c.gen) __builtin_amdgcn_s_sleep(1);
    __builtin_amdgcn_fence(__ATOMIC_ACQUIRE, "agent");
    asm volatile("s_waitcnt vmcnt(0)" ::: "memory");
  }
  __syncthreads();
}

__global__ void __launch_bounds__(512, 2) mega(P p) {
  extern __shared__ __attribute__((aligned(16))) unsigned char smraw[];
  bf16_t* sm = (bf16_t*)smraw;
  cg::grid_group grid = cg::this_grid();
  if (threadIdx.x == 0)
    ((unsigned*)smraw)[0] = __hip_atomic_fetch_add((unsigned*)(p.ws + O_BAR) + xcc_id() * 32, 1u, __ATOMIC_RELAXED, __HIP_MEMORY_SCOPE_AGENT);
  __syncthreads();
  const unsigned my_rank = (unsigned)__builtin_amdgcn_readfirstlane((int)((volatile unsigned*)smraw)[0]);
  __syncthreads();
#ifndef PHMASK
#define PHMASK 0xff
#endif
  if (PHMASK & 1) phase0(p, sm);
  grid.sync();
  BarCtx bc;
  bc.base = (unsigned*)(p.ws + O_BAR); bc.xcc = xcc_id(); bc.gen = 0;
  bc.xcnt = (unsigned)__builtin_amdgcn_readfirstlane((int)__hip_atomic_load(bc.base + bc.xcc * 32, __ATOMIC_RELAXED, __HIP_MEMORY_SCOPE_AGENT));
  bc.nxcc = 0;
  for (unsigned i = 0; i < 16; ++i) bc.nxcc += __hip_atomic_load(bc.base + i * 32, __ATOMIC_RELAXED, __HIP_MEMORY_SCOPE_AGENT) ? 1u : 0u;
  bc.nxcc = (unsigned)__builtin_amdgcn_readfirstlane((int)bc.nxcc);
  unsigned hi_cnt = 0;
  for (unsigned i = 8; i < 16; ++i) hi_cnt += __hip_atomic_load(bc.base + i * 32, __ATOMIC_RELAXED, __HIP_MEMORY_SCOPE_AGENT);
  hi_cnt = (unsigned)__builtin_amdgcn_readfirstlane((int)hi_cnt);
  Geo ge;
  if (bc.nxcc == 8 && hi_cnt == 0) { ge.xcd = (int)bc.xcc; ge.loc = (int)my_rank; ge.nloc = (int)bc.xcnt; }
  else { ge.xcd = blockIdx.x & 7; ge.loc = blockIdx.x >> 3; ge.nloc = gridDim.x >> 3; }
  unsigned* qheads = bc.base + 64 * 32;
  for (int layer = 0; layer < NL; ++layer) {
    if (PHMASK & 2) phase_inproj(p, layer, sm, ge);
    gbar(bc);
    phase23(p, layer, sm, qheads + (layer * 2) * 32, qheads + (layer * 2 + 1) * 32);
    gbar(bc);
    if (PHMASK & 16) phase_merge(p, layer, sm, ge);
    gbar(bc);
    if (PHMASK & 32) phase_resid(p, (const bf16_t*)(p.ws + O_WO + layer * SZ_WO), (const bf16_t*)(p.ws + O_Z), 1024, sm, ge, false);
    gbar(bc);
    if (PHMASK & 64) phase_up(p, layer, sm, ge);
    gbar(bc);
    if (PHMASK & 128) phase_resid(p, (const bf16_t*)(p.ws + O_WDN + layer * SZ_WDN), (const bf16_t*)(p.ws + O_U), 4096, sm, ge, layer == NL - 1);
    gbar(bc);
  }
}

extern "C" void kernel_launch(void* const* d_in, const int* in_sizes, int n_in, void* d_out, int out_size, void* d_ws,
                              size_t ws_size, hipStream_t stream) {
  static int grid_blocks = 0;
  if (!grid_blocks) {
    int dev = 0, cus = 0, per_cu = 0;
    (void)hipGetDevice(&dev);
    (void)hipDeviceGetAttribute(&cus, hipDeviceAttributeMultiprocessorCount, dev);
    (void)hipFuncSetAttribute((const void*)mega, hipFuncAttributeMaxDynamicSharedMemorySize, LDS_BYTES);
    (void)hipOccupancyMaxActiveBlocksPerMultiprocessor(&per_cu, (const void*)mega, NTHR, LDS_BYTES);
    if (per_cu < 1) per_cu = 1;
    if (per_cu > 1) per_cu = 1;
    grid_blocks = cus * per_cu;
    if (ws_size < WS_END) fprintf(stderr, "workspace too small: %zu < %zu\n", ws_size, (size_t)WS_END);
  }
  P p{};
  p.x = (const float*)d_in[0]; p.w_in = (const float*)d_in[1]; p.qk_gain = (const float*)d_in[2];
  p.diff_lambda = (const float*)d_in[3]; p.diff_subln = (const float*)d_in[4]; p.sinks = (const float*)d_in[5];
  p.cmp_pos = (const float*)d_in[6]; p.cmp_w1 = (const float*)d_in[7]; p.cmp_w2 = (const float*)d_in[8];
  p.w_branch = (const float*)d_in[9]; p.w_out = (const float*)d_in[10]; p.norm_mix = (const float*)d_in[11];
  p.norm_mlp = (const float*)d_in[12]; p.w_up = (const float*)d_in[13]; p.w_down = (const float*)d_in[14];
  p.rel_bias = (const float*)d_in[15];
  p.out = (float*)d_out; p.ws = (unsigned char*)d_ws;
  (void)hipMemsetAsync((unsigned char*)d_ws + O_BAR, 0, 80 * 128, stream);
  void* args[] = {&p};
  hipError_t e = hipLaunchCooperativeKernel((const void*)mega, dim3(grid_blocks), dim3(NTHR), args, LDS_BYTES, stream);
  if (e != hipSuccess) fprintf(stderr, "cooperative launch failed: %s (grid %d)\n", hipGetErrorString(e), grid_blocks);
}
```

```cpp
#include <hip/hip_runtime.h>
#include <hip/hip_cooperative_groups.h>
#include <cstdio>
namespace cg = cooperative_groups;

typedef unsigned short bf16_t;
using bf16x8 = __attribute__((ext_vector_type(8))) short;
using f32x16 = __attribute__((ext_vector_type(16))) float;
using u32x4 = __attribute__((ext_vector_type(4))) unsigned;
#define DI __device__ __forceinline__
#define MFMA32(a, b, c) __builtin_amdgcn_mfma_f32_32x32x16_bf16((a), (b), (c), 0, 0, 0)

constexpr int S_ = 4096, T_ = 16384, NL = 4;
constexpr int NIN = 6680, NINP = 6912;
constexpr int LDS_BYTES = 147456;
constexpr int NTHR = 512;
constexpr int LDT = 72;
constexpr int LDK1 = 1088, LDK4 = 4160;
constexpr int WT_E = 256 * LDT;

constexpr size_t SZ_WIN = (size_t)NINP * LDK1 * 2;
constexpr size_t SZ_WBR = (size_t)3 * 1024 * 512 * 2;
constexpr size_t SZ_WO = (size_t)1024 * LDK1 * 2;
constexpr size_t SZ_WUP = (size_t)4096 * LDK1 * 2;
constexpr size_t SZ_WDN = (size_t)1024 * LDK4 * 2;
constexpr size_t SZ_W1 = (size_t)2 * 256 * 2048 * 2;
constexpr size_t SZ_W2 = (size_t)2 * 128 * 256 * 2;
constexpr size_t O_WIN = 0;
constexpr size_t O_WBR = O_WIN + NL * SZ_WIN;
constexpr size_t O_WO = O_WBR + NL * SZ_WBR;
constexpr size_t O_WUP = O_WO + NL * SZ_WO;
constexpr size_t O_WDN = O_WUP + NL * SZ_WUP;
constexpr size_t O_W1 = O_WDN + NL * SZ_WDN;
constexpr size_t O_W2 = O_W1 + NL * SZ_W1;
constexpr size_t O_POSW1 = O_W2 + NL * SZ_W2;
constexpr size_t O_LAM = O_POSW1 + (size_t)NL * 2 * 4 * 256 * 4;
constexpr size_t O_TABS = O_LAM + 256;
constexpr size_t O_PART = O_TABS + 20 * 132 * 4 + 192;
constexpr size_t O_XB = ((O_PART + (size_t)T_ * 16 * 4 + 255) / 256) * 256;
constexpr size_t O_ACT = O_XB + (size_t)T_ * LDK1 * 2;
constexpr size_t O_AQ = O_ACT;
constexpr size_t O_BQ = O_AQ + (size_t)T_ * 512 * 2;
constexpr size_t O_CQ = O_BQ + (size_t)T_ * 512 * 2;
constexpr size_t O_AK = O_CQ + (size_t)T_ * 512 * 2;
constexpr size_t O_AVT = O_AK + (size_t)T_ * 512 * 2;
constexpr size_t O_Z = O_AK;
constexpr size_t O_BK = O_AVT + (size_t)T_ * 512 * 2;
constexpr size_t SZ_S = (size_t)T_ * 128 * 2;
constexpr size_t O_BVT = O_BK + SZ_S;
constexpr size_t O_CK = O_BVT + SZ_S;
constexpr size_t O_CV = O_CK + SZ_S;
constexpr size_t O_KS = O_CV + SZ_S + 65536;
constexpr size_t O_VST = O_KS + SZ_S;
constexpr size_t O_KW = O_VST + SZ_S;
constexpr size_t O_VWT = O_KW + SZ_S;
constexpr size_t O_CGS = O_VWT + SZ_S;
constexpr size_t O_MGS = O_CGS + (size_t)T_ * 24 * 4;
constexpr size_t O_HID = O_MGS + (size_t)T_ * 3072 * 2;
constexpr size_t O_KC = O_HID + (size_t)16 * 256 * 256 * 2;
constexpr size_t O_VCT = O_KC + (size_t)8 * 256 * 64 * 2;
constexpr size_t O_U = O_ACT;
constexpr size_t O_BAR = O_VCT + (size_t)8 * 256 * 64 * 2;
constexpr size_t WS_END = O_BAR + 80 * 128;
static_assert(O_Z + (size_t)T_ * LDK1 * 2 <= O_CGS && O_U + (size_t)T_ * LDK4 * 2 <= O_HID, "u must fit in the aliased region");

struct P {
  const float* x; const float* w_in; const float* qk_gain; const float* diff_lambda; const float* diff_subln;
  const float* sinks; const float* cmp_pos; const float* cmp_w1; const float* cmp_w2; const float* w_branch;
  const float* w_out; const float* norm_mix; const float* norm_mlp; const float* w_up; const float* w_down;
  const float* rel_bias;
  float* out; unsigned char* ws;
};

DI int tidx() { int t = threadIdx.x; asm volatile("" : "+v"(t)); return t; }
DI bf16_t f2bf(float x) { unsigned u = __float_as_uint(x); u += 0x7fffu + ((u >> 16) & 1u); return (bf16_t)(u >> 16); }
DI float bf2f(bf16_t b) { return __uint_as_float(((unsigned)b) << 16); }
typedef float f32x2_t __attribute__((ext_vector_type(2)));
typedef __bf16 bf16x2_t __attribute__((ext_vector_type(2)));
DI unsigned pack2(float a, float b) { f32x2_t v = {a, b}; bf16x2_t r = __builtin_convertvector(v, bf16x2_t); return __builtin_bit_cast(unsigned, r); }
constexpr float LOG2E = 1.4426950408889634f;
constexpr float QSCL = 0.125f * LOG2E;
DI float ex2(float x) { return __builtin_amdgcn_exp2f(x); }
DI float sigmoidf_(float x) { return __builtin_amdgcn_rcpf(1.f + ex2(-LOG2E * x)); }
DI float xor32(float v) { return __shfl_xor(v, 32); }

DI void gemm_wide(const bf16_t* __restrict__ W, int ldw, const bf16_t* __restrict__ X, int ldx, int nkt,
                  f32x16 (&acc)[4][2], bf16_t* lds) {
  const int tid = tidx(), lane = tid & 63, wv = tid >> 6, wn = wv & 1, wm = wv >> 1;
  const int lr = lane & 31, lh = lane >> 5;
  const int lrow = tid >> 3, lkc = (tid & 7) * 8;
  const bf16_t* wp = W + (size_t)lrow * ldw + lkc;
  const bf16_t* xp = X + (size_t)lrow * ldx + lkc;
  const size_t wst = (size_t)64 * ldw, xst = (size_t)64 * ldx;
  u32x4 rw0, rw1, rw2, rw3, rx0, rx1, rx2, rx3;
#define GW_GLOAD(KT) { const size_t ko_ = (size_t)(KT) * 64; \
    rw0 = *(const u32x4*)(wp + ko_); rw1 = *(const u32x4*)(wp + wst + ko_); \
    rw2 = *(const u32x4*)(wp + 2 * wst + ko_); rw3 = *(const u32x4*)(wp + 3 * wst + ko_); \
    rx0 = *(const u32x4*)(xp + ko_); rx1 = *(const u32x4*)(xp + xst + ko_); \
    rx2 = *(const u32x4*)(xp + 2 * xst + ko_); rx3 = *(const u32x4*)(xp + 3 * xst + ko_); }
#define GW_LSTORE(BUF) { bf16_t* wb_ = lds + (BUF) * 2 * WT_E + lrow * LDT + lkc; bf16_t* xb_ = wb_ + WT_E; \
    *(u32x4*)(wb_) = rw0; *(u32x4*)(wb_ + 64 * LDT) = rw1; *(u32x4*)(wb_ + 128 * LDT) = rw2; *(u32x4*)(wb_ + 192 * LDT) = rw3; \
    *(u32x4*)(xb_) = rx0; *(u32x4*)(xb_ + 64 * LDT) = rx1; *(u32x4*)(xb_ + 128 * LDT) = rx2; *(u32x4*)(xb_ + 192 * LDT) = rx3; }
  u32x4 sw0, sw1, sw2, sw3, sx0, sx1, sx2, sx3;
#define GW_GLOAD_B(KT) { const size_t ko_ = (size_t)(KT) * 64; \
    sw0 = *(const u32x4*)(wp + ko_); sw1 = *(const u32x4*)(wp + wst + ko_); \
    sw2 = *(const u32x4*)(wp + 2 * wst + ko_); sw3 = *(const u32x4*)(wp + 3 * wst + ko_); \
    sx0 = *(const u32x4*)(xp + ko_); sx1 = *(const u32x4*)(xp + xst + ko_); \
    sx2 = *(const u32x4*)(xp + 2 * xst + ko_); sx3 = *(const u32x4*)(xp + 3 * xst + ko_); }
#define GW_LSTORE_B(BUF) { bf16_t* wb_ = lds + (BUF) * 2 * WT_E + lrow * LDT + lkc; bf16_t* xb_ = wb_ + WT_E; \
    *(u32x4*)(wb_) = sw0; *(u32x4*)(wb_ + 64 * LDT) = sw1; *(u32x4*)(wb_ + 128 * LDT) = sw2; *(u32x4*)(wb_ + 192 * LDT) = sw3; \
    *(u32x4*)(xb_) = sx0; *(u32x4*)(xb_ + 64 * LDT) = sx1; *(u32x4*)(xb_ + 128 * LDT) = sx2; *(u32x4*)(xb_ + 192 * LDT) = sx3; }
#define GW_KS(KT, ks) { \
      const bf16_t* wb = lds + ((KT) & 1) * 2 * WT_E + (wn * 128 + lr) * LDT + lh * 8; \
      const bf16_t* xb = lds + ((KT) & 1) * 2 * WT_E + WT_E + (wm * 64 + lr) * LDT + lh * 8; \
      const bf16x8 b0 = *(const bf16x8*)(xb + (ks) * 16), b1 = *(const bf16x8*)(xb + 32 * LDT + (ks) * 16); \
      const bf16x8 a0 = *(const bf16x8*)(wb + (ks) * 16), a1 = *(const bf16x8*)(wb + 32 * LDT + (ks) * 16); \
      const bf16x8 a2 = *(const bf16x8*)(wb + 64 * LDT + (ks) * 16), a3 = *(const bf16x8*)(wb + 96 * LDT + (ks) * 16); \
      acc[0][0] = MFMA32(a0, b0, acc[0][0]); acc[0][1] = MFMA32(a0, b1, acc[0][1]); \
      acc[1][0] = MFMA32(a1, b0, acc[1][0]); acc[1][1] = MFMA32(a1, b1, acc[1][1]); \
      acc[2][0] = MFMA32(a2, b0, acc[2][0]); acc[2][1] = MFMA32(a2, b1, acc[2][1]); \
      acc[3][0] = MFMA32(a3, b0, acc[3][0]); acc[3][1] = MFMA32(a3, b1, acc[3][1]); }
#define GW_ST2(BUF, OFF, R0, R1) { bf16_t* d_ = lds + (BUF) * 2 * WT_E + (OFF) + lrow * LDT + lkc; \
      *(u32x4*)(d_) = R0; *(u32x4*)(d_ + 64 * LDT) = R1; }
  __syncthreads();
  GW_GLOAD(0)
  GW_LSTORE(0)
  GW_GLOAD(1)
  GW_GLOAD_B(nkt > 2 ? 2 : nkt - 1)
  __syncthreads();
  for (int kt = 0; kt < nkt; kt += 2) {
    __builtin_amdgcn_sched_barrier(0);
    GW_ST2(1, 0, rw0, rw1)                         GW_KS(kt, 0)
    GW_ST2(1, 128 * LDT, rw2, rw3)                 GW_KS(kt, 1)
    GW_ST2(1, WT_E, rx0, rx1)                      GW_KS(kt, 2)
    GW_ST2(1, WT_E + 128 * LDT, rx2, rx3)          GW_KS(kt, 3)
    __builtin_amdgcn_sched_barrier(0);
    GW_GLOAD(kt + 3 < nkt ? kt + 3 : nkt - 1)
    __syncthreads();
    __builtin_amdgcn_sched_barrier(0);
    GW_ST2(0, 0, sw0, sw1)                         GW_KS(kt + 1, 0)
    GW_ST2(0, 128 * LDT, sw2, sw3)                 GW_KS(kt + 1, 1)
    GW_ST2(0, WT_E, sx0, sx1)                      GW_KS(kt + 1, 2)
    GW_ST2(0, WT_E + 128 * LDT, sx2, sx3)          GW_KS(kt + 1, 3)
    __builtin_amdgcn_sched_barrier(0);
    GW_GLOAD_B(kt + 4 < nkt ? kt + 4 : nkt - 1)
    __syncthreads();
  }
#undef GW_KS
#undef GW_ST2
#undef GW_GLOAD_B
#undef GW_LSTORE_B
#undef GW_GLOAD
#undef GW_LSTORE
}

constexpr int MID_E = (128 + 256) * LDT;
DI void gemm_mid(const bf16_t* __restrict__ W, int ldw, const bf16_t* __restrict__ X, size_t ldx, int mclamp, int kts,
                 int nkt, int m0, f32x16 (&acc)[2][2], bf16_t* lds) {
  const int tid = tidx(), lane = tid & 63, wv = tid >> 6, wn = wv & 1, wm = wv >> 1;
  const int lr = lane & 31, lh = lane >> 5;
  const int lrow = tid >> 3, lkc = (tid & 7) * 8;
  const bf16_t* wp = W + (size_t)lrow * ldw + lkc;
  const size_t wst = (size_t)64 * ldw;
  const bf16_t *xp0, *xp1, *xp2, *xp3;
  { int m;
    m = m0 + lrow;       m = m < mclamp ? m : mclamp; xp0 = X + (size_t)m * ldx + lkc;
    m = m0 + lrow + 64;  m = m < mclamp ? m : mclamp; xp1 = X + (size_t)m * ldx + lkc;
    m = m0 + lrow + 128; m = m < mclamp ? m : mclamp; xp2 = X + (size_t)m * ldx + lkc;
    m = m0 + lrow + 192; m = m < mclamp ? m : mclamp; xp3 = X + (size_t)m * ldx + lkc; }
  u32x4 rw0, rw1, rx0, rx1, rx2, rx3;
#define GM_GLOAD(KT) { \
    rw0 = *(const u32x4*)(wp + (size_t)(KT) * 64); rw1 = *(const u32x4*)(wp + wst + (size_t)(KT) * 64); \
    rx0 = *(const u32x4*)(xp0 + (size_t)(KT) * kts); rx1 = *(const u32x4*)(xp1 + (size_t)(KT) * kts); \
    rx2 = *(const u32x4*)(xp2 + (size_t)(KT) * kts); rx3 = *(const u32x4*)(xp3 + (size_t)(KT) * kts); }
#define GM_LSTORE(BUF) { bf16_t* wb_ = lds + (BUF) * MID_E + lrow * LDT + lkc; bf16_t* xb_ = wb_ + 128 * LDT; \
    *(u32x4*)(wb_) = rw0; *(u32x4*)(wb_ + 64 * LDT) = rw1; \
    *(u32x4*)(xb_) = rx0; *(u32x4*)(xb_ + 64 * LDT) = rx1; *(u32x4*)(xb_ + 128 * LDT) = rx2; *(u32x4*)(xb_ + 192 * LDT) = rx3; }
  __syncthreads();
  GM_GLOAD(0)
  GM_LSTORE(0)
  __syncthreads();
  for (int kt = 0; kt < nkt; ++kt) {
    const bool more = kt + 1 < nkt;
    if (more) GM_GLOAD(kt + 1)
    __builtin_amdgcn_sched_barrier(0);
    {
      const bf16_t* wb = lds + (kt & 1) * MID_E + (wn * 64 + lr) * LDT + lh * 8;
      const bf16_t* xb = lds + (kt & 1) * MID_E + 128 * LDT + (wm * 64 + lr) * LDT + lh * 8;
#pragma unroll
      for (int ks = 0; ks < 4; ++ks) {
        const bf16x8 a0 = *(const bf16x8*)(wb + ks * 16), a1 = *(const bf16x8*)(wb + 32 * LDT + ks * 16);
        const bf16x8 b0 = *(const bf16x8*)(xb + ks * 16), b1 = *(const bf16x8*)(xb + 32 * LDT + ks * 16);
        acc[0][0] = MFMA32(a0, b0, acc[0][0]); acc[0][1] = MFMA32(a0, b1, acc[0][1]);
        acc[1][0] = MFMA32(a1, b0, acc[1][0]); acc[1][1] = MFMA32(a1, b1, acc[1][1]);
      }
    }
    __builtin_amdgcn_sched_barrier(0);
    if (more) GM_LSTORE((kt + 1) & 1)
    __syncthreads();
  }
#undef GM_GLOAD
#undef GM_LSTORE
}

DI void zero_acc(f32x16 (&acc)[2][2]) {
#pragma unroll
  for (int a = 0; a < 2; ++a)
#pragma unroll
    for (int b = 0; b < 2; ++b)
#pragma unroll
      for (int i = 0; i < 16; ++i) acc[a][b][i] = 0.f;
}
DI void zero_acc8(f32x16 (&acc)[4][2]) {
#pragma unroll
  for (int a = 0; a < 4; ++a)
#pragma unroll
    for (int b = 0; b < 2; ++b)
#pragma unroll
      for (int i = 0; i < 16; ++i) acc[a][b][i] = 0.f;
}

DI const float* tile_rstd(const float* __restrict__ part, int m0, bf16_t* sm) {
  float* rs = (float*)((unsigned char*)sm + 139264);
  const int tid = tidx();
  if (tid < 256) {
    const float4* p4 = (const float4*)(part + (size_t)(m0 + tid) * 16);
    float s = 0.f;
#pragma unroll
    for (int i = 0; i < 4; ++i) { float4 v = p4[i]; s += v.x + v.y + v.z + v.w; }
    rs[tid] = rsqrtf(s * (1.f / 1024.f) + 1e-6f);
  }
  __syncthreads();
  return rs;
}
DI float row_rstd(const float* __restrict__ part, int m) {
  const float4* p4 = (const float4*)(part + (size_t)m * 16);
  float s = 0.f;
#pragma unroll
  for (int i = 0; i < 4; ++i) { float4 v = p4[i]; s += v.x + v.y + v.z + v.w; }
  return rsqrtf(s * (1.f / 1024.f) + 1e-6f);
}

struct Geo { int xcd, loc, nloc; };
struct TileWalk {
  int xcd, loc, nloc, ng, NT, g, i;
  DI TileWalk(int NT_, const Geo& ge) : xcd(ge.xcd), loc(ge.loc), nloc(ge.nloc), ng((NT_ + 7) >> 3), NT(NT_), g(0), i(ge.loc) {}
  DI bool next(int& mt, int& nt) {
    for (;;) {
      if (g >= ng) return false;
      if (i >= 64) { i = loc; ++g; continue; }
      mt = xcd * 8 + (i & 7); nt = g * 8 + (i >> 3);
      i += nloc;
      if (nt < NT) return true;
    }
  }
};

DI int next_task(unsigned* ctr, bf16_t* sm) {
  volatile int* slot = (volatile int*)((unsigned char*)sm + LDS_BYTES - 16);
  __syncthreads();
  if (threadIdx.x == 0) *slot = (int)__hip_atomic_fetch_add(ctr, 1u, __ATOMIC_RELAXED, __HIP_MEMORY_SCOPE_AGENT);
  __syncthreads();
  return __builtin_amdgcn_readfirstlane(*slot);
}

DI void tr_tile(const float* __restrict__ src, int ldS, int C, int r0, int c0, bf16_t* __restrict__ dst, int ldd,
                const float* __restrict__ g, int remap, float* tl) {
  const int tid = tidx() & 255;
  __syncthreads();
  {
    const int c4 = (tid & 15) * 4;
#pragma unroll
    for (int i = 0; i < 4; ++i) {
      const int r = (tid >> 4) + 16 * i;
      float4 v = make_float4(0.f, 0.f, 0.f, 0.f);
      if (c0 + c4 < C) {
        v = *(const float4*)(src + (size_t)(r0 + r) * ldS + c0 + c4);
        if (g) { const float gg = g[r0 + r]; v.x *= gg; v.y *= gg; v.z *= gg; v.w *= gg; }
      }
      float* t4 = tl + r * 65 + c4;
      t4[0] = v.x; t4[1] = v.y; t4[2] = v.z; t4[3] = v.w;
    }
  }
  __syncthreads();
  {
    const int c = tid >> 2, rq = (tid & 3) * 16;
    if (c0 + c < C) {
      int dr = c0 + c;
      if (remap) { if (dr >= 3608) dr -= 24; else if (dr >= 3584) dr += 6656 - 3584; }
      unsigned w[8];
#pragma unroll
      for (int k = 0; k < 8; ++k) w[k] = pack2(tl[(rq + 2 * k) * 65 + c], tl[(rq + 2 * k + 1) * 65 + c]);
      uint4* d4 = (uint4*)(dst + (size_t)dr * ldd + r0 + rq);
      d4[0] = make_uint4(w[0], w[1], w[2], w[3]);
      d4[1] = make_uint4(w[4], w[5], w[6], w[7]);
    }
  }
}

DI void tr_tile_wave(const float* __restrict__ src, int ldS, int C, int r0, int c0, bf16_t* __restrict__ dst, int ldd,
                     const float* __restrict__ g, int remap, float* tl) {
  const int lane = tidx() & 63;
  {
    const int c4 = (lane & 15) * 4;
    float4 v[16];
#pragma unroll
    for (int i = 0; i < 16; ++i) {
      const int r = (lane >> 4) + 4 * i;
      v[i] = make_float4(0.f, 0.f, 0.f, 0.f);
      if (c0 + c4 < C) v[i] = *(const float4*)(src + (size_t)(r0 + r) * ldS + c0 + c4);
    }
#pragma unroll
    for (int i = 0; i < 16; ++i) {
      const int r = (lane >> 4) + 4 * i;
      const float gg = g ? g[r0 + r] : 1.f;
      float* t4 = tl + r * 65 + c4;
      t4[0] = v[i].x * gg; t4[1] = v[i].y * gg; t4[2] = v[i].z * gg; t4[3] = v[i].w * gg;
    }
  }
  __builtin_amdgcn_fence(__ATOMIC_RELEASE, "wavefront");
  __builtin_amdgcn_wave_barrier();
#pragma unroll
  for (int j = 0; j < 4; ++j) {
    const int c = (lane >> 2) + 16 * j, rq = (lane & 3) * 16;
    if (c0 + c < C) {
      int dr = c0 + c;
      if (remap) { if (dr >= 3608) dr -= 24; else if (dr >= 3584) dr += 6656 - 3584; }
      unsigned w[8];
#pragma unroll
      for (int k = 0; k < 8; ++k) w[k] = pack2(tl[(rq + 2 * k) * 65 + c], tl[(rq + 2 * k + 1) * 65 + c]);
      uint4* d4 = (uint4*)(dst + (size_t)dr * ldd + r0 + rq);
      d4[0] = make_uint4(w[0], w[1], w[2], w[3]);
      d4[1] = make_uint4(w[4], w[5], w[6], w[7]);
    }
  }
  __builtin_amdgcn_wave_barrier();
}

DI void phase0(const P& p, bf16_t* sm) {
  const int tid5 = tidx(), half = tid5 >> 8, tid = tid5 & 255, lane = tid5 & 63, wv8 = tid5 >> 6;
  float* tl = (float*)sm + half * (64 * 65);
  constexpr int NTR_L = 1680 + 384 + 256 + 1024 + 1024 + 256 + 8;
  {
    float* tlw = (float*)sm + wv8 * (64 * 65);
    for (int t = blockIdx.x * 8 + wv8; t < NTR_L * NL; t += gridDim.x * 8) {
      const int layer = t / NTR_L; int r = t % NTR_L;
      if (r < 1680) {
        tr_tile_wave(p.w_in + (size_t)layer * 1024 * NIN, NIN, NIN, (r / 105) * 64, (r % 105) * 64,
                     (bf16_t*)(p.ws + O_WIN + layer * SZ_WIN), LDK1, p.norm_mix + layer * 1024, 1, tlw);
      } else if ((r -= 1680) < 384) {
        const int n3 = r / 128; r %= 128;
        tr_tile_wave(p.w_branch + ((size_t)layer * 3 + n3) * 512 * 1024, 1024, 1024, (r / 16) * 64, (r % 16) * 64,
                     (bf16_t*)(p.ws + O_WBR + layer * SZ_WBR) + (size_t)n3 * 1024 * 512, 512, nullptr, 0, tlw);
      } else if ((r -= 384) < 256) {
        tr_tile_wave(p.w_out + (size_t)layer * 1024 * 1024, 1024, 1024, (r / 16) * 64, (r % 16) * 64,
                     (bf16_t*)(p.ws + O_WO + layer * SZ_WO), LDK1, nullptr, 0, tlw);
      } else if ((r -= 256) < 1024) {
        tr_tile_wave(p.w_up + (size_t)layer * 1024 * 4096, 4096, 4096, (r / 64) * 64, (r % 64) * 64,
                     (bf16_t*)(p.ws + O_WUP + layer * SZ_WUP), LDK1, p.norm_mlp + layer * 1024, 0, tlw);
      } else if ((r -= 1024) < 1024) {
        tr_tile_wave(p.w_down + (size_t)layer * 4096 * 1024, 1024, 1024, (r / 16) * 64, (r % 16) * 64,
                     (bf16_t*)(p.ws + O_WDN + layer * SZ_WDN), LDK4, nullptr, 0, tlw);
      } else if ((r -= 1024) < 256) {
        const int kv = r / 128; r %= 128;
        tr_tile_wave(p.cmp_w1 + ((size_t)layer * 2 + kv) * 2048 * 256, 256, 256, (r / 4) * 64, (r % 4) * 64,
                     (bf16_t*)(p.ws + O_W1 + layer * SZ_W1) + (size_t)kv * 256 * 2048, 2048, nullptr, 0, tlw);
      } else {
        r -= 256;
        const int kv = r / 4; r %= 4;
        tr_tile_wave(p.cmp_w2 + ((size_t)layer * 2 + kv) * 256 * 64, 64, 64, r * 64, 0,
                     (bf16_t*)(p.ws + O_W2 + layer * SZ_W2) + (size_t)kv * 128 * 256, 256, nullptr, 0, tlw);
      }
    }
    __syncthreads();
  }
  constexpr int J_TR = 0;
  constexpr int J_X = J_TR + T_ / 8;
  constexpr int J_POS = J_X + 256;
  constexpr int J_MISC = J_POS + 1;
  constexpr int ZW_PER = ((NINP - NIN) * LDK1 / 8 + 511) / 512;
  constexpr int J_ZW = J_MISC + NL * ZW_PER;
  constexpr int J_ZW2 = J_ZW + 32;
  for (int job = blockIdx.x; job < J_ZW2; job += gridDim.x) {
    if (job < J_TR) {
      const int t = job * 2 + half;
      const int layer = t / NTR_L; int r = t % NTR_L;
      if (r < 1680) {
        tr_tile(p.w_in + (size_t)layer * 1024 * NIN, NIN, NIN, (r / 105) * 64, (r % 105) * 64,
                (bf16_t*)(p.ws + O_WIN + layer * SZ_WIN), LDK1, p.norm_mix + layer * 1024, 1, tl);
      } else if ((r -= 1680) < 384) {
        const int n3 = r / 128; r %= 128;
        tr_tile(p.w_branch + ((size_t)layer * 3 + n3) * 512 * 1024, 1024, 1024, (r / 16) * 64, (r % 16) * 64,
                (bf16_t*)(p.ws + O_WBR + layer * SZ_WBR) + (size_t)n3 * 1024 * 512, 512, nullptr, 0, tl);
      } else if ((r -= 384) < 256) {
        tr_tile(p.w_out + (size_t)layer * 1024 * 1024, 1024, 1024, (r / 16) * 64, (r % 16) * 64,
                (bf16_t*)(p.ws + O_WO + layer * SZ_WO), LDK1, nullptr, 0, tl);
      } else if ((r -= 256) < 1024) {
        tr_tile(p.w_up + (size_t)layer * 1024 * 4096, 4096, 4096, (r / 64) * 64, (r % 64) * 64,
                (bf16_t*)(p.ws + O_WUP + layer * SZ_WUP), LDK1, p.norm_mlp + layer * 1024, 0, tl);
      } else if ((r -= 1024) < 1024) {
        tr_tile(p.w_down + (size_t)layer * 4096 * 1024, 1024, 1024, (r / 16) * 64, (r % 16) * 64,
                (bf16_t*)(p.ws + O_WDN + layer * SZ_WDN), LDK4, nullptr, 0, tl);
      } else if ((r -= 1024) < 256) {
        const int kv = r / 128; r %= 128;
        tr_tile(p.cmp_w1 + ((size_t)layer * 2 + kv) * 2048 * 256, 256, 256, (r / 4) * 64, (r % 4) * 64,
                (bf16_t*)(p.ws + O_W1 + layer * SZ_W1) + (size_t)kv * 256 * 2048, 2048, nullptr, 0, tl);
      } else {
        r -= 256;
        const int kv = r / 4; r %= 4;
        tr_tile(p.cmp_w2 + ((size_t)layer * 2 + kv) * 256 * 64, 64, 64, r * 64, 0,
                (bf16_t*)(p.ws + O_W2 + layer * SZ_W2) + (size_t)kv * 128 * 256, 256, nullptr, 0, tl);
      }
    } else if (job < J_X) {
      const int row = (job - J_TR) * 8 + wv8;
      const float4* src = (const float4*)(p.x + (size_t)row * 1024);
      bf16_t* xb = (bf16_t*)(p.ws + O_XB) + (size_t)row * LDK1;
      float ss = 0.f;
#pragma unroll
      for (int i = 0; i < 4; ++i) {
        float4 v = src[lane + 64 * i];
        ss += v.x * v.x + v.y * v.y + v.z * v.z + v.w * v.w;
        *(uint2*)(xb + (lane + 64 * i) * 4) = make_uint2(pack2(v.x, v.y), pack2(v.z, v.w));
      }
#pragma unroll
      for (int o = 32; o >= 1; o >>= 1) ss += __shfl_xor(ss, o);
      float* part = (float*)(p.ws + O_PART) + (size_t)row * 16;
      if (lane < 16) part[lane] = lane == 0 ? ss : 0.f;
    } else if (job < J_POS) {
      const int jj = job - J_X; const int unit = jj >> 2, kq = jj & 3, lk = unit >> 3, ng = unit & 7;
      const int col = ng * 32 + (tid5 & 31), ksl = tid5 >> 5;
      const float* pos = p.cmp_pos + (size_t)lk * 2048;
      const float* w1 = p.cmp_w1 + (size_t)lk * 2048 * 256;
      float s = 0.f;
      const int k0 = kq * 512 + ksl * 32;
#pragma unroll 8
      for (int k = k0; k < k0 + 32; ++k) s += pos[k] * w1[(size_t)k * 256 + col];
      float* red = (float*)sm;
      __syncthreads();
      red[tid5] = s;
      __syncthreads();
      if (tid5 < 32) {
        float t = 0.f;
        for (int q = 0; q < 16; ++q) t += red[q * 32 + tid5];
        ((float*)(p.ws + O_POSW1))[(lk * 4 + kq) * 256 + col] = t;
      }
    } else if (job < J_MISC) {
      float* tabs = (float*)(p.ws + O_TABS);
      for (int i = tid5; i < 20 * 129; i += NTHR) {
        const int h = i / 129, d = i % 129;
        int bk;
        if (d < 16) bk = d;
        else { bk = 16 + (int)(logf((float)d / 16.f) / 2.0794415416798357f * 16.f); if (bk > 31) bk = 31; }
        tabs[h * 132 + d] = p.rel_bias[bk * 20 + h] * LOG2E;
      }
      if (wv8 == 0) {
        for (int layer = 0; layer < NL; ++layer) {
          const float* lm = p.diff_lambda + layer * 256;
          float a = lm[lane] * lm[64 + lane], b = lm[128 + lane] * lm[192 + lane];
#pragma unroll
          for (int o = 32; o >= 1; o >>= 1) { a += __shfl_xor(a, o); b += __shfl_xor(b, o); }
          const float li = 0.8f - 0.6f * expf(-0.3f * (float)layer);
          if (lane == 0) ((float*)(p.ws + O_LAM))[layer] = expf(a) - expf(b) + li;
        }
      }
    } else if (job < J_ZW) {
      const int jj = job - J_MISC; const int layer = jj / ZW_PER, q = jj % ZW_PER;
      uint4* d = (uint4*)(p.ws + O_WIN + layer * SZ_WIN + (size_t)NIN * LDK1 * 2) + q * 512 + tid5;
      if (q * 512 + tid5 < (NINP - NIN) * LDK1 / 8) *d = make_uint4(0, 0, 0, 0);
    } else {
      const int jj = job - J_ZW; const int lk = jj >> 2, q = jj & 3;
      uint4* d = (uint4*)(p.ws + O_W2 + (size_t)lk * 128 * 256 * 2 + 64 * 256 * 2) + q * 512 + tid5;
      *d = make_uint4(0, 0, 0, 0);
    }
  }
}

DI bool epi_inproj_chunk(const P& p, int layer, int ch, int m0w, f32x16 (&a0)[2], f32x16 (&a1)[2], bf16_t* stg, int cp,
                         bf16_t*& rdst, int& rldd, int& rcoff, float rs0, float rs1) {
  const int lane = tidx() & 63;
  const int lr = lane & 31, lh = lane >> 5;
  enum { NORM, RAW, TRANS, SIG, CG };
  int type = RAW, ldd = 512, coff = 0, nh = 2, dv = 64, hd = 0, doff = 0;
  bf16_t* dst = nullptr; const float* gain = nullptr; float scl = 1.f;
  const float* gains = p.qk_gain + layer * 512;
  unsigned char* ws = p.ws;
  if (ch < 8) { type = NORM; dst = (bf16_t*)(ws + O_AQ); coff = ch * 64; gain = gains; scl = QSCL; }
  else if (ch < 16) { type = NORM; dst = (bf16_t*)(ws + O_AK); coff = (ch - 8) * 64; gain = gains + 64; }
  else if (ch < 24) { type = TRANS; dst = (bf16_t*)(ws + O_AVT); nh = 4; dv = 128; hd = (ch - 16) >> 1; doff = ((ch - 16) & 1) * 64; }
  else if (ch < 32) { type = NORM; dst = (bf16_t*)(ws + O_BQ); coff = (ch - 24) * 64; gain = gains + 128; scl = QSCL; }
  else if (ch < 34) { type = NORM; dst = (bf16_t*)(ws + O_BK); ldd = 128; coff = (ch - 32) * 64; gain = gains + 192; }
  else if (ch < 36) { type = TRANS; dst = (bf16_t*)(ws + O_BVT); hd = ch - 34; }
  else if (ch < 44) { type = NORM; dst = (bf16_t*)(ws + O_CQ); coff = (ch - 36) * 64; gain = gains + 256; scl = QSCL; }
  else if (ch < 46) { type = RAW; dst = (bf16_t*)(ws + O_CK); ldd = 128; coff = (ch - 44) * 64; }
  else if (ch < 48) { type = RAW; dst = (bf16_t*)(ws + O_CV); ldd = 128; coff = (ch - 46) * 64; }
  else if (ch < 50) { type = NORM; dst = (bf16_t*)(ws + O_KS); ldd = 128; coff = (ch - 48) * 64; gain = gains + 384; }
  else if (ch < 52) { type = TRANS; dst = (bf16_t*)(ws + O_VST); hd = ch - 50; }
  else if (ch < 54) { type = NORM; dst = (bf16_t*)(ws + O_KW); ldd = 128; coff = (ch - 52) * 64; gain = gains + 448; }
  else if (ch < 56) { type = TRANS; dst = (bf16_t*)(ws + O_VWT); hd = ch - 54; }
  else if (ch < 104) { type = SIG; dst = (bf16_t*)(ws + O_MGS); ldd = 3072; coff = (ch - 56) * 64; }
  else if (ch == 104) { type = CG; }
  else return false;
  rdst = dst; rldd = ldd; rcoff = coff;
#pragma unroll
  for (int mt = 0; mt < 2; ++mt) {
    const int m = m0w + mt * 32 + lr;
    const float rs = mt ? rs1 : rs0;
    float v[2][16];
    float ss = 0.f;
#pragma unroll
    for (int i = 0; i < 16; ++i) { float t = a0[mt][i] * rs; v[0][i] = t; ss += t * t; }
#pragma unroll
    for (int i = 0; i < 16; ++i) { float t = a1[mt][i] * rs; v[1][i] = t; ss += t * t; }
    if (type == NORM) {
      ss += xor32(ss);
      const float r = rsqrtf(ss * (1.f / 64.f) + 1e-6f) * scl;
#pragma unroll
      for (int nt = 0; nt < 2; ++nt)
#pragma unroll
        for (int qd = 0; qd < 4; ++qd) {
          const int n = nt * 32 + 8 * qd + 4 * lh;
          const float4 g4 = *(const float4*)(gain + n);
          *(uint2*)(stg + (mt * 32 + lr) * 136 + cp * 64 + n) =
              make_uint2(pack2(v[nt][4 * qd] * r * g4.x, v[nt][4 * qd + 1] * r * g4.y),
                         pack2(v[nt][4 * qd + 2] * r * g4.z, v[nt][4 * qd + 3] * r * g4.w));
        }
    } else if (type == RAW || type == SIG) {
#pragma unroll
      for (int nt = 0; nt < 2; ++nt)
#pragma unroll
        for (int qd = 0; qd < 4; ++qd) {
          const int n = nt * 32 + 8 * qd + 4 * lh;
          float a = v[nt][4 * qd], b = v[nt][4 * qd + 1], c = v[nt][4 * qd + 2], d = v[nt][4 * qd + 3];
          if (type == SIG) { a = sigmoidf_(a); b = sigmoidf_(b); c = sigmoidf_(c); d = sigmoidf_(d); }
          if (type == SIG)
            { typedef unsigned u32x2_t __attribute__((ext_vector_type(2))); u32x2_t gv; gv[0] = pack2(a, b); gv[1] = pack2(c, d);
              __builtin_nontemporal_store(gv, (u32x2_t*)(dst + ((size_t)((coff + n) >> 2) * T_ + m) * 4)); }
          else
            *(uint2*)(stg + (mt * 32 + lr) * 136 + cp * 64 + n) = make_uint2(pack2(a, b), pack2(c, d));
        }
    } else if (type == TRANS) {
      const int b = m >> 12, s = m & 4095;
      bf16_t* base = dst + ((size_t)(b * nh + hd) * dv + doff) * S_ + s;
#pragma unroll
      for (int nt = 0; nt < 2; ++nt)
#pragma unroll
        for (int i = 0; i < 16; ++i) {
          const int n = nt * 32 + 8 * (i >> 2) + 4 * lh + (i & 3);
          base[(size_t)n * S_] = f2bf(v[nt][i]);
        }
    } else {
      float* cg = (float*)(ws + O_CGS) + (size_t)m * 24;
#pragma unroll
      for (int i = 0; i < 16; ++i) {
        const int n = 8 * (i >> 2) + 4 * lh + (i & 3);
        if (n < 24) cg[n] = sigmoidf_(v[0][i]);
      }
    }
  }
  return type == NORM || type == RAW;
}

template <bool NT = false>
DI void stage_rows_store(const bf16_t* stg, bf16_t* dst, size_t ldd, int m0w) {
  const int lane = tidx() & 63;
#pragma unroll
  for (int it = 0; it < 16; ++it) {
    const int row = it * 4 + (lane >> 4), c16 = lane & 15;
    const u32x4 v = *(const u32x4*)(stg + row * 136 + c16 * 8);
    u32x4* d = (u32x4*)(dst + (size_t)(m0w + row) * ldd + c16 * 8);
    if (NT) __builtin_nontemporal_store(v, d);
    else *d = v;
  }
}

DI void phase_inproj(const P& p, int layer, bf16_t* sm, const Geo& ge) {
  const bf16_t* W = (const bf16_t*)(p.ws + O_WIN + layer * SZ_WIN);
  const bf16_t* X = (const bf16_t*)(p.ws + O_XB);
  TileWalk tw(27, ge);
  int mt, nt, mt_have = -1;
  float rs0 = 0.f, rs1 = 0.f;
  while (tw.next(mt, nt)) {
    if (mt != mt_have) {
      const int lane_ = tidx() & 63, wm_ = (tidx() >> 6) >> 1;
      rs0 = row_rstd((const float*)(p.ws + O_PART), mt * 256 + wm_ * 64 + (lane_ & 31));
      rs1 = row_rstd((const float*)(p.ws + O_PART), mt * 256 + wm_ * 64 + 32 + (lane_ & 31));
      mt_have = mt;
    }
    f32x16 acc[4][2]; zero_acc8(acc);
    gemm_wide(W + (size_t)nt * 256 * LDK1, LDK1, X + (size_t)mt * 256 * LDK1, LDK1, 16, acc, sm);
    const int wv = tidx() >> 6, wn = wv & 1, wm = wv >> 1;
    bf16_t* stg = sm + wv * (64 * 136);
    bf16_t *d0 = nullptr, *d1 = nullptr; int ld0 = 0, ld1 = 0, co0 = 0, co1 = 0;
    const bool s0 = epi_inproj_chunk(p, layer, nt * 4 + wn * 2, mt * 256 + wm * 64, acc[0], acc[1], stg, 0, d0, ld0, co0, rs0, rs1);
    const bool s1 = epi_inproj_chunk(p, layer, nt * 4 + wn * 2 + 1, mt * 256 + wm * 64, acc[2], acc[3], stg, 1, d1, ld1, co1, rs0, rs1);
    if (s0 && s1) stage_rows_store(stg, d0 + co0, ld0, mt * 256 + wm * 64);
  }
}

template <int NDT, int MODE, bool ALLON>
DI void attn_tile(const bf16_t* Kl, int kst, const bf16_t* Vl, const bf16x8 (&q)[4], f32x16 (&O)[NDT], float& m, float& l,
                  int kbase, int qp, int win, float cbias, const float* tab, bool lane_on) {
  const int lane = tidx() & 63, lr = lane & 31, lh = lane >> 5;
  f32x16 s[2];
#pragma unroll
  for (int st = 0; st < 2; ++st) {
#pragma unroll
    for (int i = 0; i < 16; ++i) s[st][i] = 0.f;
  }
#pragma unroll
  for (int ks = 0; ks < 4; ++ks) {
    const bf16x8 k0 = *(const bf16x8*)(Kl + lr * kst + ks * 16 + lh * 8);
    const bf16x8 k1 = *(const bf16x8*)(Kl + (32 + lr) * kst + ks * 16 + lh * 8);
    s[0] = MFMA32(k0, q[ks], s[0]);
    s[1] = MFMA32(k1, q[ks], s[1]);
  }
  float alpha, psum = 0.f;
  if (MODE == 0) {
    float tmax = fmaxf(s[0][0], s[1][0]);
#pragma unroll
    for (int i = 1; i < 16; ++i) tmax = fmaxf(tmax, fmaxf(s[0][i], s[1][i]));
    tmax = fmaxf(tmax, xor32(tmax)) + cbias;
    if (!ALLON) tmax = lane_on ? tmax : -1e30f;
    const float mn = fmaxf(m, tmax);
    alpha = ex2(m - mn);
    m = mn;
    const float mc = (ALLON || lane_on) ? mn - cbias : 1e30f;
#pragma unroll
    for (int st = 0; st < 2; ++st)
#pragma unroll
      for (int i = 0; i < 16; ++i) { const float pe = ex2(s[st][i] - mc); psum += pe; s[st][i] = pe; }
  } else {
    float tmax = -1e30f;
#pragma unroll
    for (int st = 0; st < 2; ++st)
#pragma unroll
      for (int i = 0; i < 16; ++i) {
        const int key = kbase + st * 32 + 8 * (i >> 2) + 4 * lh + (i & 3);
        float v;
        if (MODE == 1) {
          const int dist = qp - key;
          const bool ok = (ALLON || lane_on) && dist >= 0 && dist < win;
          const int di = dist < 0 ? 0 : (dist > 128 ? 128 : dist);
          v = ok ? s[st][i] + tab[di] : -1e30f;
        } else {
          v = (16 * key + 31 <= qp) ? s[st][i] : -1e30f;
        }
        s[st][i] = v;
        tmax = fmaxf(tmax, v);
      }
    tmax = fmaxf(tmax, xor32(tmax));
    const float mn = fmaxf(m, tmax);
    alpha = ex2(m - mn);
    m = mn;
#pragma unroll
    for (int st = 0; st < 2; ++st)
#pragma unroll
      for (int i = 0; i < 16; ++i) {
        const float pe = s[st][i] > -5e29f ? ex2(s[st][i] - mn) : 0.f;
        psum += pe;
        s[st][i] = pe;
      }
  }
  l = l * alpha + psum;
  if (__ballot(alpha != 1.f)) {
#pragma unroll
    for (int dt = 0; dt < NDT; ++dt)
#pragma unroll
      for (int i = 0; i < 16; ++i) O[dt][i] *= alpha;
  }
#pragma unroll
  for (int st = 0; st < 2; ++st)
#pragma unroll
    for (int sk = 0; sk < 2; ++sk) {
      u32x4 pu;
      pu[0] = pack2(s[st][8 * sk + 0], s[st][8 * sk + 1]);
      pu[1] = pack2(s[st][8 * sk + 2], s[st][8 * sk + 3]);
      pu[2] = pack2(s[st][8 * sk + 4], s[st][8 * sk + 5]);
      pu[3] = pack2(s[st][8 * sk + 6], s[st][8 * sk + 7]);
      const bf16x8 pf = __builtin_bit_cast(bf16x8, pu);
#pragma unroll
      for (int dt = 0; dt < NDT; ++dt) {
        const bf16_t* vp = Vl + (dt * 32 + lr) * 72 + st * 32 + sk * 16 + 4 * lh;
        const uint2 v0 = *(const uint2*)(vp);
        const uint2 v1 = *(const uint2*)(vp + 8);
        u32x4 vu; vu[0] = v0.x; vu[1] = v0.y; vu[2] = v1.x; vu[3] = v1.y;
        O[dt] = MFMA32(__builtin_bit_cast(bf16x8, vu), pf, O[dt]);
      }
    }
}

DI float gelu_tanh(float x) {
  const float u = 0.7978845608028654f * (x + 0.044715f * x * x * x);
  const float e = __expf(2.f * u);
  const float th = 1.f - 2.f * __builtin_amdgcn_rcpf(e + 1.f);
  return 0.5f * x * (1.f + th);
}

DI void task_compress(const P& p, int layer, int task, bf16_t* sm) {
  const int tid = tidx(), lane = tid & 63, wv = tid >> 6, wn = wv & 1, wm = wv >> 1;
  const int lr = lane & 31, lh = lane >> 5;
  const int b = task & 3, g = (task >> 2) & 1, kv = task >> 3;
  const bf16_t* src = (const bf16_t*)(p.ws + (kv ? O_CV : O_CK)) + (size_t)b * S_ * 128 + g * 64;
  const bf16_t* W1 = (const bf16_t*)(p.ws + O_W1 + layer * SZ_W1) + (size_t)kv * 256 * 2048;
  const bf16_t* W2 = (const bf16_t*)(p.ws + O_W2 + layer * SZ_W2) + (size_t)kv * 128 * 256;
  bf16_t* hid = (bf16_t*)(p.ws + O_HID) + (size_t)((kv * 2 + g) * 4 + b) * 65536;
  const float* pw = (const float*)(p.ws + O_POSW1) + (layer * 2 + kv) * 1024;
  for (int nt2 = 0; nt2 < 2; ++nt2) {
    f32x16 acc[2][2]; zero_acc(acc);
    gemm_mid(W1 + (size_t)nt2 * 128 * 2048, 2048, src, 16 * 128, 254, 128, 32, 0, acc, sm);
#pragma unroll
    for (int mt = 0; mt < 2; ++mt) {
      const int m = wm * 64 + mt * 32 + lr;
#pragma unroll
      for (int nt = 0; nt < 2; ++nt)
#pragma unroll
        for (int qd = 0; qd < 4; ++qd) {
          const int n = nt2 * 128 + wn * 64 + nt * 32 + 8 * qd + 4 * lh;
          float4 pw4 = *(const float4*)(pw + n);
          { const float4 a1 = *(const float4*)(pw + 256 + n), a2 = *(const float4*)(pw + 512 + n), a3 = *(const float4*)(pw + 768 + n);
            pw4.x = ((pw4.x + a1.x) + a2.x) + a3.x; pw4.y = ((pw4.y + a1.y) + a2.y) + a3.y;
            pw4.z = ((pw4.z + a1.z) + a2.z) + a3.z; pw4.w = ((pw4.w + a1.w) + a2.w) + a3.w; }
          *(uint2*)(hid + (size_t)m * 256 + n) =
              make_uint2(pack2(gelu_tanh(acc[nt][mt][4 * qd] + pw4.x), gelu_tanh(acc[nt][mt][4 * qd + 1] + pw4.y)),
                         pack2(gelu_tanh(acc[nt][mt][4 * qd + 2] + pw4.z), gelu_tanh(acc[nt][mt][4 * qd + 3] + pw4.w)));
        }
    }
  }
  __threadfence();
  __syncthreads();
  {
    f32x16 acc[2][2]; zero_acc(acc);
    gemm_mid(W2, 256, hid, 256, 1 << 30, 64, 4, 0, acc, sm);
    if (wn == 0) {
      const float* gain = p.qk_gain + layer * 512 + 320;
#pragma unroll
      for (int mt = 0; mt < 2; ++mt) {
        const int m = wm * 64 + mt * 32 + lr;
        if (kv == 0) {
          float ss = 0.f;
#pragma unroll
          for (int nt = 0; nt < 2; ++nt)
#pragma unroll
            for (int i = 0; i < 16; ++i) ss += acc[nt][mt][i] * acc[nt][mt][i];
          ss += xor32(ss);
          const float r = rsqrtf(ss * (1.f / 64.f) + 1e-6f);
          bf16_t* kc = (bf16_t*)(p.ws + O_KC) + ((size_t)(b * 2 + g) * 256 + m) * 64;
#pragma unroll
          for (int nt = 0; nt < 2; ++nt)
#pragma unroll
            for (int qd = 0; qd < 4; ++qd) {
              const int n = nt * 32 + 8 * qd + 4 * lh;
              const float4 g4 = *(const float4*)(gain + n);
              *(uint2*)(kc + n) = make_uint2(pack2(acc[nt][mt][4 * qd] * r * g4.x, acc[nt][mt][4 * qd + 1] * r * g4.y),
                                             pack2(acc[nt][mt][4 * qd + 2] * r * g4.z, acc[nt][mt][4 * qd + 3] * r * g4.w));
            }
        } else {
          bf16_t* vc = (bf16_t*)(p.ws + O_VCT) + (size_t)(b * 2 + g) * 64 * 256 + m;
#pragma unroll
          for (int nt = 0; nt < 2; ++nt)
#pragma unroll
            for (int i = 0; i < 16; ++i) {
              const int n = nt * 32 + 8 * (i >> 2) + 4 * lh + (i & 3);
              vc[(size_t)n * 256] = f2bf(acc[nt][mt][i]);
            }
        }
      }
    }
  }
}

DI void task_attnA(const P& p, int layer, int task, bf16_t* sm, int dm) {
  const int tid = tidx(), lane = tid & 63, wv = tid >> 6, c = wv & 1, qs = wv >> 1;
  const int lr = lane & 31, lh = lane >> 5;
  const int qb = 31 - (task >> 4), bh = task & 15, b = bh >> 2, h = bh & 3;
  float* tab = (float*)((unsigned char*)sm + 71680);
  bf16x8* qlds = (bf16x8*)((unsigned char*)sm + 72704) + wv * 256 + lane;
  float* xbuf = (float*)((unsigned char*)sm);
  __syncthreads();
  if (tid < 129) tab[tid] = ((const float*)(p.ws + O_TABS))[h * 132 + tid];
  const int q0 = qb * 128, qmin = q0 + qs * 32, qp = qmin + lr;
  bf16_t* aq = (bf16_t*)(p.ws + O_AQ);
  {
    const bf16_t* qptr = aq + (size_t)(b * S_ + qp) * 512 + h * 128 + c * 64 + lh * 8;
#pragma unroll
    for (int ks = 0; ks < 4; ++ks) qlds[ks * 64] = *(const bf16x8*)(qptr + ks * 16);
  }
  f32x16 O[4];
#pragma unroll
  for (int dt = 0; dt < 4; ++dt)
#pragma unroll
    for (int i = 0; i < 16; ++i) O[dt][i] = 0.f;
  float m = -1e30f, l = 0.f;
  const bf16_t* kg = (const bf16_t*)(p.ws + O_AK) + (size_t)b * S_ * 512 + h * 128;
  const bf16_t* vg = (const bf16_t*)(p.ws + O_AVT) + (size_t)((b * 4 + h) * 128) * S_;
  u32x4 rk0, rk1, rv0, rv1;
#define A_GLOAD(i, KT) { const int chk = tid + 512 * i; \
    rk##i = *(const u32x4*)(kg + (size_t)((KT) * 64 + (chk >> 4)) * 512 + (chk & 15) * 8); \
    rv##i = *(const u32x4*)(vg + (size_t)(chk >> 3) * S_ + (KT) * 64 + (chk & 7) * 8); }
#define A_LSTORE(i) { const int chk = tid + 512 * i; \
    *(u32x4*)(Kl + (chk >> 4) * 136 + (chk & 15) * 8) = rk##i; \
    *(u32x4*)(Kl + 64 * 136 + (chk >> 3) * 72 + (chk & 7) * 8) = rv##i; }
  const int kt_hi = 2 * qb + 1;
  A_GLOAD(0, 0) A_GLOAD(1, 0)
  for (int kt = 0; kt <= kt_hi; ++kt) {
    bf16_t* Kl = sm + (kt & 1) * 17920; const bf16_t* Vl = Kl + 64 * 136;
    A_LSTORE(0) A_LSTORE(1)
    if (kt < kt_hi) { A_GLOAD(0, kt + 1) A_GLOAD(1, kt + 1) }
    __syncthreads();
    if (kt * 64 <= qmin + 31) {
      bf16x8 q[4];
#pragma unroll
      for (int ks = 0; ks < 4; ++ks) q[ks] = qlds[ks * 64];
      if (kt * 64 + 63 + 128 <= qmin)
        attn_tile<4, 0, true>(Kl + c * 64, 136, Vl, q, O, m, l, kt * 64, qp, 0, tab[128], tab, true);
      else
        attn_tile<4, 1, true>(Kl + c * 64, 136, Vl, q, O, m, l, kt * 64, qp, 1 << 30, 0.f, tab, true);
    }
  }
#undef A_GLOAD
#undef A_LSTORE
  const float lt = l + xor32(l);
  const float inv = 1.f / lt;
  __syncthreads();
  if (c == 1) {
#pragma unroll
    for (int dt = 0; dt < 4; ++dt)
#pragma unroll
      for (int i = 0; i < 16; ++i) {
        const int d = dt * 32 + 8 * (i >> 2) + 4 * lh + (i & 3);
        xbuf[(qs * 128 + d) * 32 + lr] = O[dt][i] * inv;
      }
  }
  __syncthreads();
  if (c == 0) {
    const float lam = ((const float*)(p.ws + O_LAM))[layer];
    const float li = 0.8f - 0.6f * expf(-0.3f * (float)layer);
    float ss = 0.f;
#pragma unroll
    for (int dt = 0; dt < 4; ++dt)
#pragma unroll
      for (int i = 0; i < 16; ++i) {
        const int d = dt * 32 + 8 * (i >> 2) + 4 * lh + (i & 3);
        const float o = O[dt][i] * inv - lam * xbuf[(qs * 128 + d) * 32 + lr];
        O[dt][i] = o;
        ss += o * o;
      }
    ss += xor32(ss);
    const float r = rsqrtf(ss * (1.f / 128.f) + 1e-6f) * (1.f - li);
    const float* sub = p.diff_subln + layer * 128;
    bf16_t* dst = (dm ? (bf16_t*)(p.ws + WS_END) : aq) + (size_t)(b * S_ + qp) * 512 + h * 128;
#pragma unroll
    for (int dt = 0; dt < 4; ++dt)
#pragma unroll
      for (int qd = 0; qd < 4; ++qd) {
        const int d = dt * 32 + 8 * qd + 4 * lh;
        const float4 g4 = *(const float4*)(sub + d);
        *(uint2*)(dst + d) = make_uint2(pack2(O[dt][4 * qd] * r * g4.x, O[dt][4 * qd + 1] * r * g4.y),
                                        pack2(O[dt][4 * qd + 2] * r * g4.z, O[dt][4 * qd + 3] * r * g4.w));
      }
  }
}

struct KVRegs { u32x4 k0, v0; };
DI void kv_gload(KVRegs& r, const bf16_t* kg, size_t kld, const bf16_t* vg, size_t vld, int key0) {
  const int c0 = tidx();
  r.k0 = *(const u32x4*)(kg + (size_t)(key0 + (c0 >> 3)) * kld + (c0 & 7) * 8);
  r.v0 = *(const u32x4*)(vg + (size_t)(c0 >> 3) * vld + key0 + (c0 & 7) * 8);
}
DI void kv_lstore(const KVRegs& r, bf16_t* Kl, bf16_t* Vl) {
  const int c0 = tidx();
  *(u32x4*)(Kl + (c0 >> 3) * 72 + (c0 & 7) * 8) = r.k0;
  *(u32x4*)(Vl + (c0 >> 3) * 72 + (c0 & 7) * 8) = r.v0;
}

DI void task_attnB(const P& p, int layer, int task, bf16_t* sm, int dm) {
  const int tid = tidx(), lane = tid & 63, wv = tid >> 6, hr = wv & 3, qs = wv >> 2;
  const int lr = lane & 31, lh = lane >> 5;
  const int qb = 63 - (task >> 3), bg = task & 7, b = bg >> 1, g = bg & 1, head = g * 4 + hr;
  float* tabs = (float*)((unsigned char*)sm + 36864);
  __syncthreads();
  for (int i = tid; i < 4 * 129; i += NTHR) {
    const int r = i / 129, d = i % 129;
    tabs[r * 132 + d] = ((const float*)(p.ws + O_TABS))[(4 + g * 4 + r) * 132 + d];
  }
  const int q0 = qb * 64, qmin = q0 + qs * 32, qp = qmin + lr;
  bf16_t* bq = (bf16_t*)(p.ws + O_BQ);
  bf16x8 q[4];
  {
    const bf16_t* qptr = bq + (size_t)(b * S_ + qp) * 512 + head * 64 + lh * 8;
#pragma unroll
    for (int ks = 0; ks < 4; ++ks) q[ks] = *(const bf16x8*)(qptr + ks * 16);
  }
  f32x16 O[2];
#pragma unroll
  for (int dt = 0; dt < 2; ++dt)
#pragma unroll
    for (int i = 0; i < 16; ++i) O[dt][i] = 0.f;
  float m = p.sinks[layer * 8 + head] * LOG2E, l = lh == 0 ? 1.f : 0.f;
  const bf16_t* kg = (const bf16_t*)(p.ws + O_BK) + (size_t)b * S_ * 128 + g * 64;
  const bf16_t* vg = (const bf16_t*)(p.ws + O_BVT) + (size_t)((b * 2 + g) * 64) * S_;
  const int kt_lo = q0 >= 127 ? (q0 - 127) >> 6 : 0, kt_hi = qb;
  KVRegs R;
  kv_gload(R, kg, 128, vg, S_, kt_lo * 64);
  for (int kt = kt_lo; kt <= kt_hi; ++kt) {
    bf16_t* Kl = sm + (kt & 1) * 9216; bf16_t* Vl = Kl + 4608;
    kv_lstore(R, Kl, Vl);
    if (kt < kt_hi) kv_gload(R, kg, 128, vg, S_, (kt + 1) * 64);
    __syncthreads();
    if (kt * 64 <= qmin + 31 && kt * 64 + 63 + 127 >= qmin)
      attn_tile<2, 1, true>(Kl, 72, Vl, q, O, m, l, kt * 64, qp, 128, 0.f, tabs + hr * 132, true);
  }
  const float lt = l + xor32(l);
  const float inv = 1.f / lt;
  bf16_t* dst = (dm ? (bf16_t*)(p.ws + WS_END) : bq) + (size_t)(b * S_ + qp) * 512 + head * 64;
#pragma unroll
  for (int dt = 0; dt < 2; ++dt)
#pragma unroll
    for (int qd = 0; qd < 4; ++qd) {
      const int d = dt * 32 + 8 * qd + 4 * lh;
      *(uint2*)(dst + d) = make_uint2(pack2(O[dt][4 * qd] * inv, O[dt][4 * qd + 1] * inv),
                                      pack2(O[dt][4 * qd + 2] * inv, O[dt][4 * qd + 3] * inv));
    }
}

DI void phase2(const P& p, int layer, bf16_t* sm, unsigned* qhead, int dm = 0) {
  for (;;) {
    const int task = next_task(qhead, sm);
    if (task >= 16 + 512 + 512) break;
    if (task < 16) task_compress(p, layer, task, sm);
    else if (task < 16 + 512) task_attnA(p, layer, task - 16, sm, dm);
    else task_attnB(p, layer, task - 528, sm, dm);
  }
}

DI void task_nsa(const P& p, int layer, int task, bf16_t* sm, int dm) {
  const int tid = tidx(), lane = tid & 63, wv = tid >> 6, hr = wv & 3, qs = wv >> 2;
  const int lr = lane & 31, lh = lane >> 5;
  const int qb = 63 - (task >> 3), bg = task & 7, b = bg >> 1, g = bg & 1, head = g * 4 + hr;
  float* tabs = (float*)((unsigned char*)sm + 36864);
  float* cbuf = (float*)((unsigned char*)sm + 39168);
  unsigned long long* masks = (unsigned long long*)((unsigned char*)sm + 55808);
  float* outl = (float*)((unsigned char*)sm + 56320) + wv * 2048 + lane;
  int itc = 0;
  __syncthreads();
  for (int i = tid; i < 4 * 129; i += NTHR) {
    const int r = i / 129, d = i % 129;
    tabs[r * 132 + d] = ((const float*)(p.ws + O_TABS))[(12 + g * 4 + r) * 132 + d];
  }
  for (int i = tid; i < 64 * 65; i += NTHR) cbuf[i] = 0.f;
  const float* tab = tabs + hr * 132;
  const int q0 = qb * 64, qmin = q0 + qs * 32, ql = qs * 32 + lr, qp = q0 + ql;
  bf16_t* cq = (bf16_t*)(p.ws + O_CQ);
  bf16x8 q[4];
  {
    const bf16_t* qptr = cq + (size_t)(b * S_ + qp) * 512 + head * 64 + lh * 8;
#pragma unroll
    for (int ks = 0; ks < 4; ++ks) q[ks] = *(const bf16x8*)(qptr + ks * 16);
  }
  const float* cg = (const float*)(p.ws + O_CGS) + (size_t)(b * S_ + qp) * 24 + head * 3;
  const float g0 = cg[0], g1 = cg[1], g2 = cg[2];
  f32x16 O[2];
  KVRegs R;
  {
    int nct = (((q0 + 32) >> 4) + 1 + 63) >> 6; if (nct > 4) nct = 4;
    const bf16_t* kg = (const bf16_t*)(p.ws + O_KC) + (size_t)(b * 2 + g) * 256 * 64;
    const bf16_t* vg = (const bf16_t*)(p.ws + O_VCT) + (size_t)(b * 2 + g) * 64 * 256;
#pragma unroll
    for (int dt = 0; dt < 2; ++dt)
#pragma unroll
      for (int i = 0; i < 16; ++i) O[dt][i] = 0.f;
    float m = -1e30f, l = 0.f;
    kv_gload(R, kg, 64, vg, 256, 0);
    for (int ct = 0; ct < nct; ++ct, ++itc) {
      bf16_t* Kl = sm + (itc & 1) * 9216; bf16_t* Vl = Kl + 4608;
      kv_lstore(R, Kl, Vl);
      if (ct + 1 < nct) kv_gload(R, kg, 64, vg, 256, (ct + 1) * 64);
      __syncthreads();
      attn_tile<2, 2, true>(Kl, 72, Vl, q, O, m, l, ct * 64, qp, 0, 0.f, tab, true);
    }
    const float lt = l + xor32(l);
    const float inv = lt > 0.f ? 1.f / lt : 0.f;
    {
      const float sc = g0 * inv;
#pragma unroll
      for (int dt = 0; dt < 2; ++dt)
#pragma unroll
        for (int i = 0; i < 16; ++i) outl[(dt * 16 + i) * 64] = sc * O[dt][i];
    }
    float carry = 0.f;
    kv_gload(R, kg, 64, vg, 256, 0);
    for (int ct = 0; ct < nct; ++ct, ++itc) {
      bf16_t* Kl = sm + (itc & 1) * 9216; bf16_t* Vl = Kl + 4608;
      kv_lstore(R, Kl, Vl);
      if (ct + 1 < nct) kv_gload(R, kg, 64, vg, 256, (ct + 1) * 64);
      __syncthreads();
      float val[2][4];
#pragma unroll
      for (int st = 0; st < 2; ++st) {
        f32x16 s;
#pragma unroll
        for (int i = 0; i < 16; ++i) s[i] = 0.f;
#pragma unroll
        for (int ks = 0; ks < 4; ++ks) {
          bf16x8 kf = *(const bf16x8*)(Kl + (st * 32 + lr) * 72 + ks * 16 + lh * 8);
          s = MFMA32(kf, q[ks], s);
        }
        float pq[4], pl[4], other[4];
#pragma unroll
        for (int g4 = 0; g4 < 4; ++g4) {
          float sum = 0.f, last = 0.f;
#pragma unroll
          for (int e = 0; e < 4; ++e) {
            const int cc = ct * 64 + st * 32 + 8 * g4 + 4 * lh + e;
            const float pe = (16 * cc + 31 <= qp) ? ex2(s[4 * g4 + e] - m) * inv : 0.f;
            sum += pe; last = pe;
          }
          pq[g4] = sum; pl[g4] = last;
        }
#pragma unroll
        for (int g4 = 0; g4 < 4; ++g4) other[g4] = xor32(pl[g4]);
        val[st][0] = pq[0] + (lh ? other[0] : carry);
        val[st][1] = pq[1] + (lh ? other[1] : other[0]);
        val[st][2] = pq[2] + (lh ? other[2] : other[1]);
        val[st][3] = pq[3] + (lh ? other[3] : other[2]);
        carry = other[3];
      }
      for (int w = 0; w < 4; ++w) {
        if (hr == w) {
#pragma unroll
          for (int st = 0; st < 2; ++st)
#pragma unroll
            for (int g4 = 0; g4 < 4; ++g4) cbuf[(ct * 16 + st * 8 + 2 * g4 + lh) * 65 + ql] += val[st][g4];
        }
        __syncthreads();
      }
    }
  }
  __syncthreads();
  for (int qi = 0; qi < 8; ++qi) {
    const int qq = wv * 8 + qi, qpos = q0 + qq, j = lane, cur = qpos >> 6;
    const float imp = cbuf[j * 65 + qq];
    const bool valid = j <= cur;
    const bool forced = (j == 0) || (j == cur) || (j == cur - 1);
    const float score = valid ? imp + (forced ? 1e4f : 0.f) : -1e30f;
    int rank = 0;
#pragma unroll 4
    for (int jp = 0; jp < 64; ++jp) {
      const float sj = __int_as_float(__builtin_amdgcn_readlane(__float_as_int(score), jp));
      rank += ((sj > score) || (sj == score && jp < j)) ? 1 : 0;
    }
    const unsigned long long mk = __ballot(rank < 16);
    if (lane == 0) masks[qq] = mk;
  }
  __syncthreads();
  const unsigned long long mymask = masks[ql];
  unsigned long long un = 0ull;
  for (int i = 0; i < 64; ++i) un |= masks[i];
  {
    const int cmax = qb;
    unsigned long long todo = un & (cmax == 63 ? ~0ull : ((1ull << (cmax + 1)) - 1ull));
    const bf16_t* kg = (const bf16_t*)(p.ws + O_KS) + (size_t)b * S_ * 128 + g * 64;
    const bf16_t* vg = (const bf16_t*)(p.ws + O_VST) + (size_t)((b * 2 + g) * 64) * S_;
#pragma unroll
    for (int dt = 0; dt < 2; ++dt)
#pragma unroll
      for (int i = 0; i < 16; ++i) O[dt][i] = 0.f;
    float m = -1e30f, l = 0.f;
    kv_gload(R, kg, 128, vg, S_, (__ffsll((long long)todo) - 1) * 64);
    for (; todo; ++itc) {
      const int j = __ffsll((long long)todo) - 1;
      todo &= todo - 1ull;
      bf16_t* Kl = sm + (itc & 1) * 9216; bf16_t* Vl = Kl + 4608;
      kv_lstore(R, Kl, Vl);
      if (todo) kv_gload(R, kg, 128, vg, S_, (__ffsll((long long)todo) - 1) * 64);
      __syncthreads();
      const bool on = (mymask >> j) & 1ull;
      if (j * 64 <= qmin + 31 && __ballot(on)) {
        if (j * 64 + 63 + 128 <= qmin)
          attn_tile<2, 0, false>(Kl, 72, Vl, q, O, m, l, j * 64, qp, 0, tab[128], tab, on);
        else
          attn_tile<2, 1, false>(Kl, 72, Vl, q, O, m, l, j * 64, qp, 1 << 30, 0.f, tab, on);
      }
    }
    const float lt = l + xor32(l);
    const float inv = lt > 0.f ? 1.f / lt : 0.f;
    {
      const float sc = g1 * inv;
#pragma unroll
      for (int dt = 0; dt < 2; ++dt)
#pragma unroll
        for (int i = 0; i < 16; ++i) outl[(dt * 16 + i) * 64] += sc * O[dt][i];
    }
  }
  {
    const bf16_t* kg = (const bf16_t*)(p.ws + O_KW) + (size_t)b * S_ * 128 + g * 64;
    const bf16_t* vg = (const bf16_t*)(p.ws + O_VWT) + (size_t)((b * 2 + g) * 64) * S_;
#pragma unroll
    for (int dt = 0; dt < 2; ++dt)
#pragma unroll
      for (int i = 0; i < 16; ++i) O[dt][i] = 0.f;
    float m = -1e30f, l = 0.f;
    const int kt_lo = q0 >= 511 ? (q0 - 511) >> 6 : 0, kt_hi = qb;
    kv_gload(R, kg, 128, vg, S_, kt_lo * 64);
    for (int kt = kt_lo; kt <= kt_hi; ++kt, ++itc) {
      bf16_t* Kl = sm + (itc & 1) * 9216; bf16_t* Vl = Kl + 4608;
      kv_lstore(R, Kl, Vl);
      if (kt < kt_hi) kv_gload(R, kg, 128, vg, S_, (kt + 1) * 64);
      __syncthreads();
      if (kt * 64 <= qmin + 31 && kt * 64 + 63 + 511 >= qmin) {
        if (kt * 64 + 63 + 128 <= qmin && qmin + 31 - kt * 64 < 512)
          attn_tile<2, 0, true>(Kl, 72, Vl, q, O, m, l, kt * 64, qp, 0, tab[128], tab, true);
        else
          attn_tile<2, 1, true>(Kl, 72, Vl, q, O, m, l, kt * 64, qp, 512, 0.f, tab, true);
      }
    }
    const float lt = l + xor32(l);
    const float inv = 1.f / lt;
    {
      const float sc = g2 * inv;
#pragma unroll
      for (int dt = 0; dt < 2; ++dt)
#pragma unroll
        for (int i = 0; i < 16; ++i) O[dt][i] = outl[(dt * 16 + i) * 64] + sc * O[dt][i];
    }
  }
  bf16_t* dst = (dm ? (bf16_t*)(p.ws + WS_END) : cq) + (size_t)(b * S_ + qp) * 512 + head * 64;
#pragma unroll
  for (int dt = 0; dt < 2; ++dt)
#pragma unroll
    for (int qd = 0; qd < 4; ++qd) {
      const int d = dt * 32 + 8 * qd + 4 * lh;
      *(uint2*)(dst + d) = make_uint2(pack2(O[dt][4 * qd], O[dt][4 * qd + 1]), pack2(O[dt][4 * qd + 2], O[dt][4 * qd + 3]));
    }
}

DI void phase3(const P& p, int layer, bf16_t* sm, unsigned* qhead, int dm = 0) {
  for (;;) {
    const int task = next_task(qhead, sm);
    if (task >= 512) break;
    task_nsa(p, layer, task, sm, dm);
  }
}

DI void phase23(const P& p, int layer, bf16_t* sm, unsigned* qhead, unsigned* cdone) {
  for (;;) {
    const int task = next_task(qhead, sm);
    if (task >= 16 + 512 + 512 + 512) break;
    if (task < 16) {
      task_compress(p, layer, task, sm);
      asm volatile("s_waitcnt vmcnt(0) lgkmcnt(0)" ::: "memory");
      __syncthreads();
      if (threadIdx.x == 0) {
        __builtin_amdgcn_fence(__ATOMIC_RELEASE, "agent");
        asm volatile("s_waitcnt vmcnt(0)" ::: "memory");
        __hip_atomic_fetch_add(cdone, 1u, __ATOMIC_RELAXED, __HIP_MEMORY_SCOPE_AGENT);
      }
    } else if (task < 16 + 512) task_attnA(p, layer, task - 16, sm, 0);
    else if (task >= 1040) task_attnB(p, layer, task - 1040, sm, 0);
    else {
      if (threadIdx.x == 0) {
        while (__hip_atomic_load(cdone, __ATOMIC_RELAXED, __HIP_MEMORY_SCOPE_AGENT) < 16u) __builtin_amdgcn_s_sleep(2);
        __builtin_amdgcn_fence(__ATOMIC_ACQUIRE, "agent");
        asm volatile("s_waitcnt vmcnt(0)" ::: "memory");
      }
      __syncthreads();
      task_nsa(p, layer, task - 528, sm, 0);
    }
  }
}

DI void phase_merge(const P& p, int layer, bf16_t* sm, const Geo& ge) {
  const int tid = tidx(), lane = tid & 63, wv = tid >> 6, wn = wv & 1, wm = wv >> 1;
  const int lr = lane & 31, lh = lane >> 5;
  const bf16_t* W = (const bf16_t*)(p.ws + O_WBR + layer * SZ_WBR);
  const bf16_t* mgs = (const bf16_t*)(p.ws + O_MGS);
  bf16_t* z = (bf16_t*)(p.ws + O_Z);
  TileWalk tw(8, ge);
  int mt_, nt_;
  while (tw.next(mt_, nt_)) {
    unsigned zp[2][2][8];
#pragma unroll
    for (int a_ = 0; a_ < 2; ++a_)
#pragma unroll
      for (int b_ = 0; b_ < 2; ++b_)
#pragma unroll
        for (int i = 0; i < 8; ++i) zp[a_][b_][i] = 0u;
    for (int n3 = 0; n3 < 3; ++n3) {
      const bf16_t* X = (const bf16_t*)(p.ws + (n3 == 0 ? O_AQ : (n3 == 1 ? O_BQ : O_CQ)));
      f32x16 acc[2][2]; zero_acc(acc);
      gemm_mid(W + ((size_t)n3 * 1024 + nt_ * 128) * 512, 512, X, 512, 1 << 30, 64, 8, mt_ * 256, acc, sm);
#pragma unroll
      for (int mt = 0; mt < 2; ++mt) {
        const int m = mt_ * 256 + wm * 64 + mt * 32 + lr;
#pragma unroll
        for (int nt = 0; nt < 2; ++nt)
#pragma unroll
          for (int qd = 0; qd < 4; ++qd) {
            const int n = nt_ * 128 + wn * 64 + nt * 32 + 8 * qd + 4 * lh;
            const uint2 gq = *(const uint2*)(mgs + ((size_t)((n3 * 1024 + n) >> 2) * T_ + m) * 4);
            const unsigned z01 = zp[nt][mt][2 * qd], z23 = zp[nt][mt][2 * qd + 1];
            const float v0 = bf2f((bf16_t)(z01 & 0xffff)) + bf2f((bf16_t)(gq.x & 0xffff)) * acc[nt][mt][4 * qd];
            const float v1 = bf2f((bf16_t)(z01 >> 16)) + bf2f((bf16_t)(gq.x >> 16)) * acc[nt][mt][4 * qd + 1];
            const float v2 = bf2f((bf16_t)(z23 & 0xffff)) + bf2f((bf16_t)(gq.y & 0xffff)) * acc[nt][mt][4 * qd + 2];
            const float v3 = bf2f((bf16_t)(z23 >> 16)) + bf2f((bf16_t)(gq.y >> 16)) * acc[nt][mt][4 * qd + 3];
            zp[nt][mt][2 * qd] = pack2(v0, v1);
            zp[nt][mt][2 * qd + 1] = pack2(v2, v3);
          }
      }
    }
    bf16_t* stg = sm + wv * (64 * 72);
#pragma unroll
    for (int mt = 0; mt < 2; ++mt)
#pragma unroll
      for (int nt = 0; nt < 2; ++nt)
#pragma unroll
        for (int qd = 0; qd < 4; ++qd)
          *(uint2*)(stg + (mt * 32 + lr) * 72 + nt * 32 + 8 * qd + 4 * lh) = make_uint2(zp[nt][mt][2 * qd], zp[nt][mt][2 * qd + 1]);
#pragma unroll
    for (int it = 0; it < 8; ++it) {
      const int row = it * 8 + (lane >> 3), c16 = lane & 7;
      const u32x4 v = *(const u32x4*)(stg + row * 72 + c16 * 8);
      *(u32x4*)(z + (size_t)(mt_ * 256 + wm * 64 + row) * LDK1 + nt_ * 128 + wn * 64 + c16 * 8) = v;
    }
  }
}

DI void phase_resid(const P& p, const bf16_t* W, const bf16_t* X, int K, bf16_t* sm, const Geo& ge, bool last) {
  const int tid = tidx(), lane = tid & 63, wv = tid >> 6, wn = wv & 1, wm = wv >> 1;
  const int lr = lane & 31, lh = lane >> 5;
  bf16_t* xb = (bf16_t*)(p.ws + O_XB);
  float* part = (float*)(p.ws + O_PART);
  TileWalk tw(4, ge);
  int mt_, nt_;
  while (tw.next(mt_, nt_)) {
    f32x16 acc[4][2]; zero_acc8(acc);
    const int ldk = K + 64;
    gemm_wide(W + (size_t)nt_ * 256 * ldk, ldk, X + (size_t)mt_ * 256 * ldk, ldk, K / 64, acc, sm);
    float* stg = (float*)sm + wv * (64 * 68);
    const int m0w = mt_ * 256 + wm * 64, n0w = nt_ * 256 + wn * 128;
#pragma unroll
    for (int cp = 0; cp < 2; ++cp) {
#pragma unroll 4
      for (int it = 0; it < 8; ++it) {
        const int row = it * 8 + (lane >> 3), c8 = (lane & 7) * 8;
        const u32x4 raw = *(const u32x4*)(xb + (size_t)(m0w + row) * LDK1 + n0w + cp * 64 + c8);
        float* d = stg + row * 68 + c8;
        *(float4*)(d) = make_float4(__uint_as_float(raw[0] << 16), __uint_as_float(raw[0] & 0xffff0000u),
                                    __uint_as_float(raw[1] << 16), __uint_as_float(raw[1] & 0xffff0000u));
        *(float4*)(d + 4) = make_float4(__uint_as_float(raw[2] << 16), __uint_as_float(raw[2] & 0xffff0000u),
                                        __uint_as_float(raw[3] << 16), __uint_as_float(raw[3] & 0xffff0000u));
      }
#pragma unroll
      for (int mt = 0; mt < 2; ++mt) {
        float ss = 0.f;
#pragma unroll
        for (int nh = 0; nh < 2; ++nh)
#pragma unroll
          for (int qd = 0; qd < 4; ++qd) {
            const int nt = cp * 2 + nh;
            float4* sp = (float4*)(stg + (mt * 32 + lr) * 68 + nh * 32 + 8 * qd + 4 * lh);
            float4 v = *sp;
            v.x += acc[nt][mt][4 * qd]; v.y += acc[nt][mt][4 * qd + 1]; v.z += acc[nt][mt][4 * qd + 2]; v.w += acc[nt][mt][4 * qd + 3];
            *sp = v;
            ss += v.x * v.x + v.y * v.y + v.z * v.z + v.w * v.w;
          }
        ss += xor32(ss);
        if (lh == 0) part[(size_t)(m0w + mt * 32 + lr) * 16 + nt_ * 4 + wn * 2 + cp] = ss;
      }
#pragma unroll 4
      for (int it = 0; it < 16; ++it) {
        const int row = it * 4 + (lane >> 4), c4 = (lane & 15) * 4;
        const float4 v = *(const float4*)(stg + row * 68 + c4);
        if (last) *(float4*)(p.out + (size_t)(m0w + row) * 1024 + n0w + cp * 64 + c4) = v;
        *(uint2*)(xb + (size_t)(m0w + row) * LDK1 + n0w + cp * 64 + c4) = make_uint2(pack2(v.x, v.y), pack2(v.z, v.w));
      }
    }
  }
}

DI void phase_up(const P& p, int layer, bf16_t* sm, const Geo& ge) {
  const int tid = tidx(), lane = tid & 63, wv = tid >> 6, wn = wv & 1, wm = wv >> 1;
  const int lr = lane & 31, lh = lane >> 5;
  const bf16_t* W = (const bf16_t*)(p.ws + O_WUP + layer * SZ_WUP);
  const bf16_t* X = (const bf16_t*)(p.ws + O_XB);
  const float* part = (const float*)(p.ws + O_PART);
  bf16_t* u = (bf16_t*)(p.ws + O_U);
  TileWalk tw(16, ge);
  int mt_, nt_, mt_have = -1;
  float rs0 = 0.f, rs1 = 0.f;
  while (tw.next(mt_, nt_)) {
    if (mt_ != mt_have) {
      rs0 = row_rstd(part, mt_ * 256 + wm * 64 + lr);
      rs1 = row_rstd(part, mt_ * 256 + wm * 64 + 32 + lr);
      mt_have = mt_;
    }
    f32x16 acc[4][2]; zero_acc8(acc);
    gemm_wide(W + (size_t)nt_ * 256 * LDK1, LDK1, X + (size_t)mt_ * 256 * LDK1, LDK1, 16, acc, sm);
    bf16_t* stg = sm + wv * (64 * 136);
#pragma unroll
    for (int mt = 0; mt < 2; ++mt) {
      const float rs = mt ? rs1 : rs0;
#pragma unroll
      for (int nt = 0; nt < 4; ++nt)
#pragma unroll
        for (int qd = 0; qd < 4; ++qd) {
          const int n = nt_ * 256 + wn * 128 + nt * 32 + 8 * qd + 4 * lh;
          float a = fmaxf(acc[nt][mt][4 * qd] * rs, 0.f), b = fmaxf(acc[nt][mt][4 * qd + 1] * rs, 0.f);
          float c = fmaxf(acc[nt][mt][4 * qd + 2] * rs, 0.f), d = fmaxf(acc[nt][mt][4 * qd + 3] * rs, 0.f);
          *(uint2*)(stg + (mt * 32 + lr) * 136 + nt * 32 + 8 * qd + 4 * lh) = make_uint2(pack2(a * a, b * b), pack2(c * c, d * d));
        }
    }
    stage_rows_store<true>(stg, u + nt_ * 256 + wn * 128, LDK4, mt_ * 256 + wm * 64);
  }
}

DI unsigned xcc_id() { return (unsigned)__builtin_amdgcn_s_getreg((3 << 11) | 20) & 0xFu; }
struct BarCtx { unsigned* base; unsigned xcc, xcnt, nxcc, gen; };
DI void gbar(BarCtx& c) {
  ++c.gen;
  asm volatile("s_waitcnt vmcnt(0) lgkmcnt(0)" ::: "memory");
  __syncthreads();
  if (threadIdx.x == 0) {
    const unsigned old = __hip_atomic_fetch_add(c.base + (16 + c.xcc) * 32, 1u, __ATOMIC_RELAXED, __HIP_MEMORY_SCOPE_AGENT);
    if (old % c.xcnt == c.xcnt - 1) {
      __builtin_amdgcn_fence(__ATOMIC_RELEASE, "agent");
      asm volatile("s_waitcnt vmcnt(0)" ::: "memory");
      const unsigned t = __hip_atomic_fetch_add(c.base + 32 * 32, 1u, __ATOMIC_RELAXED, __HIP_MEMORY_SCOPE_AGENT);
      if (t % c.nxcc == c.nxcc - 1) {
        for (unsigned i = 0; i < 16; ++i)
          __hip_atomic_store(c.base + (33 + i) * 32, c.gen, __ATOMIC_RELAXED, __HIP_MEMORY_SCOPE_AGENT);
      }
    }
    while (__hip_atomic_load(c.base + (33 + c.xcc) * 32, __ATOMIC_RELAXED, __HIP_MEMORY_SCOPE_AGENT) < c.gen) __builtin_amdgcn_s_sleep(1);
    __builtin_amdgcn_fence(__ATOMIC_ACQUIRE, "agent");
    asm volatile("s_waitcnt vmcnt(0)" ::: "memory");
  }
  __syncthreads();
}

__global__ void __launch_bounds__(512, 2) mega(P p) {
  extern __shared__ __attribute__((aligned(16))) unsigned char smraw[];
  bf16_t* sm = (bf16_t*)smraw;
  cg::grid_group grid = cg::this_grid();
  if (threadIdx.x == 0)
    ((unsigned*)smraw)[0] = __hip_atomic_fetch_add((unsigned*)(p.ws + O_BAR) + xcc_id() * 32, 1u, __ATOMIC_RELAXED, __HIP_MEMORY_SCOPE_AGENT);
  __syncthreads();
  const unsigned my_rank = (unsigned)__builtin_amdgcn_readfirstlane((int)((volatile unsigned*)smraw)[0]);
  __syncthreads();
#ifndef PHMASK
#define PHMASK 0xff
#endif
  if (PHMASK & 1) phase0(p, sm);
  grid.sync();
  BarCtx bc;
  bc.base = (unsigned*)(p.ws + O_BAR); bc.xcc = xcc_id(); bc.gen = 0;
  bc.xcnt = (unsigned)__builtin_amdgcn_readfirstlane((int)__hip_atomic_load(bc.base + bc.xcc * 32, __ATOMIC_RELAXED, __HIP_MEMORY_SCOPE_AGENT));
  bc.nxcc = 0;
  for (unsigned i = 0; i < 16; ++i) bc.nxcc += __hip_atomic_load(bc.base + i * 32, __ATOMIC_RELAXED, __HIP_MEMORY_SCOPE_AGENT) ? 1u : 0u;
  bc.nxcc = (unsigned)__builtin_amdgcn_readfirstlane((int)bc.nxcc);
  unsigned hi_cnt = 0;
  for (unsigned i = 8; i < 16; ++i) hi_cnt += __hip_atomic_load(bc.base + i * 32, __ATOMIC_RELAXED, __HIP_MEMORY_SCOPE_AGENT);
  hi_cnt = (unsigned)__builtin_amdgcn_readfirstlane((int)hi_cnt);
  Geo ge;
  if (bc.nxcc == 8 && hi_cnt == 0) { ge.xcd = (int)bc.xcc; ge.loc = (int)my_rank; ge.nloc = (int)bc.xcnt; }
  else { ge.xcd = blockIdx.x & 7; ge.loc = blockIdx.x >> 3; ge.nloc = gridDim.x >> 3; }
  unsigned* qheads = bc.base + 64 * 32;
  for (int layer = 0; layer < NL; ++layer) {
    if (PHMASK & 2) phase_inproj(p, layer, sm, ge);
    gbar(bc);
    phase23(p, layer, sm, qheads + (layer * 2) * 32, qheads + (layer * 2 + 1) * 32);
    gbar(bc);
    if (PHMASK & 16) phase_merge(p, layer, sm, ge);
    gbar(bc);
    if (PHMASK & 32) phase_resid(p, (const bf16_t*)(p.ws + O_WO + layer * SZ_WO), (const bf16_t*)(p.ws + O_Z), 1024, sm, ge, false);
    gbar(bc);
    if (PHMASK & 64) phase_up(p, layer, sm, ge);
    gbar(bc);
    if (PHMASK & 128) phase_resid(p, (const bf16_t*)(p.ws + O_WDN + layer * SZ_WDN), (const bf16_t*)(p.ws + O_U), 4096, sm, ge, layer == NL - 1);
    gbar(bc);
  }
}

extern "C" void kernel_launch(void* const* d_in, const int* in_sizes, int n_in, void* d_out, int out_size, void* d_ws,
                              size_t ws_size, hipStream_t stream) {
  static int grid_blocks = 0;
  if (!grid_blocks) {
    int dev = 0, cus = 0, per_cu = 0;
    (void)hipGetDevice(&dev);
    (void)hipDeviceGetAttribute(&cus, hipDeviceAttributeMultiprocessorCount, dev);
    (void)hipFuncSetAttribute((const void*)mega, hipFuncAttributeMaxDynamicSharedMemorySize, LDS_BYTES);
    (void)hipOccupancyMaxActiveBlocksPerMultiprocessor(&per_cu, (const void*)mega, NTHR, LDS_BYTES);
    if (per_cu < 1) per_cu = 1;
    if (per_cu > 1) per_cu = 1;
    grid_blocks = cus * per_cu;
    if (ws_size < WS_END) fprintf(stderr, "workspace too small: %zu < %zu\n", ws_size, (size_t)WS_END);
  }
  P p{};
  p.x = (const float*)d_in[0]; p.w_in = (const float*)d_in[1]; p.qk_gain = (const float*)d_in[2];
  p.diff_lambda = (const float*)d_in[3]; p.diff_subln = (const float*)d_in[4]; p.sinks = (const float*)d_in[5];
  p.cmp_pos = (const float*)d_in[6]; p.cmp_w1 = (const float*)d_in[7]; p.cmp_w2 = (const float*)d_in[8];
  p.w_branch = (const float*)d_in[9]; p.w_out = (const float*)d_in[10]; p.norm_mix = (const float*)d_in[11];
  p.norm_mlp = (const float*)d_in[12]; p.w_up = (const float*)d_in[13]; p.w_down = (const float*)d_in[14];
  p.rel_bias = (const float*)d_in[15];
  p.out = (float*)d_out; p.ws = (unsigned char*)d_ws;
  (void)hipMemsetAsync((unsigned char*)d_ws + O_BAR, 0, 80 * 128, stream);
  void* args[] = {&p};
  hipError_t e = hipLaunchCooperativeKernel((const void*)mega, dim3(grid_blocks), dim3(NTHR), args, LDS_BYTES, stream);
  if (e != hipSuccess) fprintf(stderr, "cooperative launch failed: %s (grid %d)\n", hipGetErrorString(e), grid_blocks);
}
```

```cpp
#include <hip/hip_runtime.h>
#include <hip/hip_cooperative_groups.h>
#include <cstdio>
namespace cg = cooperative_groups;

typedef unsigned short bf16_t;
using bf16x8 = __attribute__((ext_vector_type(8))) short;
using f32x16 = __attribute__((ext_vector_type(16))) float;
using u32x4 = __attribute__((ext_vector_type(4))) unsigned;
#define DI __device__ __forceinline__
#define MFMA32(a, b, c) __builtin_amdgcn_mfma_f32_32x32x16_bf16((a), (b), (c), 0, 0, 0)

constexpr int S_ = 4096, T_ = 16384, NL = 4;
constexpr int NIN = 6680, NINP = 6912;
constexpr int LDS_BYTES = 147456;
constexpr int NTHR = 512;
constexpr int LDT = 72;
constexpr int LDK1 = 1088, LDK4 = 4160;
constexpr int WT_E = 256 * LDT;

constexpr size_t SZ_WIN = (size_t)NINP * LDK1 * 2;
constexpr size_t SZ_WBR = (size_t)3 * 1024 * 512 * 2;
constexpr size_t SZ_WO = (size_t)1024 * LDK1 * 2;
constexpr size_t SZ_WUP = (size_t)4096 * LDK1 * 2;
constexpr size_t SZ_WDN = (size_t)1024 * LDK4 * 2;
constexpr size_t SZ_W1 = (size_t)2 * 256 * 2048 * 2;
constexpr size_t SZ_W2 = (size_t)2 * 128 * 256 * 2;
constexpr size_t O_WIN = 0;
constexpr size_t O_WBR = O_WIN + NL * SZ_WIN;
constexpr size_t O_WO = O_WBR + NL * SZ_WBR;
constexpr size_t O_WUP = O_WO + NL * SZ_WO;
constexpr size_t O_WDN = O_WUP + NL * SZ_WUP;
constexpr size_t O_W1 = O_WDN + NL * SZ_WDN;
constexpr size_t O_W2 = O_W1 + NL * SZ_W1;
constexpr size_t O_POSW1 = O_W2 + NL * SZ_W2;
constexpr size_t O_LAM = O_POSW1 + (size_t)NL * 2 * 4 * 256 * 4;
constexpr size_t O_TABS = O_LAM + 256;
constexpr size_t O_PART = O_TABS + 20 * 132 * 4 + 192;
constexpr size_t O_XB = ((O_PART + (size_t)T_ * 16 * 4 + 255) / 256) * 256;
constexpr size_t O_ACT = O_XB + (size_t)T_ * LDK1 * 2;
constexpr size_t O_AQ = O_ACT;
constexpr size_t O_BQ = O_AQ + (size_t)T_ * 512 * 2;
constexpr size_t O_CQ = O_BQ + (size_t)T_ * 512 * 2;
constexpr size_t O_AK = O_CQ + (size_t)T_ * 512 * 2;
constexpr size_t O_AVT = O_AK + (size_t)T_ * 512 * 2;
constexpr size_t O_Z = O_AK;
constexpr size_t O_BK = O_AVT + (size_t)T_ * 512 * 2;
constexpr size_t SZ_S = (size_t)T_ * 128 * 2;
constexpr size_t O_BVT = O_BK + SZ_S;
constexpr size_t O_CK = O_BVT + SZ_S;
constexpr size_t O_CV = O_CK + SZ_S;
constexpr size_t O_KS = O_CV + SZ_S + 65536;
constexpr size_t O_VST = O_KS + SZ_S;
constexpr size_t O_KW = O_VST + SZ_S;
constexpr size_t O_VWT = O_KW + SZ_S;
constexpr size_t O_CGS = O_VWT + SZ_S;
constexpr size_t O_MGS = O_CGS + (size_t)T_ * 24 * 4;
constexpr size_t O_HID = O_MGS + (size_t)T_ * 3072 * 2;
constexpr size_t O_KC = O_HID + (size_t)16 * 256 * 256 * 2;
constexpr size_t O_VCT = O_KC + (size_t)8 * 256 * 64 * 2;
constexpr size_t O_U = O_ACT;
constexpr size_t O_BAR = O_VCT + (size_t)8 * 256 * 64 * 2;
constexpr size_t WS_END = O_BAR + 80 * 128;
static_assert(O_Z + (size_t)T_ * LDK1 * 2 <= O_CGS && O_U + (size_t)T_ * LDK4 * 2 <= O_HID, "u must fit in the aliased region");

struct P {
  const float* x; const float* w_in; const float* qk_gain; const float* diff_lambda; const float* diff_subln;
  const float* sinks; const float* cmp_pos; const float* cmp_w1; const float* cmp_w2; const float* w_branch;
  const float* w_out; const float* norm_mix; const float* norm_mlp; const float* w_up; const float* w_down;
  const float* rel_bias;
  float* out; unsigned char* ws;
};

DI int tidx() { int t = threadIdx.x; asm volatile("" : "+v"(t)); return t; }
DI bf16_t f2bf(float x) { unsigned u = __float_as_uint(x); u += 0x7fffu + ((u >> 16) & 1u); return (bf16_t)(u >> 16); }
DI float bf2f(bf16_t b) { return __uint_as_float(((unsigned)b) << 16); }
typedef float f32x2_t __attribute__((ext_vector_type(2)));
typedef __bf16 bf16x2_t __attribute__((ext_vector_type(2)));
DI unsigned pack2(float a, float b) { f32x2_t v = {a, b}; bf16x2_t r = __builtin_convertvector(v, bf16x2_t); return __builtin_bit_cast(unsigned, r); }
constexpr float LOG2E = 1.4426950408889634f;
constexpr float QSCL = 0.125f * LOG2E;
DI float ex2(float x) { return __builtin_amdgcn_exp2f(x); }
DI float sigmoidf_(float x) { return __builtin_amdgcn_rcpf(1.f + ex2(-LOG2E * x)); }
DI float xor32(float v) { return __shfl_xor(v, 32); }

DI void gemm_wide(const bf16_t* __restrict__ W, int ldw, const bf16_t* __restrict__ X, int ldx, int nkt,
                  f32x16 (&acc)[4][2], bf16_t* lds) {
  const int tid = tidx(), lane = tid & 63, wv = tid >> 6, wn = wv & 1, wm = wv >> 1;
  const int lr = lane & 31, lh = lane >> 5;
  const int lrow = tid >> 3, lkc = (tid & 7) * 8;
  const bf16_t* wp = W + (size_t)lrow * ldw + lkc;
  const bf16_t* xp = X + (size_t)lrow * ldx + lkc;
  const size_t wst = (size_t)64 * ldw, xst = (size_t)64 * ldx;
  u32x4 rw0, rw1, rw2, rw3, rx0, rx1, rx2, rx3;
#define GW_GLOAD(KT) { const size_t ko_ = (size_t)(KT) * 64; \
    rw0 = *(const u32x4*)(wp + ko_); rw1 = *(const u32x4*)(wp + wst + ko_); \
    rw2 = *(const u32x4*)(wp + 2 * wst + ko_); rw3 = *(const u32x4*)(wp + 3 * wst + ko_); \
    rx0 = *(const u32x4*)(xp + ko_); rx1 = *(const u32x4*)(xp + xst + ko_); \
    rx2 = *(const u32x4*)(xp + 2 * xst + ko_); rx3 = *(const u32x4*)(xp + 3 * xst + ko_); }
#define GW_LSTORE(BUF) { bf16_t* wb_ = lds + (BUF) * 2 * WT_E + lrow * LDT + lkc; bf16_t* xb_ = wb_ + WT_E; \
    *(u32x4*)(wb_) = rw0; *(u32x4*)(wb_ + 64 * LDT) = rw1; *(u32x4*)(wb_ + 128 * LDT) = rw2; *(u32x4*)(wb_ + 192 * LDT) = rw3; \
    *(u32x4*)(xb_) = rx0; *(u32x4*)(xb_ + 64 * LDT) = rx1; *(u32x4*)(xb_ + 128 * LDT) = rx2; *(u32x4*)(xb_ + 192 * LDT) = rx3; }
  u32x4 sw0, sw1, sw2, sw3, sx0, sx1, sx2, sx3;
#define GW_GLOAD_B(KT) { const size_t ko_ = (size_t)(KT) * 64; \
    sw0 = *(const u32x4*)(wp + ko_); sw1 = *(const u32x4*)(wp + wst + ko_); \
    sw2 = *(const u32x4*)(wp + 2 * wst + ko_); sw3 = *(const u32x4*)(wp + 3 * wst + ko_); \
    sx0 = *(const u32x4*)(xp + ko_); sx1 = *(const u32x4*)(xp + xst + ko_); \
    sx2 = *(const u32x4*)(xp + 2 * xst + ko_); sx3 = *(const u32x4*)(xp + 3 * xst + ko_); }
#define GW_LSTORE_B(BUF) { bf16_t* wb_ = lds + (BUF) * 2 * WT_E + lrow * LDT + lkc; bf16_t* xb_ = wb_ + WT_E; \
    *(u32x4*)(wb_) = sw0; *(u32x4*)(wb_ + 64 * LDT) = sw1; *(u32x4*)(wb_ + 128 * LDT) = sw2; *(u32x4*)(wb_ + 192 * LDT) = sw3; \
    *(u32x4*)(xb_) = sx0; *(u32x4*)(xb_ + 64 * LDT) = sx1; *(u32x4*)(xb_ + 128 * LDT) = sx2; *(u32x4*)(xb_ + 192 * LDT) = sx3; }
#define GW_KS(KT, ks) { \
      const bf16_t* wb = lds + ((KT) & 1) * 2 * WT_E + (wn * 128 + lr) * LDT + lh * 8; \
      const bf16_t* xb = lds + ((KT) & 1) * 2 * WT_E + WT_E + (wm * 64 + lr) * LDT + lh * 8; \
      const bf16x8 b0 = *(const bf16x8*)(xb + (ks) * 16), b1 = *(const bf16x8*)(xb + 32 * LDT + (ks) * 16); \
      const bf16x8 a0 = *(const bf16x8*)(wb + (ks) * 16), a1 = *(const bf16x8*)(wb + 32 * LDT + (ks) * 16); \
      const bf16x8 a2 = *(const bf16x8*)(wb + 64 * LDT + (ks) * 16), a3 = *(const bf16x8*)(wb + 96 * LDT + (ks) * 16); \
      acc[0][0] = MFMA32(a0, b0, acc[0][0]); acc[0][1] = MFMA32(a0, b1, acc[0][1]); \
      acc[1][0] = MFMA32(a1, b0, acc[1][0]); acc[1][1] = MFMA32(a1, b1, acc[1][1]); \
      acc[2][0] = MFMA32(a2, b0, acc[2][0]); acc[2][1] = MFMA32(a2, b1, acc[2][1]); \
      acc[3][0] = MFMA32(a3, b0, acc[3][0]); acc[3][1] = MFMA32(a3, b1, acc[3][1]); }
#define GW_ST2(BUF, OFF, R0, R1) { bf16_t* d_ = lds + (BUF) * 2 * WT_E + (OFF) + lrow * LDT + lkc; \
      *(u32x4*)(d_) = R0; *(u32x4*)(d_ + 64 * LDT) = R1; }
  __syncthreads();
  GW_GLOAD(0)
  GW_LSTORE(0)
  GW_GLOAD(1)
  GW_GLOAD_B(nkt > 2 ? 2 : nkt - 1)
  __syncthreads();
  for (int kt = 0; kt < nkt; kt += 2) {
    __builtin_amdgcn_sched_barrier(0);
    GW_ST2(1, 0, rw0, rw1)                         GW_KS(kt, 0)
    GW_ST2(1, 128 * LDT, rw2, rw3)                 GW_KS(kt, 1)
    GW_ST2(1, WT_E, rx0, rx1)                      GW_KS(kt, 2)
    GW_ST2(1, WT_E + 128 * LDT, rx2, rx3)          GW_KS(kt, 3)
    __builtin_amdgcn_sched_barrier(0);
    GW_GLOAD(kt + 3 < nkt ? kt + 3 : nkt - 1)
    __syncthreads();
    __builtin_amdgcn_sched_barrier(0);
    GW_ST2(0, 0, sw0, sw1)                         GW_KS(kt + 1, 0)
    GW_ST2(0, 128 * LDT, sw2, sw3)                 GW_KS(kt + 1, 1)
    GW_ST2(0, WT_E, sx0, sx1)                      GW_KS(kt + 1, 2)
    GW_ST2(0, WT_E + 128 * LDT, sx2, sx3)          GW_KS(kt + 1, 3)
    __builtin_amdgcn_sched_barrier(0);
    GW_GLOAD_B(kt + 4 < nkt ? kt + 4 : nkt - 1)
    __syncthreads();
  }
#undef GW_KS
#undef GW_ST2
#undef GW_GLOAD_B
#undef GW_LSTORE_B
#undef GW_GLOAD
#undef GW_LSTORE
}

constexpr int MID_E = (128 + 256) * LDT;
DI void gemm_mid(const bf16_t* __restrict__ W, int ldw, const bf16_t* __restrict__ X, size_t ldx, int mclamp, int kts,
                 int nkt, int m0, f32x16 (&acc)[2][2], bf16_t* lds) {
  const int tid = tidx(), lane = tid & 63, wv = tid >> 6, wn = wv & 1, wm = wv >> 1;
  const int lr = lane & 31, lh = lane >> 5;
  const int lrow = tid >> 3, lkc = (tid & 7) * 8;
  const bf16_t* wp = W + (size_t)lrow * ldw + lkc;
  const size_t wst = (size_t)64 * ldw;
  const bf16_t *xp0, *xp1, *xp2, *xp3;
  { int m;
    m = m0 + lrow;       m = m < mclamp ? m : mclamp; xp0 = X + (size_t)m * ldx + lkc;
    m = m0 + lrow + 64;  m = m < mclamp ? m : mclamp; xp1 = X + (size_t)m * ldx + lkc;
    m = m0 + lrow + 128; m = m < mclamp ? m : mclamp; xp2 = X + (size_t)m * ldx + lkc;
    m = m0 + lrow + 192; m = m < mclamp ? m : mclamp; xp3 = X + (size_t)m * ldx + lkc; }
  u32x4 rw0, rw1, rx0, rx1, rx2, rx3;
#define GM_GLOAD(KT) { \
    rw0 = *(const u32x4*)(wp + (size_t)(KT) * 64); rw1 = *(const u32x4*)(wp + wst + (size_t)(KT) * 64); \
    rx0 = *(const u32x4*)(xp0 + (size_t)(KT) * kts); rx1 = *(const u32x4*)(xp1 + (size_t)(KT) * kts); \
    rx2 = *(const u32x4*)(xp2 + (size_t)(KT) * kts); rx3 = *(const u32x4*)(xp3 + (size_t)(KT) * kts); }
#define GM_LSTORE(BUF) { bf16_t* wb_ = lds + (BUF) * MID_E + lrow * LDT + lkc; bf16_t* xb_ = wb_ + 128 * LDT; \
    *(u32x4*)(wb_) = rw0; *(u32x4*)(wb_ + 64 * LDT) = rw1; \
    *(u32x4*)(xb_) = rx0; *(u32x4*)(xb_ + 64 * LDT) = rx1; *(u32x4*)(xb_ + 128 * LDT) = rx2; *(u32x4*)(xb_ + 192 * LDT) = rx3; }
  __syncthreads();
  GM_GLOAD(0)
  GM_LSTORE(0)
  __syncthreads();
  for (int kt = 0; kt < nkt; ++kt) {
    const bool more = kt + 1 < nkt;
    if (more) GM_GLOAD(kt + 1)
    __builtin_amdgcn_sched_barrier(0);
    {
      const bf16_t* wb = lds + (kt & 1) * MID_E + (wn * 64 + lr) * LDT + lh * 8;
      const bf16_t* xb = lds + (kt & 1) * MID_E + 128 * LDT + (wm * 64 + lr) * LDT + lh * 8;
#pragma unroll
      for (int ks = 0; ks < 4; ++ks) {
        const bf16x8 a0 = *(const bf16x8*)(wb + ks * 16), a1 = *(const bf16x8*)(wb + 32 * LDT + ks * 16);
        const bf16x8 b0 = *(const bf16x8*)(xb + ks * 16), b1 = *(const bf16x8*)(xb + 32 * LDT + ks * 16);
        acc[0][0] = MFMA32(a0, b0, acc[0][0]); acc[0][1] = MFMA32(a0, b1, acc[0][1]);
        acc[1][0] = MFMA32(a1, b0, acc[1][0]); acc[1][1] = MFMA32(a1, b1, acc[1][1]);
      }
    }
    __builtin_amdgcn_sched_barrier(0);
    if (more) GM_LSTORE((kt + 1) & 1)
    __syncthreads();
  }
#undef GM_GLOAD
#undef GM_LSTORE
}

DI void zero_acc(f32x16 (&acc)[2][2]) {
#pragma unroll
  for (int a = 0; a < 2; ++a)
#pragma unroll
    for (int b = 0; b < 2; ++b)
#pragma unroll
      for (int i = 0; i < 16; ++i) acc[a][b][i] = 0.f;
}
DI void zero_acc8(f32x16 (&acc)[4][2]) {
#pragma unroll
  for (int a = 0; a < 4; ++a)
#pragma unroll
    for (int b = 0; b < 2; ++b)
#pragma unroll
      for (int i = 0; i < 16; ++i) acc[a][b][i] = 0.f;
}

DI const float* tile_rstd(const float* __restrict__ part, int m0, bf16_t* sm) {
  float* rs = (float*)((unsigned char*)sm + 139264);
  const int tid = tidx();
  if (tid < 256) {
    const float4* p4 = (const float4*)(part + (size_t)(m0 + tid) * 16);
    float s = 0.f;
#pragma unroll
    for (int i = 0; i < 4; ++i) { float4 v = p4[i]; s += v.x + v.y + v.z + v.w; }
    rs[tid] = rsqrtf(s * (1.f / 1024.f) + 1e-6f);
  }
  __syncthreads();
  return rs;
}
DI float row_rstd(const float* __restrict__ part, int m) {
  const float4* p4 = (const float4*)(part + (size_t)m * 16);
  float s = 0.f;
#pragma unroll
  for (int i = 0; i < 4; ++i) { float4 v = p4[i]; s += v.x + v.y + v.z + v.w; }
  return rsqrtf(s * (1.f / 1024.f) + 1e-6f);
}

struct Geo { int xcd, loc, nloc; };
struct TileWalk {
  int xcd, loc, nloc, ng, NT, g, i;
  DI TileWalk(int NT_, const Geo& ge) : xcd(ge.xcd), loc(ge.loc), nloc(ge.nloc), ng((NT_ + 7) >> 3), NT(NT_), g(0), i(ge.loc) {}
  DI bool next(int& mt, int& nt) {
    for (;;) {
      if (g >= ng) return false;
      if (i >= 64) { i = loc; ++g; continue; }
      mt = xcd * 8 + (i & 7); nt = g * 8 + (i >> 3);
      i += nloc;
      if (nt < NT) return true;
    }
  }
};

DI int next_task(unsigned* ctr, bf16_t* sm) {
  volatile int* slot = (volatile int*)((unsigned char*)sm + LDS_BYTES - 16);
  __syncthreads();
  if (threadIdx.x == 0) *slot = (int)__hip_atomic_fetch_add(ctr, 1u, __ATOMIC_RELAXED, __HIP_MEMORY_SCOPE_AGENT);
  __syncthreads();
  return __builtin_amdgcn_readfirstlane(*slot);
}

DI void tr_tile(const float* __restrict__ src, int ldS, int C, int r0, int c0, bf16_t* __restrict__ dst, int ldd,
                const float* __restrict__ g, int remap, float* tl) {
  const int tid = tidx() & 255;
  __syncthreads();
  {
    const int c4 = (tid & 15) * 4;
#pragma unroll
    for (int i = 0; i < 4; ++i) {
      const int r = (tid >> 4) + 16 * i;
      float4 v = make_float4(0.f, 0.f, 0.f, 0.f);
      if (c0 + c4 < C) {
        v = *(const float4*)(src + (size_t)(r0 + r) * ldS + c0 + c4);
        if (g) { const float gg = g[r0 + r]; v.x *= gg; v.y *= gg; v.z *= gg; v.w *= gg; }
      }
      float* t4 = tl + r * 65 + c4;
      t4[0] = v.x; t4[1] = v.y; t4[2] = v.z; t4[3] = v.w;
    }
  }
  __syncthreads();
  {
    const int c = tid >> 2, rq = (tid & 3) * 16;
    if (c0 + c < C) {
      int dr = c0 + c;
      if (remap) { if (dr >= 3608) dr -= 24; else if (dr >= 3584) dr += 6656 - 3584; }
      unsigned w[8];
#pragma unroll
      for (int k = 0; k < 8; ++k) w[k] = pack2(tl[(rq + 2 * k) * 65 + c], tl[(rq + 2 * k + 1) * 65 + c]);
      uint4* d4 = (uint4*)(dst + (size_t)dr * ldd + r0 + rq);
      d4[0] = make_uint4(w[0], w[1], w[2], w[3]);
      d4[1] = make_uint4(w[4], w[5], w[6], w[7]);
    }
  }
}

DI void tr_tile_wave(const float* __restrict__ src, int ldS, int C, int r0, int c0, bf16_t* __restrict__ dst, int ldd,
                     const float* __restrict__ g, int remap, float* tl) {
  const int lane = tidx() & 63;
  {
    const int c4 = (lane & 15) * 4;
    float4 v[16];
#pragma unroll
    for (int i = 0; i < 16; ++i) {
      const int r = (lane >> 4) + 4 * i;
      v[i] = make_float4(0.f, 0.f, 0.f, 0.f);
      if (c0 + c4 < C) v[i] = *(const float4*)(src + (size_t)(r0 + r) * ldS + c0 + c4);
    }
#pragma unroll
    for (int i = 0; i < 16; ++i) {
      const int r = (lane >> 4) + 4 * i;
      const float gg = g ? g[r0 + r] : 1.f;
      float* t4 = tl + r * 65 + c4;
      t4[0] = v[i].x * gg; t4[1] = v[i].y * gg; t4[2] = v[i].z * gg; t4[3] = v[i].w * gg;
    }
  }
  __builtin_amdgcn_fence(__ATOMIC_RELEASE, "wavefront");
  __builtin_amdgcn_wave_barrier();
#pragma unroll
  for (int j = 0; j < 4; ++j) {
    const int c = (lane >> 2) + 16 * j, rq = (lane & 3) * 16;
    if (c0 + c < C) {
      int dr = c0 + c;
      if (remap) { if (dr >= 3608) dr -= 24; else if (dr >= 3584) dr += 6656 - 3584; }
      unsigned w[8];
#pragma unroll
      for (int k = 0; k < 8; ++k) w[k] = pack2(tl[(rq + 2 * k) * 65 + c], tl[(rq + 2 * k + 1) * 65 + c]);
      uint4* d4 = (uint4*)(dst + (size_t)dr * ldd + r0 + rq);
      d4[0] = make_uint4(w[0], w[1], w[2], w[3]);
      d4[1] = make_uint4(w[4], w[5], w[6], w[7]);
    }
  }
  __builtin_amdgcn_wave_barrier();
}

DI void phase0(const P& p, bf16_t* sm) {
  const int tid5 = tidx(), half = tid5 >> 8, tid = tid5 & 255, lane = tid5 & 63, wv8 = tid5 >> 6;
  float* tl = (float*)sm + half * (64 * 65);
  constexpr int NTR_L = 1680 + 384 + 256 + 1024 + 1024 + 256 + 8;
  {
    float* tlw = (float*)sm + wv8 * (64 * 65);
    for (int t = blockIdx.x * 8 + wv8; t < NTR_L * NL; t += gridDim.x * 8) {
      const int layer = t / NTR_L; int r = t % NTR_L;
      if (r < 1680) {
        tr_tile_wave(p.w_in + (size_t)layer * 1024 * NIN, NIN, NIN, (r / 105) * 64, (r % 105) * 64,
                     (bf16_t*)(p.ws + O_WIN + layer * SZ_WIN), LDK1, p.norm_mix + layer * 1024, 1, tlw);
      } else if ((r -= 1680) < 384) {
        const int n3 = r / 128; r %= 128;
        tr_tile_wave(p.w_branch + ((size_t)layer * 3 + n3) * 512 * 1024, 1024, 1024, (r / 16) * 64, (r % 16) * 64,
                     (bf16_t*)(p.ws + O_WBR + layer * SZ_WBR) + (size_t)n3 * 1024 * 512, 512, nullptr, 0, tlw);
      } else if ((r -= 384) < 256) {
        tr_tile_wave(p.w_out + (size_t)layer * 1024 * 1024, 1024, 1024, (r / 16) * 64, (r % 16) * 64,
                     (bf16_t*)(p.ws + O_WO + layer * SZ_WO), LDK1, nullptr, 0, tlw);
      } else if ((r -= 256) < 1024) {
        tr_tile_wave(p.w_up + (size_t)layer * 1024 * 4096, 4096, 4096, (r / 64) * 64, (r % 64) * 64,
                     (bf16_t*)(p.ws + O_WUP + layer * SZ_WUP), LDK1, p.norm_mlp + layer * 1024, 0, tlw);
      } else if ((r -= 1024) < 1024) {
        tr_tile_wave(p.w_down + (size_t)layer * 4096 * 1024, 1024, 1024, (r / 16) * 64, (r % 16) * 64,
                     (bf16_t*)(p.ws + O_WDN + layer * SZ_WDN), LDK4, nullptr, 0, tlw);
      } else if ((r -= 1024) < 256) {
        const int kv = r / 128; r %= 128;
        tr_tile_wave(p.cmp_w1 + ((size_t)layer * 2 + kv) * 2048 * 256, 256, 256, (r / 4) * 64, (r % 4) * 64,
                     (bf16_t*)(p.ws + O_W1 + layer * SZ_W1) + (size_t)kv * 256 * 2048, 2048, nullptr, 0, tlw);
      } else {
        r -= 256;
        const int kv = r / 4; r %= 4;
        tr_tile_wave(p.cmp_w2 + ((size_t)layer * 2 + kv) * 256 * 64, 64, 64, r * 64, 0,
                     (bf16_t*)(p.ws + O_W2 + layer * SZ_W2) + (size_t)kv * 128 * 256, 256, nullptr, 0, tlw);
      }
    }
    __syncthreads();
  }
  constexpr int J_TR = 0;
  constexpr int J_X = J_TR + T_ / 8;
  constexpr int J_POS = J_X + 256;
  constexpr int J_MISC = J_POS + 1;
  constexpr int ZW_PER = ((NINP - NIN) * LDK1 / 8 + 511) / 512;
  constexpr int J_ZW = J_MISC + NL * ZW_PER;
  constexpr int J_ZW2 = J_ZW + 32;
  for (int job = blockIdx.x; job < J_ZW2; job += gridDim.x) {
    if (job < J_TR) {
      const int t = job * 2 + half;
      const int layer = t / NTR_L; int r = t % NTR_L;
      if (r < 1680) {
        tr_tile(p.w_in + (size_t)layer * 1024 * NIN, NIN, NIN, (r / 105) * 64, (r % 105) * 64,
                (bf16_t*)(p.ws + O_WIN + layer * SZ_WIN), LDK1, p.norm_mix + layer * 1024, 1, tl);
      } else if ((r -= 1680) < 384) {
        const int n3 = r / 128; r %= 128;
        tr_tile(p.w_branch + ((size_t)layer * 3 + n3) * 512 * 1024, 1024, 1024, (r / 16) * 64, (r % 16) * 64,
                (bf16_t*)(p.ws + O_WBR + layer * SZ_WBR) + (size_t)n3 * 1024 * 512, 512, nullptr, 0, tl);
      } else if ((r -= 384) < 256) {
        tr_tile(p.w_out + (size_t)layer * 1024 * 1024, 1024, 1024, (r / 16) * 64, (r % 16) * 64,
                (bf16_t*)(p.ws + O_WO + layer * SZ_WO), LDK1, nullptr, 0, tl);
      } else if ((r -= 256) < 1024) {
        tr_tile(p.w_up + (size_t)layer * 1024 * 4096, 4096, 4096, (r / 64) * 64, (r % 64) * 64,
                (bf16_t*)(p.ws + O_WUP + layer * SZ_WUP), LDK1, p.norm_mlp + layer * 1024, 0, tl);
      } else if ((r -= 1024) < 1024) {
        tr_tile(p.w_down + (size_t)layer * 4096 * 1024, 1024, 1024, (r / 16) * 64, (r % 16) * 64,
                (bf16_t*)(p.ws + O_WDN + layer * SZ_WDN), LDK4, nullptr, 0, tl);
      } else if ((r -= 1024) < 256) {
        const int kv = r / 128; r %= 128;
        tr_tile(p.cmp_w1 + ((size_t)layer * 2 + kv) * 2048 * 256, 256, 256, (r / 4) * 64, (r % 4) * 64,
                (bf16_t*)(p.ws + O_W1 + layer * SZ_W1) + (size_t)kv * 256 * 2048, 2048, nullptr, 0, tl);
      } else {
        r -= 256;
        const int kv = r / 4; r %= 4;
        tr_tile(p.cmp_w2 + ((size_t)layer * 2 + kv) * 256 * 64, 64, 64, r * 64, 0,
                (bf16_t*)(p.ws + O_W2 + layer * SZ_W2) + (size_t)kv * 128 * 256, 256, nullptr, 0, tl);
      }
    } else if (job < J_X) {
      const int row = (job - J_TR) * 8 + wv8;
      const float4* src = (const float4*)(p.x + (size_t)row * 1024);
      bf16_t* xb = (bf16_t*)(p.ws + O_XB) + (size_t)row * LDK1;
      float ss = 0.f;
#pragma unroll
      for (int i = 0; i < 4; ++i) {
        float4 v = src[lane + 64 * i];
        ss += v.x * v.x + v.y * v.y + v.z * v.z + v.w * v.w;
        *(uint2*)(xb + (lane + 64 * i) * 4) = make_uint2(pack2(v.x, v.y), pack2(v.z, v.w));
      }
#pragma unroll
      for (int o = 32; o >= 1; o >>= 1) ss += __shfl_xor(ss, o);
      float* part = (float*)(p.ws + O_PART) + (size_t)row * 16;
      if (lane < 16) part[lane] = lane == 0 ? ss : 0.f;
    } else if (job < J_POS) {
      const int jj = job - J_X; const int unit = jj >> 2, kq = jj & 3, lk = unit >> 3, ng = unit & 7;
      const int col = ng * 32 + (tid5 & 31), ksl = tid5 >> 5;
      const float* pos = p.cmp_pos + (size_t)lk * 2048;
      const float* w1 = p.cmp_w1 + (size_t)lk * 2048 * 256;
      float s = 0.f;
      const int k0 = kq * 512 + ksl * 32;
#pragma unroll 8
      for (int k = k0; k < k0 + 32; ++k) s += pos[k] * w1[(size_t)k * 256 + col];
      float* red = (float*)sm;
      __syncthreads();
      red[tid5] = s;
      __syncthreads();
      if (tid5 < 32) {
        float t = 0.f;
        for (int q = 0; q < 16; ++q) t += red[q * 32 + tid5];
        ((float*)(p.ws + O_POSW1))[(lk * 4 + kq) * 256 + col] = t;
      }
    } else if (job < J_MISC) {
      float* tabs = (float*)(p.ws + O_TABS);
      for (int i = tid5; i < 20 * 129; i += NTHR) {
        const int h = i / 129, d = i % 129;
        int bk;
        if (d < 16) bk = d;
        else { bk = 16 + (int)(logf((float)d / 16.f) / 2.0794415416798357f * 16.f); if (bk > 31) bk = 31; }
        tabs[h * 132 + d] = p.rel_bias[bk * 20 + h] * LOG2E;
      }
      if (wv8 == 0) {
        for (int layer = 0; layer < NL; ++layer) {
          const float* lm = p.diff_lambda + layer * 256;
          float a = lm[lane] * lm[64 + lane], b = lm[128 + lane] * lm[192 + lane];
#pragma unroll
          for (int o = 32; o >= 1; o >>= 1) { a += __shfl_xor(a, o); b += __shfl_xor(b, o); }
          const float li = 0.8f - 0.6f * expf(-0.3f * (float)layer);
          if (lane == 0) ((float*)(p.ws + O_LAM))[layer] = expf(a) - expf(b) + li;
        }
      }
    } else if (job < J_ZW) {
      const int jj = job - J_MISC; const int layer = jj / ZW_PER, q = jj % ZW_PER;
      uint4* d = (uint4*)(p.ws + O_WIN + layer * SZ_WIN + (size_t)NIN * LDK1 * 2) + q * 512 + tid5;
      if (q * 512 + tid5 < (NINP - NIN) * LDK1 / 8) *d = make_uint4(0, 0, 0, 0);
    } else {
      const int jj = job - J_ZW; const int lk = jj >> 2, q = jj & 3;
      uint4* d = (uint4*)(p.ws + O_W2 + (size_t)lk * 128 * 256 * 2 + 64 * 256 * 2) + q * 512 + tid5;
      *d = make_uint4(0, 0, 0, 0);
    }
  }
}

DI bool epi_inproj_chunk(const P& p, int layer, int ch, int m0w, f32x16 (&a0)[2], f32x16 (&a1)[2], bf16_t* stg, int cp,
                         bf16_t*& rdst, int& rldd, int& rcoff, float rs0, float rs1) {
  const int lane = tidx() & 63;
  const int lr = lane & 31, lh = lane >> 5;
  enum { NORM, RAW, TRANS, SIG, CG };
  int type = RAW, ldd = 512, coff = 0, nh = 2, dv = 64, hd = 0, doff = 0;
  bf16_t* dst = nullptr; const float* gain = nullptr; float scl = 1.f;
  const float* gains = p.qk_gain + layer * 512;
  unsigned char* ws = p.ws;
  if (ch < 8) { type = NORM; dst = (bf16_t*)(ws + O_AQ); coff = ch * 64; gain = gains; scl = QSCL; }
  else if (ch < 16) { type = NORM; dst = (bf16_t*)(ws + O_AK); coff = (ch - 8) * 64; gain = gains + 64; }
  else if (ch < 24) { type = TRANS; dst = (bf16_t*)(ws + O_AVT); nh = 4; dv = 128; hd = (ch - 16) >> 1; doff = ((ch - 16) & 1) * 64; }
  else if (ch < 32) { type = NORM; dst = (bf16_t*)(ws + O_BQ); coff = (ch - 24) * 64; gain = gains + 128; scl = QSCL; }
  else if (ch < 34) { type = NORM; dst = (bf16_t*)(ws + O_BK); ldd = 128; coff = (ch - 32) * 64; gain = gains + 192; }
  else if (ch < 36) { type = TRANS; dst = (bf16_t*)(ws + O_BVT); hd = ch - 34; }
  else if (ch < 44) { type = NORM; dst = (bf16_t*)(ws + O_CQ); coff = (ch - 36) * 64; gain = gains + 256; scl = QSCL; }
  else if (ch < 46) { type = RAW; dst = (bf16_t*)(ws + O_CK); ldd = 128; coff = (ch - 44) * 64; }
  else if (ch < 48) { type = RAW; dst = (bf16_t*)(ws + O_CV); ldd = 128; coff = (ch - 46) * 64; }
  else if (ch < 50) { type = NORM; dst = (bf16_t*)(ws + O_KS); ldd = 128; coff = (ch - 48) * 64; gain = gains + 384; }
  else if (ch < 52) { type = TRANS; dst = (bf16_t*)(ws + O_VST); hd = ch - 50; }
  else if (ch < 54) { type = NORM; dst = (bf16_t*)(ws + O_KW); ldd = 128; coff = (ch - 52) * 64; gain = gains + 448; }
  else if (ch < 56) { type = TRANS; dst = (bf16_t*)(ws + O_VWT); hd = ch - 54; }
  else if (ch < 104) { type = SIG; dst = (bf16_t*)(ws + O_MGS); ldd = 3072; coff = (ch - 56) * 64; }
  else if (ch == 104) { type = CG; }
  else return false;
  rdst = dst; rldd = ldd; rcoff = coff;
#pragma unroll
  for (int mt = 0; mt < 2; ++mt) {
    const int m = m0w + mt * 32 + lr;
    const float rs = mt ? rs1 : rs0;
    float v[2][16];
    float ss = 0.f;
#pragma unroll
    for (int i = 0; i < 16; ++i) { float t = a0[mt][i] * rs; v[0][i] = t; ss += t * t; }
#pragma unroll
    for (int i = 0; i < 16; ++i) { float t = a1[mt][i] * rs; v[1][i] = t; ss += t * t; }
    if (type == NORM) {
      ss += xor32(ss);
      const float r = rsqrtf(ss * (1.f / 64.f) + 1e-6f) * scl;
#pragma unroll
      for (int nt = 0; nt < 2; ++nt)
#pragma unroll
        for (int qd = 0; qd < 4; ++qd) {
          const int n = nt * 32 + 8 * qd + 4 * lh;
          const float4 g4 = *(const float4*)(gain + n);
          *(uint2*)(stg + (mt * 32 + lr) * 136 + cp * 64 + n) =
              make_uint2(pack2(v[nt][4 * qd] * r * g4.x, v[nt][4 * qd + 1] * r * g4.y),
                         pack2(v[nt][4 * qd + 2] * r * g4.z, v[nt][4 * qd + 3] * r * g4.w));
        }
    } else if (type == RAW || type == SIG) {
#pragma unroll
      for (int nt = 0; nt < 2; ++nt)
#pragma unroll
        for (int qd = 0; qd < 4; ++qd) {
          const int n = nt * 32 + 8 * qd + 4 * lh;
          float a = v[nt][4 * qd], b = v[nt][4 * qd + 1], c = v[nt][4 * qd + 2], d = v[nt][4 * qd + 3];
          if (type == SIG) { a = sigmoidf_(a); b = sigmoidf_(b); c = sigmoidf_(c); d = sigmoidf_(d); }
          if (type == SIG)
            { typedef unsigned u32x2_t __attribute__((ext_vector_type(2))); u32x2_t gv; gv[0] = pack2(a, b); gv[1] = pack2(c, d);
              __builtin_nontemporal_store(gv, (u32x2_t*)(dst + ((size_t)((coff + n) >> 2) * T_ + m) * 4)); }
          else
            *(uint2*)(stg + (mt * 32 + lr) * 136 + cp * 64 + n) = make_uint2(pack2(a, b), pack2(c, d));
        }
    } else if (type == TRANS) {
      const int b = m >> 12, s = m & 4095;
      bf16_t* base = dst + ((size_t)(b * nh + hd) * dv + doff) * S_ + s;
#pragma unroll
      for (int nt = 0; nt < 2; ++nt)
#pragma unroll
        for (int i = 0; i < 16; ++i) {
          const int n = nt * 32 + 8 * (i >> 2) + 4 * lh + (i & 3);
          base[(size_t)n * S_] = f2bf(v[nt][i]);
        }
    } else {
      float* cg = (float*)(ws + O_CGS) + (size_t)m * 24;
#pragma unroll
      for (int i = 0; i < 16; ++i) {
        const int n = 8 * (i >> 2) + 4 * lh + (i & 3);
        if (n < 24) cg[n] = sigmoidf_(v[0][i]);
      }
    }
  }
  return type == NORM || type == RAW;
}

template <bool NT = false>
DI void stage_rows_store(const bf16_t* stg, bf16_t* dst, size_t ldd, int m0w) {
  const int lane = tidx() & 63;
#pragma unroll
  for (int it = 0; it < 16; ++it) {
    const int row = it * 4 + (lane >> 4), c16 = lane & 15;
    const u32x4 v = *(const u32x4*)(stg + row * 136 + c16 * 8);
    u32x4* d = (u32x4*)(dst + (size_t)(m0w + row) * ldd + c16 * 8);
    if (NT) __builtin_nontemporal_store(v, d);
    else *d = v;
  }
}

DI void phase_inproj(const P& p, int layer, bf16_t* sm, const Geo& ge) {
  const bf16_t* W = (const bf16_t*)(p.ws + O_WIN + layer * SZ_WIN);
  const bf16_t* X = (const bf16_t*)(p.ws + O_XB);
  TileWalk tw(27, ge);
  int mt, nt, mt_have = -1;
  float rs0 = 0.f, rs1 = 0.f;
  while (tw.next(mt, nt)) {
    if (mt != mt_have) {
      const int lane_ = tidx() & 63, wm_ = (tidx() >> 6) >> 1;
      rs0 = row_rstd((const float*)(p.ws + O_PART), mt * 256 + wm_ * 64 + (lane_ & 31));
      rs1 = row_rstd((const float*)(p.ws + O_PART), mt * 256 + wm_ * 64 + 32 + (lane_ & 31));
      mt_have = mt;
    }
    f32x16 acc[4][2]; zero_acc8(acc);
    gemm_wide(W + (size_t)nt * 256 * LDK1, LDK1, X + (size_t)mt * 256 * LDK1, LDK1, 16, acc, sm);
    const int wv = tidx() >> 6, wn = wv & 1, wm = wv >> 1;
    bf16_t* stg = sm + wv * (64 * 136);
    bf16_t *d0 = nullptr, *d1 = nullptr; int ld0 = 0, ld1 = 0, co0 = 0, co1 = 0;
    const bool s0 = epi_inproj_chunk(p, layer, nt * 4 + wn * 2, mt * 256 + wm * 64, acc[0], acc[1], stg, 0, d0, ld0, co0, rs0, rs1);
    const bool s1 = epi_inproj_chunk(p, layer, nt * 4 + wn * 2 + 1, mt * 256 + wm * 64, acc[2], acc[3], stg, 1, d1, ld1, co1, rs0, rs1);
    if (s0 && s1) stage_rows_store(stg, d0 + co0, ld0, mt * 256 + wm * 64);
  }
}

template <int NDT, int MODE, bool ALLON>
DI void attn_tile(const bf16_t* Kl, int kst, const bf16_t* Vl, const bf16x8 (&q)[4], f32x16 (&O)[NDT], float& m, float& l,
                  int kbase, int qp, int win, float cbias, const float* tab, bool lane_on) {
  const int lane = tidx() & 63, lr = lane & 31, lh = lane >> 5;
  f32x16 s[2];
#pragma unroll
  for (int st = 0; st < 2; ++st) {
#pragma unroll
    for (int i = 0; i < 16; ++i) s[st][i] = 0.f;
  }
#pragma unroll
  for (int ks = 0; ks < 4; ++ks) {
    const bf16x8 k0 = *(const bf16x8*)(Kl + lr * kst + ks * 16 + lh * 8);
    const bf16x8 k1 = *(const bf16x8*)(Kl + (32 + lr) * kst + ks * 16 + lh * 8);
    s[0] = MFMA32(k0, q[ks], s[0]);
    s[1] = MFMA32(k1, q[ks], s[1]);
  }
  float alpha, psum = 0.f;
  if (MODE == 0) {
    float tmax = fmaxf(s[0][0], s[1][0]);
#pragma unroll
    for (int i = 1; i < 16; ++i) tmax = fmaxf(tmax, fmaxf(s[0][i], s[1][i]));
    tmax = fmaxf(tmax, xor32(tmax)) + cbias;
    if (!ALLON) tmax = lane_on ? tmax : -1e30f;
    const float mn = fmaxf(m, tmax);
    alpha = ex2(m - mn);
    m = mn;
    const float mc = (ALLON || lane_on) ? mn - cbias : 1e30f;
#pragma unroll
    for (int st = 0; st < 2; ++st)
#pragma unroll
      for (int i = 0; i < 16; ++i) { const float pe = ex2(s[st][i] - mc); psum += pe; s[st][i] = pe; }
  } else {
    float tmax = -1e30f;
#pragma unroll
    for (int st = 0; st < 2; ++st)
#pragma unroll
      for (int i = 0; i < 16; ++i) {
        const int key = kbase + st * 32 + 8 * (i >> 2) + 4 * lh + (i & 3);
        float v;
        if (MODE == 1) {
          const int dist = qp - key;
          const bool ok = (ALLON || lane_on) && dist >= 0 && dist < win;
          const int di = dist < 0 ? 0 : (dist > 128 ? 128 : dist);
          v = ok ? s[st][i] + tab[di] : -1e30f;
        } else {
          v = (16 * key + 31 <= qp) ? s[st][i] : -1e30f;
        }
        s[st][i] = v;
        tmax = fmaxf(tmax, v);
      }
    tmax = fmaxf(tmax, xor32(tmax));
    const float mn = fmaxf(m, tmax);
    alpha = ex2(m - mn);
    m = mn;
#pragma unroll
    for (int st = 0; st < 2; ++st)
#pragma unroll
      for (int i = 0; i < 16; ++i) {
        const float pe = s[st][i] > -5e29f ? ex2(s[st][i] - mn) : 0.f;
        psum += pe;
        s[st][i] = pe;
      }
  }
  l = l * alpha + psum;
  if (__ballot(alpha != 1.f)) {
#pragma unroll
    for (int dt = 0; dt < NDT; ++dt)
#pragma unroll
      for (int i = 0; i < 16; ++i) O[dt][i] *= alpha;
  }
#pragma unroll
  for (int st = 0; st < 2; ++st)
#pragma unroll
    for (int sk = 0; sk < 2; ++sk) {
      u32x4 pu;
      pu[0] = pack2(s[st][8 * sk + 0], s[st][8 * sk + 1]);
      pu[1] = pack2(s[st][8 * sk + 2], s[st][8 * sk + 3]);
      pu[2] = pack2(s[st][8 * sk + 4], s[st][8 * sk + 5]);
      pu[3] = pack2(s[st][8 * sk + 6], s[st][8 * sk + 7]);
      const bf16x8 pf = __builtin_bit_cast(bf16x8, pu);
#pragma unroll
      for (int dt = 0; dt < NDT; ++dt) {
        const bf16_t* vp = Vl + (dt * 32 + lr) * 72 + st * 32 + sk * 16 + 4 * lh;
        const uint2 v0 = *(const uint2*)(vp);
        const uint2 v1 = *(const uint2*)(vp + 8);
        u32x4 vu; vu[0] = v0.x; vu[1] = v0.y; vu[2] = v1.x; vu[3] = v1.y;
        O[dt] = MFMA32(__builtin_bit_cast(bf16x8, vu), pf, O[dt]);
      }
    }
}

DI float gelu_tanh(float x) {
  const float u = 0.7978845608028654f * (x + 0.044715f * x * x * x);
  const float e = __expf(2.f * u);
  const float th = 1.f - 2.f * __builtin_amdgcn_rcpf(e + 1.f);
  return 0.5f * x * (1.f + th);
}

DI void task_compress(const P& p, int layer, int task, bf16_t* sm) {
  const int tid = tidx(), lane = tid & 63, wv = tid >> 6, wn = wv & 1, wm = wv >> 1;
  const int lr = lane & 31, lh = lane >> 5;
  const int b = task & 3, g = (task >> 2) & 1, kv = task >> 3;
  const bf16_t* src = (const bf16_t*)(p.ws + (kv ? O_CV : O_CK)) + (size_t)b * S_ * 128 + g * 64;
  const bf16_t* W1 = (const bf16_t*)(p.ws + O_W1 + layer * SZ_W1) + (size_t)kv * 256 * 2048;
  const bf16_t* W2 = (const bf16_t*)(p.ws + O_W2 + layer * SZ_W2) + (size_t)kv * 128 * 256;
  bf16_t* hid = (bf16_t*)(p.ws + O_HID) + (size_t)((kv * 2 + g) * 4 + b) * 65536;
  const float* pw = (const float*)(p.ws + O_POSW1) + (layer * 2 + kv) * 1024;
  for (int nt2 = 0; nt2 < 2; ++nt2) {
    f32x16 acc[2][2]; zero_acc(acc);
    gemm_mid(W1 + (size_t)nt2 * 128 * 2048, 2048, src, 16 * 128, 254, 128, 32, 0, acc, sm);
#pragma unroll
    for (int mt = 0; mt < 2; ++mt) {
      const int m = wm * 64 + mt * 32 + lr;
#pragma unroll
      for (int nt = 0; nt < 2; ++nt)
#pragma unroll
        for (int qd = 0; qd < 4; ++qd) {
          const int n = nt2 * 128 + wn * 64 + nt * 32 + 8 * qd + 4 * lh;
          float4 pw4 = *(const float4*)(pw + n);
          { const float4 a1 = *(const float4*)(pw + 256 + n), a2 = *(const float4*)(pw + 512 + n), a3 = *(const float4*)(pw + 768 + n);
            pw4.x = ((pw4.x + a1.x) + a2.x) + a3.x; pw4.y = ((pw4.y + a1.y) + a2.y) + a3.y;
            pw4.z = ((pw4.z + a1.z) + a2.z) + a3.z; pw4.w = ((pw4.w + a1.w) + a2.w) + a3.w; }
          *(uint2*)(hid + (size_t)m * 256 + n) =
              make_uint2(pack2(gelu_tanh(acc[nt][mt][4 * qd] + pw4.x), gelu_tanh(acc[nt][mt][4 * qd + 1] + pw4.y)),
                         pack2(gelu_tanh(acc[nt][mt][4 * qd + 2] + pw4.z), gelu_tanh(acc[nt][mt][4 * qd + 3] + pw4.w)));
        }
    }
  }
  __threadfence();
  __syncthreads();
  {
    f32x16 acc[2][2]; zero_acc(acc);
    gemm_mid(W2, 256, hid, 256, 1 << 30, 64, 4, 0, acc, sm);
    if (wn == 0) {
      const float* gain = p.qk_gain + layer * 512 + 320;
#pragma unroll
      for (int mt = 0; mt < 2; ++mt) {
        const int m = wm * 64 + mt * 32 + lr;
        if (kv == 0) {
          float ss = 0.f;
#pragma unroll
          for (int nt = 0; nt < 2; ++nt)
#pragma unroll
            for (int i = 0; i < 16; ++i) ss += acc[nt][mt][i] * acc[nt][mt][i];
          ss += xor32(ss);
          const float r = rsqrtf(ss * (1.f / 64.f) + 1e-6f);
          bf16_t* kc = (bf16_t*)(p.ws + O_KC) + ((size_t)(b * 2 + g) * 256 + m) * 64;
#pragma unroll
          for (int nt = 0; nt < 2; ++nt)
#pragma unroll
            for (int qd = 0; qd < 4; ++qd) {
              const int n = nt * 32 + 8 * qd + 4 * lh;
              const float4 g4 = *(const float4*)(gain + n);
              *(uint2*)(kc + n) = make_uint2(pack2(acc[nt][mt][4 * qd] * r * g4.x, acc[nt][mt][4 * qd + 1] * r * g4.y),
                                             pack2(acc[nt][mt][4 * qd + 2] * r * g4.z, acc[nt][mt][4 * qd + 3] * r * g4.w));
            }
        } else {
          bf16_t* vc = (bf16_t*)(p.ws + O_VCT) + (size_t)(b * 2 + g) * 64 * 256 + m;
#pragma unroll
          for (int nt = 0; nt < 2; ++nt)
#pragma unroll
            for (int i = 0; i < 16; ++i) {
              const int n = nt * 32 + 8 * (i >> 2) + 4 * lh + (i & 3);
              vc[(size_t)n * 256] = f2bf(acc[nt][mt][i]);
            }
        }
      }
    }
  }
}

DI void task_attnA(const P& p, int layer, int task, bf16_t* sm, int dm) {
  const int tid = tidx(), lane = tid & 63, wv = tid >> 6, c = wv & 1, qs = wv >> 1;
  const int lr = lane & 31, lh = lane >> 5;
  const int qb = 31 - (task >> 4), bh = task & 15, b = bh >> 2, h = bh & 3;
  float* tab = (float*)((unsigned char*)sm + 71680);
  bf16x8* qlds = (bf16x8*)((unsigned char*)sm + 72704) + wv * 256 + lane;
  float* xbuf = (float*)((unsigned char*)sm);
  __syncthreads();
  if (tid < 129) tab[tid] = ((const float*)(p.ws + O_TABS))[h * 132 + tid];
  const int q0 = qb * 128, qmin = q0 + qs * 32, qp = qmin + lr;
  bf16_t* aq = (bf16_t*)(p.ws + O_AQ);
  {
    const bf16_t* qptr = aq + (size_t)(b * S_ + qp) * 512 + h * 128 + c * 64 + lh * 8;
#pragma unroll
    for (int ks = 0; ks < 4; ++ks) qlds[ks * 64] = *(const bf16x8*)(qptr + ks * 16);
  }
  f32x16 O[4];
#pragma unroll
  for (int dt = 0; dt < 4; ++dt)
#pragma unroll
    for (int i = 0; i < 16; ++i) O[dt][i] = 0.f;
  float m = -1e30f, l = 0.f;
  const bf16_t* kg = (const bf16_t*)(p.ws + O_AK) + (size_t)b * S_ * 512 + h * 128;
  const bf16_t* vg = (const bf16_t*)(p.ws + O_AVT) + (size_t)((b * 4 + h) * 128) * S_;
  u32x4 rk0, rk1, rv0, rv1;
#define A_GLOAD(i, KT) { const int chk = tid + 512 * i; \
    rk##i = *(const u32x4*)(kg + (size_t)((KT) * 64 + (chk >> 4)) * 512 + (chk & 15) * 8); \
    rv##i = *(const u32x4*)(vg + (size_t)(chk >> 3) * S_ + (KT) * 64 + (chk & 7) * 8); }
#define A_LSTORE(i) { const int chk = tid + 512 * i; \
    *(u32x4*)(Kl + (chk >> 4) * 136 + (chk & 15) * 8) = rk##i; \
    *(u32x4*)(Kl + 64 * 136 + (chk >> 3) * 72 + (chk & 7) * 8) = rv##i; }
  const int kt_hi = 2 * qb + 1;
  A_GLOAD(0, 0) A_GLOAD(1, 0)
  for (int kt = 0; kt <= kt_hi; ++kt) {
    bf16_t* Kl = sm + (kt & 1) * 17920; const bf16_t* Vl = Kl + 64 * 136;
    A_LSTORE(0) A_LSTORE(1)
    if (kt < kt_hi) { A_GLOAD(0, kt + 1) A_GLOAD(1, kt + 1) }
    __syncthreads();
    if (kt * 64 <= qmin + 31) {
      bf16x8 q[4];
#pragma unroll
      for (int ks = 0; ks < 4; ++ks) q[ks] = qlds[ks * 64];
      if (kt * 64 + 63 + 128 <= qmin)
        attn_tile<4, 0, true>(Kl + c * 64, 136, Vl, q, O, m, l, kt * 64, qp, 0, tab[128], tab, true);
      else
        attn_tile<4, 1, true>(Kl + c * 64, 136, Vl, q, O, m, l, kt * 64, qp, 1 << 30, 0.f, tab, true);
    }
  }
#undef A_GLOAD
#undef A_LSTORE
  const float lt = l + xor32(l);
  const float inv = 1.f / lt;
  __syncthreads();
  if (c == 1) {
#pragma unroll
    for (int dt = 0; dt < 4; ++dt)
#pragma unroll
      for (int i = 0; i < 16; ++i) {
        const int d = dt * 32 + 8 * (i >> 2) + 4 * lh + (i & 3);
        xbuf[(qs * 128 + d) * 32 + lr] = O[dt][i] * inv;
      }
  }
  __syncthreads();
  if (c == 0) {
    const float lam = ((const float*)(p.ws + O_LAM))[layer];
    const float li = 0.8f - 0.6f * expf(-0.3f * (float)layer);
    float ss = 0.f;
#pragma unroll
    for (int dt = 0; dt < 4; ++dt)
#pragma unroll
      for (int i = 0; i < 16; ++i) {
        const int d = dt * 32 + 8 * (i >> 2) + 4 * lh + (i & 3);
        const float o = O[dt][i] * inv - lam * xbuf[(qs * 128 + d) * 32 + lr];
        O[dt][i] = o;
        ss += o * o;
      }
    ss += xor32(ss);
    const float r = rsqrtf(ss * (1.f / 128.f) + 1e-6f) * (1.f - li);
    const float* sub = p.diff_subln + layer * 128;
    bf16_t* dst = (dm ? (bf16_t*)(p.ws + WS_END) : aq) + (size_t)(b * S_ + qp) * 512 + h * 128;
#pragma unroll
    for (int dt = 0; dt < 4; ++dt)
#pragma unroll
      for (int qd = 0; qd < 4; ++qd) {
        const int d = dt * 32 + 8 * qd + 4 * lh;
        const float4 g4 = *(const float4*)(sub + d);
        *(uint2*)(dst + d) = make_uint2(pack2(O[dt][4 * qd] * r * g4.x, O[dt][4 * qd + 1] * r * g4.y),
                                        pack2(O[dt][4 * qd + 2] * r * g4.z, O[dt][4 * qd + 3] * r * g4.w));
      }
  }
}

struct KVRegs { u32x4 k0, v0; };
DI void kv_gload(KVRegs& r, const bf16_t* kg, size_t kld, const bf16_t* vg, size_t vld, int key0) {
  const int c0 = tidx();
  r.k0 = *(const u32x4*)(kg + (size_t)(key0 + (c0 >> 3)) * kld + (c0 & 7) * 8);
  r.v0 = *(const u32x4*)(vg + (size_t)(c0 >> 3) * vld + key0 + (c0 & 7) * 8);
}
DI void kv_lstore(const KVRegs& r, bf16_t* Kl, bf16_t* Vl) {
  const int c0 = tidx();
  *(u32x4*)(Kl + (c0 >> 3) * 72 + (c0 & 7) * 8) = r.k0;
  *(u32x4*)(Vl + (c0 >> 3) * 72 + (c0 & 7) * 8) = r.v0;
}

DI void task_attnB(const P& p, int layer, int task, bf16_t* sm, int dm) {
  const int tid = tidx(), lane = tid & 63, wv = tid >> 6, hr = wv & 3, qs = wv >> 2;
  const int lr = lane & 31, lh = lane >> 5;
  const int qb = 63 - (task >> 3), bg = task & 7, b = bg >> 1, g = bg & 1, head = g * 4 + hr;
  float* tabs = (float*)((unsigned char*)sm + 36864);
  __syncthreads();
  for (int i = tid; i < 4 * 129; i += NTHR) {
    const int r = i / 129, d = i % 129;
    tabs[r * 132 + d] = ((const float*)(p.ws + O_TABS))[(4 + g * 4 + r) * 132 + d];
  }
  const int q0 = qb * 64, qmin = q0 + qs * 32, qp = qmin + lr;
  bf16_t* bq = (bf16_t*)(p.ws + O_BQ);
  bf16x8 q[4];
  {
    const bf16_t* qptr = bq + (size_t)(b * S_ + qp) * 512 + head * 64 + lh * 8;
#pragma unroll
    for (int ks = 0; ks < 4; ++ks) q[ks] = *(const bf16x8*)(qptr + ks * 16);
  }
  f32x16 O[2];
#pragma unroll
  for (int dt = 0; dt < 2; ++dt)
#pragma unroll
    for (int i = 0; i < 16; ++i) O[dt][i] = 0.f;
  float m = p.sinks[layer * 8 + head] * LOG2E, l = lh == 0 ? 1.f : 0.f;
  const bf16_t* kg = (const bf16_t*)(p.ws + O_BK) + (size_t)b * S_ * 128 + g * 64;
  const bf16_t* vg = (const bf16_t*)(p.ws + O_BVT) + (size_t)((b * 2 + g) * 64) * S_;
  const int kt_lo = q0 >= 127 ? (q0 - 127) >> 6 : 0, kt_hi = qb;
  KVRegs R;
  kv_gload(R, kg, 128, vg, S_, kt_lo * 64);
  for (int kt = kt_lo; kt <= kt_hi; ++kt) {
    bf16_t* Kl = sm + (kt & 1) * 9216; bf16_t* Vl = Kl + 4608;
    kv_lstore(R, Kl, Vl);
    if (kt < kt_hi) kv_gload(R, kg, 128, vg, S_, (kt + 1) * 64);
    __syncthreads();
    if (kt * 64 <= qmin + 31 && kt * 64 + 63 + 127 >= qmin)
      attn_tile<2, 1, true>(Kl, 72, Vl, q, O, m, l, kt * 64, qp, 128, 0.f, tabs + hr * 132, true);
  }
  const float lt = l + xor32(l);
  const float inv = 1.f / lt;
  bf16_t* dst = (dm ? (bf16_t*)(p.ws + WS_END) : bq) + (size_t)(b * S_ + qp) * 512 + head * 64;
#pragma unroll
  for (int dt = 0; dt < 2; ++dt)
#pragma unroll
    for (int qd = 0; qd < 4; ++qd) {
      const int d = dt * 32 + 8 * qd + 4 * lh;
      *(uint2*)(dst + d) = make_uint2(pack2(O[dt][4 * qd] * inv, O[dt][4 * qd + 1] * inv),
                                      pack2(O[dt][4 * qd + 2] * inv, O[dt][4 * qd + 3] * inv));
    }
}

DI void phase2(const P& p, int layer, bf16_t* sm, unsigned* qhead, int dm = 0) {
  for (;;) {
    const int task = next_task(qhead, sm);
    if (task >= 16 + 512 + 512) break;
    if (task < 16) task_compress(p, layer, task, sm);
    else if (task < 16 + 512) task_attnA(p, layer, task - 16, sm, dm);
    else task_attnB(p, layer, task - 528, sm, dm);
  }
}

DI void task_nsa(const P& p, int layer, int task, bf16_t* sm, int dm) {
  const int tid = tidx(), lane = tid & 63, wv = tid >> 6, hr = wv & 3, qs = wv >> 2;
  const int lr = lane & 31, lh = lane >> 5;
  const int qb = 63 - (task >> 3), bg = task & 7, b = bg >> 1, g = bg & 1, head = g * 4 + hr;
  float* tabs = (float*)((unsigned char*)sm + 36864);
  float* cbuf = (float*)((unsigned char*)sm + 39168);
  unsigned long long* masks = (unsigned long long*)((unsigned char*)sm + 55808);
  float* outl = (float*)((unsigned char*)sm + 56320) + wv * 2048 + lane;
  int itc = 0;
  __syncthreads();
  for (int i = tid; i < 4 * 129; i += NTHR) {
    const int r = i / 129, d = i % 129;
    tabs[r * 132 + d] = ((const float*)(p.ws + O_TABS))[(12 + g * 4 + r) * 132 + d];
  }
  for (int i = tid; i < 64 * 65; i += NTHR) cbuf[i] = 0.f;
  const float* tab = tabs + hr * 132;
  const int q0 = qb * 64, qmin = q0 + qs * 32, ql = qs * 32 + lr, qp = q0 + ql;
  bf16_t* cq = (bf16_t*)(p.ws + O_CQ);
  bf16x8 q[4];
  {
    const bf16_t* qptr = cq + (size_t)(b * S_ + qp) * 512 + head * 64 + lh * 8;
#pragma unroll
    for (int ks = 0; ks < 4; ++ks) q[ks] = *(const bf16x8*)(qptr + ks * 16);
  }
  const float* cg = (const float*)(p.ws + O_CGS) + (size_t)(b * S_ + qp) * 24 + head * 3;
  const float g0 = cg[0], g1 = cg[1], g2 = cg[2];
  f32x16 O[2];
  KVRegs R;
  {
    int nct = (((q0 + 32) >> 4) + 1 + 63) >> 6; if (nct > 4) nct = 4;
    const bf16_t* kg = (const bf16_t*)(p.ws + O_KC) + (size_t)(b * 2 + g) * 256 * 64;
    const bf16_t* vg = (const bf16_t*)(p.ws + O_VCT) + (size_t)(b * 2 + g) * 64 * 256;
#pragma unroll
    for (int dt = 0; dt < 2; ++dt)
#pragma unroll
      for (int i = 0; i < 16; ++i) O[dt][i] = 0.f;
    float m = -1e30f, l = 0.f;
    kv_gload(R, kg, 64, vg, 256, 0);
    for (int ct = 0; ct < nct; ++ct, ++itc) {
      bf16_t* Kl = sm + (itc & 1) * 9216; bf16_t* Vl = Kl + 4608;
      kv_lstore(R, Kl, Vl);
      if (ct + 1 < nct) kv_gload(R, kg, 64, vg, 256, (ct + 1) * 64);
      __syncthreads();
      attn_tile<2, 2, true>(Kl, 72, Vl, q, O, m, l, ct * 64, qp, 0, 0.f, tab, true);
    }
    const float lt = l + xor32(l);
    const float inv = lt > 0.f ? 1.f / lt : 0.f;
    {
      const float sc = g0 * inv;
#pragma unroll
      for (int dt = 0; dt < 2; ++dt)
#pragma unroll
        for (int i = 0; i < 16; ++i) outl[(dt * 16 + i) * 64] = sc * O[dt][i];
    }
    float carry = 0.f;
    kv_gload(R, kg, 64, vg, 256, 0);
    for (int ct = 0; ct < nct; ++ct, ++itc) {
      bf16_t* Kl = sm + (itc & 1) * 9216; bf16_t* Vl = Kl + 4608;
      kv_lstore(R, Kl, Vl);
      if (ct + 1 < nct) kv_gload(R, kg, 64, vg, 256, (ct + 1) * 64);
      __syncthreads();
      float val[2][4];
#pragma unroll
      for (int st = 0; st < 2; ++st) {
        f32x16 s;
#pragma unroll
        for (int i = 0; i < 16; ++i) s[i] = 0.f;
#pragma unroll
        for (int ks = 0; ks < 4; ++ks) {
          bf16x8 kf = *(const bf16x8*)(Kl + (st * 32 + lr) * 72 + ks * 16 + lh * 8);
          s = MFMA32(kf, q[ks], s);
        }
        float pq[4], pl[4], other[4];
#pragma unroll
        for (int g4 = 0; g4 < 4; ++g4) {
          float sum = 0.f, last = 0.f;
#pragma unroll
          for (int e = 0; e < 4; ++e) {
            const int cc = ct * 64 + st * 32 + 8 * g4 + 4 * lh + e;
            const float pe = (16 * cc + 31 <= qp) ? ex2(s[4 * g4 + e] - m) * inv : 0.f;
            sum += pe; last = pe;
          }
          pq[g4] = sum; pl[g4] = last;
        }
#pragma unroll
        for (int g4 = 0; g4 < 4; ++g4) other[g4] = xor32(pl[g4]);
        val[st][0] = pq[0] + (lh ? other[0] : carry);
        val[st][1] = pq[1] + (lh ? other[1] : other[0]);
        val[st][2] = pq[2] + (lh ? other[2] : other[1]);
        val[st][3] = pq[3] + (lh ? other[3] : other[2]);
        carry = other[3];
      }
      for (int w = 0; w < 4; ++w) {
        if (hr == w) {
#pragma unroll
          for (int st = 0; st < 2; ++st)
#pragma unroll
            for (int g4 = 0; g4 < 4; ++g4) cbuf[(ct * 16 + st * 8 + 2 * g4 + lh) * 65 + ql] += val[st][g4];
        }
        __syncthreads();
      }
    }
  }
  __syncthreads();
  for (int qi = 0; qi < 8; ++qi) {
    const int qq = wv * 8 + qi, qpos = q0 + qq, j = lane, cur = qpos >> 6;
    const float imp = cbuf[j * 65 + qq];
    const bool valid = j <= cur;
    const bool forced = (j == 0) || (j == cur) || (j == cur - 1);
    const float score = valid ? imp + (forced ? 1e4f : 0.f) : -1e30f;
    int rank = 0;
#pragma unroll 4
    for (int jp = 0; jp < 64; ++jp) {
      const float sj = __int_as_float(__builtin_amdgcn_readlane(__float_as_int(score), jp));
      rank += ((sj > score) || (sj == score && jp < j)) ? 1 : 0;
    }
    const unsigned long long mk = __ballot(rank < 16);
    if (lane == 0) masks[qq] = mk;
  }
  __syncthreads();
  const unsigned long long mymask = masks[ql];
  unsigned long long un = 0ull;
  for (int i = 0; i < 64; ++i) un |= masks[i];
  {
    const int cmax = qb;
    unsigned long long todo = un & (cmax == 63 ? ~0ull : ((1ull << (cmax + 1)) - 1ull));
    const bf16_t* kg = (const bf16_t*)(p.ws + O_KS) + (size_t)b * S_ * 128 + g * 64;
    const bf16_t* vg = (const bf16_t*)(p.ws + O_VST) + (size_t)((b * 2 + g) * 64) * S_;
#pragma unroll
    for (int dt = 0; dt < 2; ++dt)
#pragma unroll
      for (int i = 0; i < 16; ++i) O[dt][i] = 0.f;
    float m = -1e30f, l = 0.f;
    kv_gload(R, kg, 128, vg, S_, (__ffsll((long long)todo) - 1) * 64);
    for (; todo; ++itc) {
      const int j = __ffsll((long long)todo) - 1;
      todo &= todo - 1ull;
      bf16_t* Kl = sm + (itc & 1) * 9216; bf16_t* Vl = Kl + 4608;
      kv_lstore(R, Kl, Vl);
      if (todo) kv_gload(R, kg, 128, vg, S_, (__ffsll((long long)todo) - 1) * 64);
      __syncthreads();
      const bool on = (mymask >> j) & 1ull;
      if (j * 64 <= qmin + 31 && __ballot(on)) {
        if (j * 64 + 63 + 128 <= qmin)
          attn_tile<2, 0, false>(Kl, 72, Vl, q, O, m, l, j * 64, qp, 0, tab[128], tab, on);
        else
          attn_tile<2, 1, false>(Kl, 72, Vl, q, O, m, l, j * 64, qp, 1 << 30, 0.f, tab, on);
      }
    }
    const float lt = l + xor32(l);
    const float inv = lt > 0.f ? 1.f / lt : 0.f;
    {
      const float sc = g1 * inv;
#pragma unroll
      for (int dt = 0; dt < 2; ++dt)
#pragma unroll
        for (int i = 0; i < 16; ++i) outl[(dt * 16 + i) * 64] += sc * O[dt][i];
    }
  }
  {
    const bf16_t* kg = (const bf16_t*)(p.ws + O_KW) + (size_t)b * S_ * 128 + g * 64;
    const bf16_t* vg = (const bf16_t*)(p.ws + O_VWT) + (size_t)((b * 2 + g) * 64) * S_;
#pragma unroll
    for (int dt = 0; dt < 2; ++dt)
#pragma unroll
      for (int i = 0; i < 16; ++i) O[dt][i] = 0.f;
    float m = -1e30f, l = 0.f;
    const int kt_lo = q0 >= 511 ? (q0 - 511) >> 6 : 0, kt_hi = qb;
    kv_gload(R, kg, 128, vg, S_, kt_lo * 64);
    for (int kt = kt_lo; kt <= kt_hi; ++kt, ++itc) {
      bf16_t* Kl = sm + (itc & 1) * 9216; bf16_t* Vl = Kl + 4608;
      kv_lstore(R, Kl, Vl);
      if (kt < kt_hi) kv_gload(R, kg, 128, vg, S_, (kt + 1) * 64);
      __syncthreads();
      if (kt * 64 <= qmin + 31 && kt * 64 + 63 + 511 >= qmin) {
        if (kt * 64 + 63 + 128 <= qmin && qmin + 31 - kt * 64 < 512)
          attn_tile<2, 0, true>(Kl, 72, Vl, q, O, m, l, kt * 64, qp, 0, tab[128], tab, true);
        else
          attn_tile<2, 1, true>(Kl, 72, Vl, q, O, m, l, kt * 64, qp, 512, 0.f, tab, true);
      }
    }
    const float lt = l + xor32(l);
    const float inv = 1.f / lt;
    {
      const float sc = g2 * inv;
#pragma unroll
      for (int dt = 0; dt < 2; ++dt)
#pragma unroll
        for (int i = 0; i < 16; ++i) O[dt][i] = outl[(dt * 16 + i) * 64] + sc * O[dt][i];
    }
  }
  bf16_t* dst = (dm ? (bf16_t*)(p.ws + WS_END) : cq) + (size_t)(b * S_ + qp) * 512 + head * 64;
#pragma unroll
  for (int dt = 0; dt < 2; ++dt)
#pragma unroll
    for (int qd = 0; qd < 4; ++qd) {
      const int d = dt * 32 + 8 * qd + 4 * lh;
      *(uint2*)(dst + d) = make_uint2(pack2(O[dt][4 * qd], O[dt][4 * qd + 1]), pack2(O[dt][4 * qd + 2], O[dt][4 * qd + 3]));
    }
}

DI void phase3(const P& p, int layer, bf16_t* sm, unsigned* qhead, int dm = 0) {
  for (;;) {
    const int task = next_task(qhead, sm);
    if (task >= 512) break;
    task_nsa(p, layer, task, sm, dm);
  }
}

DI void phase23(const P& p, int layer, bf16_t* sm, unsigned* qhead, unsigned* cdone) {
  for (;;) {
    const int task = next_task(qhead, sm);
    if (task >= 16 + 512 + 512 + 512) break;
    if (task < 16) {
      task_compress(p, layer, task, sm);
      asm volatile("s_waitcnt vmcnt(0) lgkmcnt(0)" ::: "memory");
      __syncthreads();
      if (threadIdx.x == 0) {
        __builtin_amdgcn_fence(__ATOMIC_RELEASE, "agent");
        asm volatile("s_waitcnt vmcnt(0)" ::: "memory");
        __hip_atomic_fetch_add(cdone, 1u, __ATOMIC_RELAXED, __HIP_MEMORY_SCOPE_AGENT);
      }
    } else if (task < 16 + 512) task_attnA(p, layer, task - 16, sm, 0);
    else if (task >= 1040) task_attnB(p, layer, task - 1040, sm, 0);
    else {
      if (threadIdx.x == 0) {
        while (__hip_atomic_load(cdone, __ATOMIC_RELAXED, __HIP_MEMORY_SCOPE_AGENT) < 16u) __builtin_amdgcn_s_sleep(2);
        __builtin_amdgcn_fence(__ATOMIC_ACQUIRE, "agent");
        asm volatile("s_waitcnt vmcnt(0)" ::: "memory");
      }
      __syncthreads();
      task_nsa(p, layer, task - 528, sm, 0);
    }
  }
}

DI void phase_merge(const P& p, int layer, bf16_t* sm, const Geo& ge) {
  const int tid = tidx(), lane = tid & 63, wv = tid >> 6, wn = wv & 1, wm = wv >> 1;
  const int lr = lane & 31, lh = lane >> 5;
  const bf16_t* W = (const bf16_t*)(p.ws + O_WBR + layer * SZ_WBR);
  const bf16_t* mgs = (const bf16_t*)(p.ws + O_MGS);
  bf16_t* z = (bf16_t*)(p.ws + O_Z);
  TileWalk tw(8, ge);
  int mt_, nt_;
  while (tw.next(mt_, nt_)) {
    unsigned zp[2][2][8];
#pragma unroll
    for (int a_ = 0; a_ < 2; ++a_)
#pragma unroll
      for (int b_ = 0; b_ < 2; ++b_)
#pragma unroll
        for (int i = 0; i < 8; ++i) zp[a_][b_][i] = 0u;
    for (int n3 = 0; n3 < 3; ++n3) {
      const bf16_t* X = (const bf16_t*)(p.ws + (n3 == 0 ? O_AQ : (n3 == 1 ? O_BQ : O_CQ)));
      f32x16 acc[2][2]; zero_acc(acc);
      gemm_mid(W + ((size_t)n3 * 1024 + nt_ * 128) * 512, 512, X, 512, 1 << 30, 64, 8, mt_ * 256, acc, sm);
#pragma unroll
      for (int mt = 0; mt < 2; ++mt) {
        const int m = mt_ * 256 + wm * 64 + mt * 32 + lr;
#pragma unroll
        for (int nt = 0; nt < 2; ++nt)
#pragma unroll
          for (int qd = 0; qd < 4; ++qd) {
            const int n = nt_ * 128 + wn * 64 + nt * 32 + 8 * qd + 4 * lh;
            const uint2 gq = *(const uint2*)(mgs + ((size_t)((n3 * 1024 + n) >> 2) * T_ + m) * 4);
            const unsigned z01 = zp[nt][mt][2 * qd], z23 = zp[nt][mt][2 * qd + 1];
            const float v0 = bf2f((bf16_t)(z01 & 0xffff)) + bf2f((bf16_t)(gq.x & 0xffff)) * acc[nt][mt][4 * qd];
            const float v1 = bf2f((bf16_t)(z01 >> 16)) + bf2f((bf16_t)(gq.x >> 16)) * acc[nt][mt][4 * qd + 1];
            const float v2 = bf2f((bf16_t)(z23 & 0xffff)) + bf2f((bf16_t)(gq.y & 0xffff)) * acc[nt][mt][4 * qd + 2];
            const float v3 = bf2f((bf16_t)(z23 >> 16)) + bf2f((bf16_t)(gq.y >> 16)) * acc[nt][mt][4 * qd + 3];
            zp[nt][mt][2 * qd] = pack2(v0, v1);
            zp[nt][mt][2 * qd + 1] = pack2(v2, v3);
          }
      }
    }
    bf16_t* stg = sm + wv * (64 * 72);
#pragma unroll
    for (int mt = 0; mt < 2; ++mt)
#pragma unroll
      for (int nt = 0; nt < 2; ++nt)
#pragma unroll
        for (int qd = 0; qd < 4; ++qd)
          *(uint2*)(stg + (mt * 32 + lr) * 72 + nt * 32 + 8 * qd + 4 * lh) = make_uint2(zp[nt][mt][2 * qd], zp[nt][mt][2 * qd + 1]);
#pragma unroll
    for (int it = 0; it < 8; ++it) {
      const int row = it * 8 + (lane >> 3), c16 = lane & 7;
      const u32x4 v = *(const u32x4*)(stg + row * 72 + c16 * 8);
      *(u32x4*)(z + (size_t)(mt_ * 256 + wm * 64 + row) * LDK1 + nt_ * 128 + wn * 64 + c16 * 8) = v;
    }
  }
}

DI void phase_resid(const P& p, const bf16_t* W, const bf16_t* X, int K, bf16_t* sm, const Geo& ge, bool last) {
  const int tid = tidx(), lane = tid & 63, wv = tid >> 6, wn = wv & 1, wm = wv >> 1;
  const int lr = lane & 31, lh = lane >> 5;
  bf16_t* xb = (bf16_t*)(p.ws + O_XB);
  float* part = (float*)(p.ws + O_PART);
  TileWalk tw(4, ge);
  int mt_, nt_;
  while (tw.next(mt_, nt_)) {
    f32x16 acc[4][2]; zero_acc8(acc);
    const int ldk = K + 64;
    gemm_wide(W + (size_t)nt_ * 256 * ldk, ldk, X + (size_t)mt_ * 256 * ldk, ldk, K / 64, acc, sm);
    float* stg = (float*)sm + wv * (64 * 68);
    const int m0w = mt_ * 256 + wm * 64, n0w = nt_ * 256 + wn * 128;
#pragma unroll
    for (int cp = 0; cp < 2; ++cp) {
#pragma unroll 4
      for (int it = 0; it < 8; ++it) {
        const int row = it * 8 + (lane >> 3), c8 = (lane & 7) * 8;
        const u32x4 raw = *(const u32x4*)(xb + (size_t)(m0w + row) * LDK1 + n0w + cp * 64 + c8);
        float* d = stg + row * 68 + c8;
        *(float4*)(d) = make_float4(__uint_as_float(raw[0] << 16), __uint_as_float(raw[0] & 0xffff0000u),
                                    __uint_as_float(raw[1] << 16), __uint_as_float(raw[1] & 0xffff0000u));
        *(float4*)(d + 4) = make_float4(__uint_as_float(raw[2] << 16), __uint_as_float(raw[2] & 0xffff0000u),
                                        __uint_as_float(raw[3] << 16), __uint_as_float(raw[3] & 0xffff0000u));
      }
#pragma unroll
      for (int mt = 0; mt < 2; ++mt) {
        float ss = 0.f;
#pragma unroll
        for (int nh = 0; nh < 2; ++nh)
#pragma unroll
          for (int qd = 0; qd < 4; ++qd) {
            const int nt = cp * 2 + nh;
            float4* sp = (float4*)(stg + (mt * 32 + lr) * 68 + nh * 32 + 8 * qd + 4 * lh);
            float4 v = *sp;
            v.x += acc[nt][mt][4 * qd]; v.y += acc[nt][mt][4 * qd + 1]; v.z += acc[nt][mt][4 * qd + 2]; v.w += acc[nt][mt][4 * qd + 3];
            *sp = v;
            ss += v.x * v.x + v.y * v.y + v.z * v.z + v.w * v.w;
          }
        ss += xor32(ss);
        if (lh == 0) part[(size_t)(m0w + mt * 32 + lr) * 16 + nt_ * 4 + wn * 2 + cp] = ss;
      }
#pragma unroll 4
      for (int it = 0; it < 16; ++it) {
        const int row = it * 4 + (lane >> 4), c4 = (lane & 15) * 4;
        const float4 v = *(const float4*)(stg + row * 68 + c4);
        if (last) *(float4*)(p.out + (size_t)(m0w + row) * 1024 + n0w + cp * 64 + c4) = v;
        *(uint2*)(xb + (size_t)(m0w + row) * LDK1 + n0w + cp * 64 + c4) = make_uint2(pack2(v.x, v.y), pack2(v.z, v.w));
      }
    }
  }
}

DI void phase_up(const P& p, int layer, bf16_t* sm, const Geo& ge) {
  const int tid = tidx(), lane = tid & 63, wv = tid >> 6, wn = wv & 1, wm = wv >> 1;
  const int lr = lane & 31, lh = lane >> 5;
  const bf16_t* W = (const bf16_t*)(p.ws + O_WUP + layer * SZ_WUP);
  const bf16_t* X = (const bf16_t*)(p.ws + O_XB);
  const float* part = (const float*)(p.ws + O_PART);
  bf16_t* u = (bf16_t*)(p.ws + O_U);
  TileWalk tw(16, ge);
  int mt_, nt_, mt_have = -1;
  float rs0 = 0.f, rs1 = 0.f;
  while (tw.next(mt_, nt_)) {
    if (mt_ != mt_have) {
      rs0 = row_rstd(part, mt_ * 256 + wm * 64 + lr);
      rs1 = row_rstd(part, mt_ * 256 + wm * 64 + 32 + lr);
      mt_have = mt_;
    }
    f32x16 acc[4][2]; zero_acc8(acc);
    gemm_wide(W + (size_t)nt_ * 256 * LDK1, LDK1, X + (size_t)mt_ * 256 * LDK1, LDK1, 16, acc, sm);
    bf16_t* stg = sm + wv * (64 * 136);
#pragma unroll
    for (int mt = 0; mt < 2; ++mt) {
      const float rs = mt ? rs1 : rs0;
#pragma unroll
      for (int nt = 0; nt < 4; ++nt)
#pragma unroll
        for (int qd = 0; qd < 4; ++qd) {
          const int n = nt_ * 256 + wn * 128 + nt * 32 + 8 * qd + 4 * lh;
          float a = fmaxf(acc[nt][mt][4 * qd] * rs, 0.f), b = fmaxf(acc[nt][mt][4 * qd + 1] * rs, 0.f);
          float c = fmaxf(acc[nt][mt][4 * qd + 2] * rs, 0.f), d = fmaxf(acc[nt][mt][4 * qd + 3] * rs, 0.f);
          *(uint2*)(stg + (mt * 32 + lr) * 136 + nt * 32 + 8 * qd + 4 * lh) = make_uint2(pack2(a * a, b * b), pack2(c * c, d * d));
        }
    }
    stage_rows_store<false>(stg, u + nt_ * 256 + wn * 128, LDK4, mt_ * 256 + wm * 64);
  }
}

DI unsigned xcc_id() { return (unsigned)__builtin_amdgcn_s_getreg((3 << 11) | 20) & 0xFu; }
struct BarCtx { unsigned* base; unsigned xcc, xcnt, nxcc, gen; };
DI void gbar(BarCtx& c) {
  ++c.gen;
  asm volatile("s_waitcnt vmcnt(0) lgkmcnt(0)" ::: "memory");
  __syncthreads();
  if (threadIdx.x == 0) {
    const unsigned old = __hip_atomic_fetch_add(c.base + (16 + c.xcc) * 32, 1u, __ATOMIC_RELAXED, __HIP_MEMORY_SCOPE_AGENT);
    if (old % c.xcnt == c.xcnt - 1) {
      __builtin_amdgcn_fence(__ATOMIC_RELEASE, "agent");
      asm volatile("s_waitcnt vmcnt(0)" ::: "memory");
      const unsigned t = __hip_atomic_fetch_add(c.base + 32 * 32, 1u, __ATOMIC_RELAXED, __HIP_MEMORY_SCOPE_AGENT);
      if (t % c.nxcc == c.nxcc - 1) {
        for (unsigned i = 0; i < 16; ++i)
          __hip_atomic_store(c.base + (33 + i) * 32, c.gen, __ATOMIC_RELAXED, __HIP_MEMORY_SCOPE_AGENT);
      }
    }
    while (__hip_atomic_load(c.base + (33 + c.xcc) * 32, __ATOMIC_RELAXED, __HIP_MEMORY_SCOPE_AGENT) < c.gen) __builtin_amdgcn_s_sleep(1);
    __builtin_amdgcn_fence(__ATOMIC_ACQUIRE, "agent");
    asm volatile("s_waitcnt vmcnt(0)" ::: "memory");
  }
  __syncthreads();
}

__global__ void __launch_bounds__(512, 2) mega(P p) {
  extern __shared__ __attribute__((aligned(16))) unsigned char smraw[];
  bf16_t* sm = (bf16_t*)smraw;
  cg::grid_group grid = cg::this_grid();
  if (threadIdx.x == 0)
    ((unsigned*)smraw)[0] = __hip_atomic_fetch_add((unsigned*)(p.ws + O_BAR) + xcc_id() * 32, 1u, __ATOMIC_RELAXED, __HIP_MEMORY_SCOPE_AGENT);
  __syncthreads();
  const unsigned my_rank = (unsigned)__builtin_amdgcn_readfirstlane((int)((volatile unsigned*)smraw)[0]);
  __syncthreads();
#ifndef PHMASK
#define PHMASK 0xff
#endif
  if (PHMASK & 1) phase0(p, sm);
  grid.sync();
  BarCtx bc;
  bc.base = (unsigned*)(p.ws + O_BAR); bc.xcc = xcc_id(); bc.gen = 0;
  bc.xcnt = (unsigned)__builtin_amdgcn_readfirstlane((int)__hip_atomic_load(bc.base + bc.xcc * 32, __ATOMIC_RELAXED, __HIP_MEMORY_SCOPE_AGENT));
  bc.nxcc = 0;
  for (unsigned i = 0; i < 16; ++i) bc.nxcc += __hip_atomic_load(bc.base + i * 32, __ATOMIC_RELAXED, __HIP_MEMORY_SCOPE_AGENT) ? 1u : 0u;
  bc.nxcc = (unsigned)__builtin_amdgcn_readfirstlane((int)bc.nxcc);
  unsigned hi_cnt = 0;
  for (unsigned i = 8; i < 16; ++i) hi_cnt += __hip_atomic_load(bc.base + i * 32, __ATOMIC_RELAXED, __HIP_MEMORY_SCOPE_AGENT);
  hi_cnt = (unsigned)__builtin_amdgcn_readfirstlane((int)hi_cnt);
  Geo ge;
  if (bc.nxcc == 8 && hi_cnt == 0) { ge.xcd = (int)bc.xcc; ge.loc = (int)my_rank; ge.nloc = (int)bc.xcnt; }
  else { ge.xcd = blockIdx.x & 7; ge.loc = blockIdx.x >> 3; ge.nloc = gridDim.x >> 3; }
  unsigned* qheads = bc.base + 64 * 32;
  for (int layer = 0; layer < NL; ++layer) {
    if (PHMASK & 2) phase_inproj(p, layer, sm, ge);
    gbar(bc);
    phase23(p, layer, sm, qheads + (layer * 2) * 32, qheads + (layer * 2 + 1) * 32);
    gbar(bc);
    if (PHMASK & 16) phase_merge(p, layer, sm, ge);
    gbar(bc);
    if (PHMASK & 32) phase_resid(p, (const bf16_t*)(p.ws + O_WO + layer * SZ_WO), (const bf16_t*)(p.ws + O_Z), 1024, sm, ge, false);
    gbar(bc);
    if (PHMASK & 64) phase_up(p, layer, sm, ge);
    gbar(bc);
    if (PHMASK & 128) phase_resid(p, (const bf16_t*)(p.ws + O_WDN + layer * SZ_WDN), (const bf16_t*)(p.ws + O_U), 4096, sm, ge, layer == NL - 1);
    gbar(bc);
  }
}

extern "C" void kernel_launch(void* const* d_in, const int* in_sizes, int n_in, void* d_out, int out_size, void* d_ws,
                              size_t ws_size, hipStream_t stream) {
  static int grid_blocks = 0;
  if (!grid_blocks) {
    int dev = 0, cus = 0, per_cu = 0;
    (void)hipGetDevice(&dev);
    (void)hipDeviceGetAttribute(&cus, hipDeviceAttributeMultiprocessorCount, dev);
    (void)hipFuncSetAttribute((const void*)mega, hipFuncAttributeMaxDynamicSharedMemorySize, LDS_BYTES);
    (void)hipOccupancyMaxActiveBlocksPerMultiprocessor(&per_cu, (const void*)mega, NTHR, LDS_BYTES);
    if (per_cu < 1) per_cu = 1;
    if (per_cu > 1) per_cu = 1;
    grid_blocks = cus * per_cu;
    if (ws_size < WS_END) fprintf(stderr, "workspace too small: %zu < %zu\n", ws_size, (size_t)WS_END);
  }
  P p{};
  p.x = (const float*)d_in[0]; p.w_in = (const float*)d_in[1]; p.qk_gain = (const float*)d_in[2];
  p.diff_lambda = (const float*)d_in[3]; p.diff_subln = (const float*)d_in[4]; p.sinks = (const float*)d_in[5];
  p.cmp_pos = (const float*)d_in[6]; p.cmp_w1 = (const float*)d_in[7]; p.cmp_w2 = (const float*)d_in[8];
  p.w_branch = (const float*)d_in[9]; p.w_out = (const float*)d_in[10]; p.norm_mix = (const float*)d_in[11];
  p.norm_mlp = (const float*)d_in[12]; p.w_up = (const float*)d_in[13]; p.w_down = (const float*)d_in[14];
  p.rel_bias = (const float*)d_in[15];
  p.out = (float*)d_out; p.ws = (unsigned char*)d_ws;
  (void)hipMemsetAsync((unsigned char*)d_ws + O_BAR, 0, 80 * 128, stream);
  void* args[] = {&p};
  hipError_t e = hipLaunchCooperativeKernel((const void*)mega, dim3(grid_blocks), dim3(NTHR), args, LDS_BYTES, stream);
  if (e != hipSuccess) fprintf(stderr, "cooperative launch failed: %s (grid %d)\n", hipGetErrorString(e), grid_blocks);
}
```
